# Optimizing an MI355X kernel written in HIP

```python
import math
import jax
import jax.numpy as jnp
from jax import lax
import numpy as np

D_MODEL = 1024
BATCH = 16
SEQ = 2048
DEPTH = 2

N_GROUPS = 4
HEAD_DIM = 64
HEADS_PER_GROUP = D_MODEL // (N_GROUPS * HEAD_DIM)
GROUP_W = HEADS_PER_GROUP * HEAD_DIM
D_MIX = N_GROUPS * GROUP_W
Q_BLOCK = 128

DIFF_QK_DIM = HEAD_DIM // 2
IDX_HEADS = 8
IDX_DIM = 32
TOPK_MAX = 256
MLA_Q_RANK = 256
MLA_KV_RANK = 128
MLA_NOPE = 64
MLA_ROPE = 32
MLA_V = HEAD_DIM
ROPE_BASE = 10000.0
REL_BUCKETS = 32
REL_MAX_DIST = 128
N_BIAS_HEADS = 2 * HEADS_PER_GROUP
ALPHA = (2.0 * DEPTH) ** 0.25
BETA = (8.0 * DEPTH) ** -0.25
NORM_EPS = 1e-5

SPLITS = (
    ("a_q", GROUP_W), ("a_k", GROUP_W), ("a_v", GROUP_W),
    ("b_q", GROUP_W), ("b_k", GROUP_W), ("b_v", GROUP_W),
    ("c_q", GROUP_W), ("c_k", GROUP_W), ("c_v", GROUP_W),
    ("c_iq", IDX_HEADS * IDX_DIM), ("c_ik", IDX_DIM), ("c_iw", IDX_HEADS),
    ("d_cq", MLA_Q_RANK), ("d_ckv", MLA_KV_RANK), ("d_kr", MLA_ROPE),
    ("gate", D_MIX),
)
VALUE_COLUMNS = ("a_v", "b_v", "c_v")
D_IN = sum(w for _, w in SPLITS)

kernel_name = "hybrid_sb_diff_dsa_mla_deepnorm"


def split_columns(h):
    out = {}
    off = 0
    for name, w in SPLITS:
        out[name] = h[..., off:off + w]
        off += w
    return out


def rms_norm(x, g, eps=1e-6):
    xf = x.astype(jnp.float32)
    y = xf * lax.rsqrt(jnp.mean(xf * xf, axis=-1, keepdims=True) + eps)
    return (y * g.astype(jnp.float32)).astype(x.dtype)


def layer_norm(x, g, b):
    xf = x.astype(jnp.float32)
    mu = jnp.mean(xf, axis=-1, keepdims=True)
    var = jnp.mean(jnp.square(xf - mu), axis=-1, keepdims=True)
    y = (xf - mu) * lax.rsqrt(var + NORM_EPS)
    return (y * g.astype(jnp.float32) + b.astype(jnp.float32)).astype(x.dtype)


def t5_bucket(dist):
    max_exact = REL_BUCKETS // 2
    n = jnp.maximum(dist, 0)
    nf = jnp.maximum(n, max_exact).astype(jnp.float32)
    large = max_exact + (jnp.log(nf / max_exact) / math.log(REL_MAX_DIST / max_exact)
                         * (REL_BUCKETS - max_exact)).astype(jnp.int32)
    large = jnp.minimum(large, REL_BUCKETS - 1)
    return jnp.where(n < max_exact, n, large)


def rope(x, ang):
    half = x.shape[-1] // 2
    x1 = x[..., :half].astype(jnp.float32)
    x2 = x[..., half:].astype(jnp.float32)
    c, s = jnp.cos(ang), jnp.sin(ang)
    return jnp.concatenate([x1 * c - x2 * s, x1 * s + x2 * c], axis=-1).astype(x.dtype)


def stick_breaking_block(q, k, v, qpos, kpos):
    z = jnp.einsum("bqhd,bkhd->bhqk", q, k).astype(jnp.float32) * (HEAD_DIM ** -0.5)
    strict = kpos[None, :] < qpos[:, None]
    log1m = jnp.where(strict, jax.nn.log_sigmoid(-z), 0.0)
    after = lax.cumsum(log1m, axis=3, reverse=True) - log1m
    w = jnp.where(strict, jnp.exp(jax.nn.log_sigmoid(z) + after), 0.0)
    return jnp.einsum("bhqk,bkhd->bqhd", w.astype(v.dtype), v)


def diff_block(q, k, v, causal, bias, lam, lam_init, subln):
    s = jnp.einsum("bqhcd,bkhcd->bchqk", q, k).astype(jnp.float32) * (DIFF_QK_DIM ** -0.5)
    s = jnp.where(causal, s + bias, -jnp.inf)
    p = jax.nn.softmax(s, axis=-1)
    a = p[:, 0] - lam * p[:, 1]
    o = jnp.einsum("bhqk,bkhd->bqhd", a.astype(v.dtype), v)
    return rms_norm(o, subln) * (1.0 - lam_init)


def dsa_block(qi, ki, iw, q, k, v, qpos, bias_table, n_sel):
    kpos = jnp.arange(ki.shape[1])
    dots = jnp.einsum("bqhe,bke->bqhk", qi, ki).astype(jnp.float32) * (IDX_DIM ** -0.5)
    score = jnp.einsum("bqh,bqhk->bqk", iw.astype(jnp.float32), jax.nn.relu(dots))
    score = jnp.where(kpos[None, None, :] <= qpos[None, :, None], score, -jnp.inf)
    _, idx = lax.top_k(score, n_sel)
    valid = idx <= qpos[None, :, None]
    gather = jax.vmap(lambda kk, ii: kk[ii])
    ks = gather(k, idx)
    vs = gather(v, idx)
    s = jnp.einsum("bqhd,bqkhd->bhqk", q, ks).astype(jnp.float32) * (HEAD_DIM ** -0.5)
    bias = bias_table[t5_bucket(qpos[None, :, None] - idx)]
    s = s + jnp.transpose(bias, (0, 3, 1, 2)).astype(jnp.float32)
    s = jnp.where(valid[:, None], s, -jnp.inf)
    p = jax.nn.softmax(s, axis=-1)
    return jnp.einsum("bhqk,bqkhd->bqhd", p.astype(vs.dtype), vs)


def mla_block(q_nope, q_rope, k_nope, k_rope, v, causal):
    s = (jnp.einsum("bqhd,bkhd->bhqk", q_nope, k_nope)
         + jnp.einsum("bqhr,bkr->bhqk", q_rope, k_rope)).astype(jnp.float32)
    s = jnp.where(causal, s * ((MLA_NOPE + MLA_ROPE) ** -0.5), -jnp.inf)
    p = jax.nn.softmax(s, axis=-1)
    return jnp.einsum("bhqk,bkhd->bqhd", p.astype(v.dtype), v)


def hybrid_layer(x, layer_idx, w_in, w_out, ln_g, ln_b, rel_bias, diff_lambda, diff_subln,
                 mla_q_norm, mla_kv_norm, mla_w_uq, mla_w_ukv):
    B, S, _ = x.shape
    H = HEADS_PER_GROUP
    p = split_columns(jnp.einsum("bsd,de->bse", x, w_in))
    a_q = p["a_q"].reshape(B, S, H, HEAD_DIM)
    a_k = p["a_k"].reshape(B, S, H, HEAD_DIM)
    a_v = p["a_v"].reshape(B, S, H, HEAD_DIM)
    b_q = p["b_q"].reshape(B, S, H, 2, DIFF_QK_DIM)
    b_k = p["b_k"].reshape(B, S, H, 2, DIFF_QK_DIM)
    b_v = p["b_v"].reshape(B, S, H, HEAD_DIM)
    lam_init = 0.8 - 0.6 * math.exp(-0.3 * layer_idx)
    lf = diff_lambda.astype(jnp.float32)
    lam = jnp.exp(jnp.sum(lf[0] * lf[1])) - jnp.exp(jnp.sum(lf[2] * lf[3])) + lam_init
    c_q = p["c_q"].reshape(B, S, H, HEAD_DIM)
    c_k = p["c_k"].reshape(B, S, H, HEAD_DIM)
    c_v = p["c_v"].reshape(B, S, H, HEAD_DIM)
    c_iq = p["c_iq"].reshape(B, S, IDX_HEADS, IDX_DIM)
    c_ik = p["c_ik"]
    c_iw = p["c_iw"] * (IDX_HEADS ** -0.5)
    n_sel = min(TOPK_MAX, S // 4)
    cq = rms_norm(p["d_cq"], mla_q_norm)
    ckv = rms_norm(p["d_ckv"], mla_kv_norm)
    d_q = jnp.einsum("bsr,re->bse", cq, mla_w_uq).reshape(B, S, H, MLA_NOPE + MLA_ROPE)
    d_kv = jnp.einsum("bsr,re->bse", ckv, mla_w_ukv).reshape(B, S, H, MLA_NOPE + MLA_V)
    pos = jnp.arange(S)
    inv_freq = ROPE_BASE ** (-jnp.arange(MLA_ROPE // 2, dtype=jnp.float32) / (MLA_ROPE // 2))
    ang = pos[:, None].astype(jnp.float32) * inv_freq[None, :]
    d_qn = d_q[..., :MLA_NOPE]
    d_qr = rope(d_q[..., MLA_NOPE:], ang[:, None, :])
    d_kn = d_kv[..., :MLA_NOPE]
    d_v = d_kv[..., MLA_NOPE:]
    d_kr = rope(p["d_kr"], ang)

    outs = []
    for i in range(S // Q_BLOCK):
        q0, q1 = i * Q_BLOCK, (i + 1) * Q_BLOCK
        qpos = jnp.arange(q0, q1)
        kpos = jnp.arange(q1)
        causal = kpos[None, :] <= qpos[:, None]
        bias_b = jnp.transpose(rel_bias[t5_bucket(qpos[:, None] - kpos[None, :])][..., :H],
                               (2, 0, 1)).astype(jnp.float32)
        o_a = stick_breaking_block(a_q[:, q0:q1], a_k[:, :q1], a_v[:, :q1], qpos, kpos)
        o_b = diff_block(b_q[:, q0:q1], b_k[:, :q1], b_v[:, :q1], causal, bias_b,
                         lam, lam_init, diff_subln)
        o_c = dsa_block(c_iq[:, q0:q1], c_ik, c_iw[:, q0:q1], c_q[:, q0:q1], c_k, c_v,
                        qpos, rel_bias[:, H:], n_sel)
        o_d = mla_block(d_qn[:, q0:q1], d_qr[:, q0:q1], d_kn[:, :q1], d_kr[:, :q1],
                        d_v[:, :q1], causal)
        o = jnp.concatenate([o_a, o_b.astype(o_a.dtype), o_c.astype(o_a.dtype),
                             o_d.astype(o_a.dtype)], axis=2)
        outs.append(o.reshape(B, Q_BLOCK, D_MIX))
    y = jnp.concatenate(outs, axis=1) * jax.nn.silu(p["gate"])
    y = jnp.einsum("bse,ed->bsd", y.astype(x.dtype), w_out)
    return layer_norm(ALPHA * x + y, ln_g, ln_b)


def setup_inputs(seed: int = 0) -> dict:
    key = jax.random.key(seed)
    ks = jax.random.split(key, 12)
    f32 = jnp.float32
    H = HEADS_PER_GROUP
    col_scale = jnp.asarray(np.concatenate(
        [np.full((w,), BETA if name in VALUE_COLUMNS else 1.0, np.float32) for name, w in SPLITS]))
    x = jax.random.normal(ks[0], (BATCH, SEQ, D_MODEL), f32)
    w_in = jax.random.normal(ks[1], (DEPTH, D_MODEL, D_IN), f32) * (D_MODEL ** -0.5) * col_scale
    w_out = jax.random.normal(ks[2], (DEPTH, D_MIX, D_MODEL), f32) * ((D_MIX ** -0.5) * BETA)
    ln_g = 1.0 + 0.02 * jax.random.normal(ks[3], (DEPTH, D_MODEL), f32)
    ln_b = 0.02 * jax.random.normal(ks[4], (DEPTH, D_MODEL), f32)
    rel_bias = 0.1 * jax.random.normal(ks[5], (REL_BUCKETS, N_BIAS_HEADS), f32)
    diff_lambda = 0.1 * jax.random.normal(ks[6], (DEPTH, 4, DIFF_QK_DIM), f32)
    diff_subln = 1.0 + 0.02 * jax.random.normal(ks[7], (DEPTH, HEAD_DIM), f32)
    mla_q_norm = 1.0 + 0.02 * jax.random.normal(ks[8], (DEPTH, MLA_Q_RANK), f32)
    mla_kv_norm = 1.0 + 0.02 * jax.random.normal(ks[9], (DEPTH, MLA_KV_RANK), f32)
    mla_w_uq = jax.random.normal(ks[10], (DEPTH, MLA_Q_RANK, H * (MLA_NOPE + MLA_ROPE)), f32) \
        * (MLA_Q_RANK ** -0.5)
    ukv_scale = jnp.concatenate([jnp.ones((MLA_NOPE,), f32), jnp.full((MLA_V,), BETA, f32)])
    mla_w_ukv = (jax.random.normal(ks[11], (DEPTH, MLA_KV_RANK, H, MLA_NOPE + MLA_V), f32)
                 * (MLA_KV_RANK ** -0.5) * ukv_scale).reshape(DEPTH, MLA_KV_RANK, H * (MLA_NOPE + MLA_V))
    return {"x": x, "w_in": w_in, "w_out": w_out, "ln_g": ln_g, "ln_b": ln_b,
            "rel_bias": rel_bias, "diff_lambda": diff_lambda, "diff_subln": diff_subln,
            "mla_q_norm": mla_q_norm, "mla_kv_norm": mla_kv_norm,
            "mla_w_uq": mla_w_uq, "mla_w_ukv": mla_w_ukv}


def reference(x, w_in, w_out, ln_g, ln_b, rel_bias, diff_lambda, diff_subln,
              mla_q_norm, mla_kv_norm, mla_w_uq, mla_w_ukv):
    for l in range(DEPTH):
        x = hybrid_layer(x, l, w_in[l], w_out[l], ln_g[l], ln_b[l], rel_bias,
                         diff_lambda[l], diff_subln[l], mla_q_norm[l], mla_kv_norm[l],
                         mla_w_uq[l], mla_w_ukv[l])
    return x
```

```cpp
#include <hip/hip_runtime.h>
#include <cstdio>
#include <cstdint>
#include <cmath>

namespace nv {
constexpr int D_MODEL = 1024, BATCH = 16, SEQ = 2048, DEPTH = 2, H = 4, HD = 64;
constexpr int D_IN = 4040;
constexpr int O_AQ = 0, O_AK = 256, O_AV = 512, O_BQ = 768, O_BK = 1024, O_BV = 1280, O_CQ = 1536, O_CK = 1792, O_CV = 2048,
              O_CIQ = 2304, O_CIK = 2560, O_CIW = 2592, O_DCQ = 2600, O_DCKV = 2856, O_DKR = 2984, O_GATE = 3016;
constexpr int CB = 4;
constexpr int MC = CB * SEQ;
constexpr float ALPHA = 1.4142135623730951f;

__global__ void __launch_bounds__(256) gemm_f32(const float* __restrict__ A, int lda, const float* __restrict__ B, int ldb,
                                                float* __restrict__ C, int ldc, int M, int N, int K) {
    __shared__ float As[16][65];
    __shared__ float Bs[16][65];
    const int tx = threadIdx.x & 15, ty = threadIdx.x >> 4;
    const int m0 = blockIdx.y * 64, n0 = blockIdx.x * 64;
    float acc[4][4];
#pragma unroll
    for (int i = 0; i < 4; ++i)
#pragma unroll
        for (int j = 0; j < 4; ++j) acc[i][j] = 0.f;
    for (int k0 = 0; k0 < K; k0 += 16) {
#pragma unroll
        for (int i = 0; i < 4; ++i) {
            const int e = threadIdx.x + i * 256, r = e >> 4, kk = e & 15;
            As[kk][r] = A[(size_t)(m0 + r) * lda + k0 + kk];
        }
#pragma unroll
        for (int i = 0; i < 4; ++i) {
            const int e = threadIdx.x + i * 256, kk = e >> 6, c = e & 63;
            Bs[kk][c] = (n0 + c < N) ? B[(size_t)(k0 + kk) * ldb + n0 + c] : 0.f;
        }
        __syncthreads();
#pragma unroll
        for (int kk = 0; kk < 16; ++kk) {
            float a[4], b[4];
#pragma unroll
            for (int i = 0; i < 4; ++i) a[i] = As[kk][ty * 4 + i];
#pragma unroll
            for (int j = 0; j < 4; ++j) b[j] = Bs[kk][tx * 4 + j];
#pragma unroll
            for (int i = 0; i < 4; ++i)
#pragma unroll
                for (int j = 0; j < 4; ++j) acc[i][j] = fmaf(a[i], b[j], acc[i][j]);
        }
        __syncthreads();
    }
#pragma unroll
    for (int i = 0; i < 4; ++i)
#pragma unroll
        for (int j = 0; j < 4; ++j) {
            const int c = n0 + tx * 4 + j;
            if (c < N) C[(size_t)(m0 + ty * 4 + i) * ldc + c] = acc[i][j];
        }
}

__device__ __forceinline__ float wave_sum(float v) {
#pragma unroll
    for (int o = 1; o < 64; o <<= 1) v += __shfl_xor(v, o);
    return v;
}

__global__ void __launch_bounds__(256) rms_rows(const float* __restrict__ src, int ld, int off, int W, const float* __restrict__ g, float* __restrict__ dst, int M) {
    const int row = blockIdx.x * 4 + (threadIdx.x >> 6), lane = threadIdx.x & 63;
    if (row >= M) return;
    const float* p = src + (size_t)row * ld + off;
    float s = 0.f;
    for (int c = lane; c < W; c += 64) { const float v = p[c]; s += v * v; }
    s = wave_sum(s);
    const float r = 1.0f / sqrtf(s / (float)W + 1e-6f);
    for (int c = lane; c < W; c += 64) dst[(size_t)row * W + c] = p[c] * r * g[c];
}

__device__ __forceinline__ float inv_freq(int i) { return powf(10000.0f, -(float)i / 16.0f); }

__global__ void __launch_bounds__(256) rope_k(float* __restrict__ dq, const float* __restrict__ hbuf, float* __restrict__ kr, int M) {
    const int idx = blockIdx.x * 256 + threadIdx.x;
    if (idx >= M * 16 * 5) return;
    const int i = idx & 15, which = (idx >> 4) % 5, m = idx / 80;
    const int t = m % SEQ;
    const float ang = (float)t * inv_freq(i);
    const float c = cosf(ang), s = sinf(ang);
    if (which < 4) {
        float* p = dq + (size_t)m * 384 + which * 96 + 64;
        const float x1 = p[i], x2 = p[16 + i];
        p[i] = x1 * c - x2 * s; p[16 + i] = x1 * s + x2 * c;
    } else {
        const float* p = hbuf + (size_t)m * D_IN + O_DKR;
        const float x1 = p[i], x2 = p[16 + i];
        kr[(size_t)m * 32 + i] = x1 * c - x2 * s; kr[(size_t)m * 32 + 16 + i] = x1 * s + x2 * c;
    }
}

__device__ __forceinline__ int t5_bucket(int dist) {
    const int n = dist > 0 ? dist : 0;
    if (n < 16) return n;
    const float nf = (float)n;
    int large = 16 + (int)(logf(nf / 16.0f) / 2.0794415416798357f * 16.0f);
    return large < 31 ? large : 31;
}

__device__ __forceinline__ float softplusf(float z) { return fmaxf(z, 0.f) + log1pf(expf(-fabsf(z))); }

__global__ void __launch_bounds__(256) attn_A(const float* __restrict__ hb, float* __restrict__ o) {
    const int b = blockIdx.z, hd = blockIdx.y, t = blockIdx.x * 256 + threadIdx.x;
    const float* qp = hb + (size_t)(b * SEQ + t) * D_IN + O_AQ + hd * 64;
    float q[64], acc[64];
#pragma unroll
    for (int d = 0; d < 64; ++d) { q[d] = qp[d]; acc[d] = 0.f; }
    float cum = 0.f;
    const int tmax = blockIdx.x * 256 + 255;
    for (int s = tmax - 1; s >= 0; --s) {
        const float* kp = hb + (size_t)(b * SEQ + s) * D_IN + O_AK + hd * 64;
        const float* vp = hb + (size_t)(b * SEQ + s) * D_IN + O_AV + hd * 64;
        float z = 0.f;
#pragma unroll
        for (int d = 0; d < 64; ++d) z = fmaf(q[d], kp[d], z);
        z *= 0.125f;
        if (s < t) {
            const float sp = softplusf(z);
            const float w = expf((z - sp) + cum);
#pragma unroll
            for (int d = 0; d < 64; ++d) acc[d] = fmaf(w, vp[d], acc[d]);
            cum -= sp;
        }
    }
    float* op = o + (size_t)(b * SEQ + t) * 1024 + 0 * 256 + hd * 64;
#pragma unroll
    for (int d = 0; d < 64; ++d) op[d] = acc[d];
}

__global__ void __launch_bounds__(256) attn_B(const float* __restrict__ hb, float* __restrict__ o, const float* __restrict__ rel_bias,
                                              const float* __restrict__ dlam, const float* __restrict__ subln, float lam_init) {
    const int b = blockIdx.z, hd = blockIdx.y, t = blockIdx.x * 256 + threadIdx.x;
    const float* qp = hb + (size_t)(b * SEQ + t) * D_IN + O_BQ + hd * 64;
    float q[64], o1[64], o2[64];
#pragma unroll
    for (int d = 0; d < 64; ++d) { q[d] = qp[d]; o1[d] = 0.f; o2[d] = 0.f; }
    float m1 = -INFINITY, m2 = -INFINITY, l1 = 0.f, l2 = 0.f;
    const int tmax = blockIdx.x * 256 + 255;
    const float sc = 0.17677669529663687f;
    for (int s = 0; s <= tmax; ++s) {
        const float* kp = hb + (size_t)(b * SEQ + s) * D_IN + O_BK + hd * 64;
        const float* vp = hb + (size_t)(b * SEQ + s) * D_IN + O_BV + hd * 64;
        float s1 = 0.f, s2 = 0.f;
#pragma unroll
        for (int d = 0; d < 32; ++d) { s1 = fmaf(q[d], kp[d], s1); s2 = fmaf(q[32 + d], kp[32 + d], s2); }
        if (s <= t) {
            const float bias = rel_bias[t5_bucket(t - s) * 8 + hd];
            s1 = s1 * sc + bias; s2 = s2 * sc + bias;
            {
                const float mn = fmaxf(m1, s1), a = expf(m1 - mn), p = expf(s1 - mn);
                l1 = l1 * a + p; m1 = mn;
#pragma unroll
                for (int d = 0; d < 64; ++d) o1[d] = fmaf(p, vp[d], o1[d] * a);
            }
            {
                const float mn = fmaxf(m2, s2), a = expf(m2 - mn), p = expf(s2 - mn);
                l2 = l2 * a + p; m2 = mn;
#pragma unroll
                for (int d = 0; d < 64; ++d) o2[d] = fmaf(p, vp[d], o2[d] * a);
            }
        }
    }
    float a0 = 0.f, a1 = 0.f;
    for (int d = 0; d < 32; ++d) { a0 += dlam[d] * dlam[32 + d]; a1 += dlam[64 + d] * dlam[96 + d]; }
    const float lam = expf(a0) - expf(a1) + lam_init;
    float ss = 0.f;
#pragma unroll
    for (int d = 0; d < 64; ++d) { o1[d] = o1[d] / l1 - lam * (o2[d] / l2); ss += o1[d] * o1[d]; }
    const float r = 1.0f / sqrtf(ss / 64.0f + 1e-6f);
    float* op = o + (size_t)(b * SEQ + t) * 1024 + 1 * 256 + hd * 64;
#pragma unroll
    for (int d = 0; d < 64; ++d) op[d] = o1[d] * r * subln[d] * (1.0f - lam_init);
}

__global__ void __launch_bounds__(256) c_score(const float* __restrict__ hb, float* __restrict__ score) {
    const int b = blockIdx.z, t = blockIdx.y, s = blockIdx.x * 256 + threadIdx.x;
    if (blockIdx.x * 256 > t) return;
    const float* iq = hb + (size_t)(b * SEQ + t) * D_IN + O_CIQ;
    const float* iw = hb + (size_t)(b * SEQ + t) * D_IN + O_CIW;
    const float* ik = hb + (size_t)(b * SEQ + s) * D_IN + O_CIK;
    float k[32];
#pragma unroll
    for (int d = 0; d < 32; ++d) k[d] = ik[d];
    float sc = 0.f;
#pragma unroll
    for (int hh = 0; hh < 8; ++hh) {
        float dot = 0.f;
#pragma unroll
        for (int d = 0; d < 32; ++d) dot = fmaf(iq[hh * 32 + d], k[d], dot);
        dot *= 0.17677669529663687f;
        sc += (iw[hh] * 0.35355339059327373f) * fmaxf(dot, 0.f);
    }
    score[((size_t)b * SEQ + t) * SEQ + s] = sc;
}

__global__ void __launch_bounds__(256) c_select(const float* __restrict__ score, unsigned* __restrict__ selbits) {
    const int row = blockIdx.x * 4 + (threadIdx.x >> 6), lane = threadIdx.x & 63;
    const int t = row % SEQ;
    unsigned* out = selbits + (size_t)row * 64;
    if (t < 256) {
        const int lo = lane * 32;
        unsigned w = 0u;
        if (t >= lo + 31) w = 0xFFFFFFFFu; else if (t >= lo) w = (2u << (t - lo)) - 1u;
        out[lane] = w;
        return;
    }
    const float* sp = score + (size_t)row * SEQ;
    unsigned u[32];
#pragma unroll
    for (int i = 0; i < 32; ++i) {
        const int key = lane * 32 + i;
        unsigned v = 0u;
        if (key <= t) { const unsigned bits = __float_as_uint(sp[key] + 0.0f); v = (bits & 0x80000000u) ? ~bits : (bits | 0x80000000u); }
        u[i] = v;
    }
    unsigned T = 0u;
    for (int bit = 31; bit >= 0; --bit) {
        const unsigned cand = T | (1u << bit);
        int c = 0;
#pragma unroll
        for (int i = 0; i < 32; ++i) c += (u[i] >= cand) ? 1 : 0;
        c = (int)wave_sum((float)c);
        if (c >= 256) T = cand;
    }
    int cg = 0, ce = 0;
#pragma unroll
    for (int i = 0; i < 32; ++i) { cg += (u[i] > T) ? 1 : 0; ce += (u[i] == T) ? 1 : 0; }
    const int G = (int)wave_sum((float)cg);
    int need = 256 - G;
    int pre = ce;
#pragma unroll
    for (int o = 1; o < 64; o <<= 1) { const int v = __shfl_up(pre, o); if (lane >= o) pre += v; }
    pre -= ce;
    unsigned w = 0u;
    int taken = pre;
#pragma unroll
    for (int i = 0; i < 32; ++i) {
        if (u[i] > T) w |= (1u << i);
        else if (u[i] == T) { if (taken < need) w |= (1u << i); ++taken; }
    }
    out[lane] = w;
}

__global__ void __launch_bounds__(256) attn_C(const float* __restrict__ hb, float* __restrict__ o, const float* __restrict__ rel_bias, const unsigned* __restrict__ selbits) {
    const int b = blockIdx.z, hd = blockIdx.y, t = blockIdx.x * 256 + threadIdx.x;
    const float* qp = hb + (size_t)(b * SEQ + t) * D_IN + O_CQ + hd * 64;
    const unsigned* sb = selbits + (size_t)(b * SEQ + t) * 64;
    float q[64], acc[64];
#pragma unroll
    for (int d = 0; d < 64; ++d) { q[d] = qp[d]; acc[d] = 0.f; }
    float m = -INFINITY, l = 0.f;
    const int tmax = blockIdx.x * 256 + 255;
    unsigned word = 0u;
    for (int s = 0; s <= tmax; ++s) {
        if ((s & 31) == 0) word = sb[s >> 5];
        const float* kp = hb + (size_t)(b * SEQ + s) * D_IN + O_CK + hd * 64;
        const float* vp = hb + (size_t)(b * SEQ + s) * D_IN + O_CV + hd * 64;
        float z = 0.f;
#pragma unroll
        for (int d = 0; d < 64; ++d) z = fmaf(q[d], kp[d], z);
        if (s <= t && ((word >> (s & 31)) & 1u)) {
            z = z * 0.125f + rel_bias[t5_bucket(t - s) * 8 + 4 + hd];
            const float mn = fmaxf(m, z), a = expf(m - mn), p = expf(z - mn);
            l = l * a + p; m = mn;
#pragma unroll
            for (int d = 0; d < 64; ++d) acc[d] = fmaf(p, vp[d], acc[d] * a);
        }
    }
    float* op = o + (size_t)(b * SEQ + t) * 1024 + 2 * 256 + hd * 64;
    const float il = 1.0f / l;
#pragma unroll
    for (int d = 0; d < 64; ++d) op[d] = acc[d] * il;
}

__global__ void __launch_bounds__(256) attn_D(const float* __restrict__ dq, const float* __restrict__ dkv, const float* __restrict__ kr, float* __restrict__ o) {
    const int b = blockIdx.z, hd = blockIdx.y, t = blockIdx.x * 256 + threadIdx.x;
    const float* qp = dq + (size_t)(b * SEQ + t) * 384 + hd * 96;
    float q[96], acc[64];
#pragma unroll
    for (int d = 0; d < 96; ++d) q[d] = qp[d];
#pragma unroll
    for (int d = 0; d < 64; ++d) acc[d] = 0.f;
    float m = -INFINITY, l = 0.f;
    const int tmax = blockIdx.x * 256 + 255;
    const float sc = 0.10206207261596577f;
    for (int s = 0; s <= tmax; ++s) {
        const float* kp = dkv + (size_t)(b * SEQ + s) * 512 + hd * 128;
        const float* vp = kp + 64;
        const float* rp = kr + (size_t)(b * SEQ + s) * 32;
        float z = 0.f;
#pragma unroll
        for (int d = 0; d < 64; ++d) z = fmaf(q[d], kp[d], z);
#pragma unroll
        for (int d = 0; d < 32; ++d) z = fmaf(q[64 + d], rp[d], z);
        if (s <= t) {
            z *= sc;
            const float mn = fmaxf(m, z), a = expf(m - mn), p = expf(z - mn);
            l = l * a + p; m = mn;
#pragma unroll
            for (int d = 0; d < 64; ++d) acc[d] = fmaf(p, vp[d], acc[d] * a);
        }
    }
    float* op = o + (size_t)(b * SEQ + t) * 1024 + 3 * 256 + hd * 64;
    const float il = 1.0f / l;
#pragma unroll
    for (int d = 0; d < 64; ++d) op[d] = acc[d] * il;
}

__global__ void __launch_bounds__(256) gate_mul(float* __restrict__ o, const float* __restrict__ hb, int M) {
    const size_t idx = (size_t)blockIdx.x * 256 + threadIdx.x;
    if (idx >= (size_t)M * 1024) return;
    const int m = (int)(idx >> 10), c = (int)(idx & 1023);
    const float g = hb[(size_t)m * D_IN + O_GATE + c];
    o[idx] = o[idx] * (g / (1.0f + expf(-g)));
}

__global__ void __launch_bounds__(256) ln_res(const float* __restrict__ x, const float* __restrict__ y, const float* __restrict__ g, const float* __restrict__ bb, float* __restrict__ out, int M) {
    const int row = blockIdx.x * 4 + (threadIdx.x >> 6), lane = threadIdx.x & 63;
    if (row >= M) return;
    float v[16]; float s = 0.f;
#pragma unroll
    for (int i = 0; i < 16; ++i) { const int c = i * 64 + lane; v[i] = ALPHA * x[(size_t)row * 1024 + c] + y[(size_t)row * 1024 + c]; s += v[i]; }
    const float mean = wave_sum(s) * (1.0f / 1024.0f);
    float s2 = 0.f;
#pragma unroll
    for (int i = 0; i < 16; ++i) { v[i] -= mean; s2 += v[i] * v[i]; }
    const float r = 1.0f / sqrtf(wave_sum(s2) * (1.0f / 1024.0f) + 1e-5f);
#pragma unroll
    for (int i = 0; i < 16; ++i) { const int c = i * 64 + lane; out[(size_t)row * 1024 + c] = v[i] * r * g[c] + bb[c]; }
}
}

extern "C" void kernel_launch(void* const* d_in, const int* in_sizes, int n_in, void* d_out, int out_size, void* d_ws, size_t ws_size, hipStream_t stream) {
    using namespace nv;
    const float* x = (const float*)d_in[0];
    const float* w_in = (const float*)d_in[1];
    const float* w_out = (const float*)d_in[2];
    const float* ln_g = (const float*)d_in[3];
    const float* ln_b = (const float*)d_in[4];
    const float* rel_bias = (const float*)d_in[5];
    const float* diff_lambda = (const float*)d_in[6];
    const float* diff_subln = (const float*)d_in[7];
    const float* mla_q_norm = (const float*)d_in[8];
    const float* mla_kv_norm = (const float*)d_in[9];
    const float* mla_w_uq = (const float*)d_in[10];
    const float* mla_w_ukv = (const float*)d_in[11];
    float* out = (float*)d_out;
    char* ws = (char*)d_ws;
    size_t off = 0;
    auto carve = [&](size_t bytes) { char* p = ws + off; off += (bytes + 255) & ~(size_t)255; return p; };
    float* hb = (float*)carve((size_t)MC * D_IN * 4);
    float* cq = (float*)carve((size_t)MC * 256 * 4);
    float* ckv = (float*)carve((size_t)MC * 128 * 4);
    float* dq = (float*)carve((size_t)MC * 384 * 4);
    float* dkv = (float*)carve((size_t)MC * 512 * 4);
    float* kr = (float*)carve((size_t)MC * 32 * 4);
    float* score = (float*)carve((size_t)CB * SEQ * SEQ * 4);
    unsigned* selbits = (unsigned*)carve((size_t)MC * 64 * 4);
    float* ob = (float*)carve((size_t)MC * 1024 * 4);
    float* yb = (float*)carve((size_t)MC * 1024 * 4);
    float* x1 = (float*)carve((size_t)MC * 1024 * 4);
    if (off > ws_size) { fprintf(stderr, "workspace too small: need %zu have %zu\n", off, ws_size); return; }

    for (int c = 0; c < BATCH / CB; ++c) {
        for (int l = 0; l < DEPTH; ++l) {
            const float* xin = (l == 0) ? x + (size_t)c * MC * 1024 : x1;
            float* xout = (l == DEPTH - 1) ? out + (size_t)c * MC * 1024 : x1;
            const float* wi = w_in + (size_t)l * 1024 * D_IN;
            const float* wo = w_out + (size_t)l * 1024 * 1024;
            const float lam_init = (float)(0.8 - 0.6 * exp(-0.3 * (double)l));
            gemm_f32<<<dim3((D_IN + 63) / 64, MC / 64), 256, 0, stream>>>(xin, 1024, wi, D_IN, hb, D_IN, MC, D_IN, 1024);
            rms_rows<<<MC / 4, 256, 0, stream>>>(hb, D_IN, O_DCQ, 256, mla_q_norm + l * 256, cq, MC);
            rms_rows<<<MC / 4, 256, 0, stream>>>(hb, D_IN, O_DCKV, 128, mla_kv_norm + l * 128, ckv, MC);
            gemm_f32<<<dim3(384 / 64, MC / 64), 256, 0, stream>>>(cq, 256, mla_w_uq + (size_t)l * 256 * 384, 384, dq, 384, MC, 384, 256);
            gemm_f32<<<dim3(512 / 64, MC / 64), 256, 0, stream>>>(ckv, 128, mla_w_ukv + (size_t)l * 128 * 512, 512, dkv, 512, MC, 512, 128);
            rope_k<<<(MC * 80 + 255) / 256, 256, 0, stream>>>(dq, hb, kr, MC);
            attn_A<<<dim3(SEQ / 256, H, CB), 256, 0, stream>>>(hb, ob);
            attn_B<<<dim3(SEQ / 256, H, CB), 256, 0, stream>>>(hb, ob, rel_bias, diff_lambda + l * 128, diff_subln + l * 64, lam_init);
            c_score<<<dim3(SEQ / 256, SEQ, CB), 256, 0, stream>>>(hb, score);
            c_select<<<MC / 4, 256, 0, stream>>>(score, selbits);
            attn_C<<<dim3(SEQ / 256, H, CB), 256, 0, stream>>>(hb, ob, rel_bias, selbits);
            attn_D<<<dim3(SEQ / 256, H, CB), 256, 0, stream>>>(dq, dkv, kr, ob);
            gate_mul<<<MC * 1024 / 256, 256, 0, stream>>>(ob, hb, MC);
            gemm_f32<<<dim3(1024 / 64, MC / 64), 256, 0, stream>>>(ob, 1024, wo, 1024, yb, 1024, MC, 1024, 1024);
            ln_res<<<MC / 4, 256, 0, stream>>>(xin, yb, ln_g + l * 1024, ln_b + l * 1024, xout, MC);
        }
    }
}
```

```cpp
#include <hip/hip_runtime.h>
#include <hip/hip_cooperative_groups.h>
#include <hip/hip_bf16.h>
#include <cstdio>
#include <cstdint>
#include <cmath>
namespace cg = cooperative_groups;

#ifndef NBATCH
#define NBATCH 16
#endif
#ifndef DIAG
#define DIAG 0
#endif

#ifndef PH_MASK
#define PH_MASK 0xFFFF
#endif
#define HAS(k) (((PH_MASK) >> (k)) & 1)

constexpr int NB = NBATCH, SEQ = 2048, DM = 1024, M_TOK = NB * SEQ, DEPTH = 2;
constexpr int D_IN = 4040, NV = 4096;
constexpr int V_AQ = 0, V_AK = 256, V_AV = 512, V_BQ = 768, V_BK = 1024, V_BV = 1280, V_CQ = 1536, V_CK = 1792, V_CV = 2048,
              V_CIQ = 2304, V_DCQ = 2560, V_DCKV = 2816, V_DKR = 2944, V_CIK = 2976, V_CIW = 3008, V_GATE = 3072;
constexpr int MD_QN = 0, MD_QR = 256, MD_KN = 512, MD_V = 768;
constexpr float ALPHA_RES = 1.4142135623730951f;
constexpr float LOG2E = 1.4426950408889634f, LN2 = 0.6931471805599453f;

__host__ __device__ __forceinline__ int src_col(int v) {
    if (v < 2560) return v;
    if (v < 2816) return 2600 + (v - 2560);
    if (v < 2944) return 2856 + (v - 2816);
    if (v < 2976) return 2984 + (v - 2944);
    if (v < 3008) return 2560 + (v - 2976);
    if (v < 3016) return 2592 + (v - 3008);
    if (v < 3072) return -1;
    return 3016 + (v - 3072);
}

constexpr size_t MiB = 1u << 20;
constexpr size_t WS_CTL = 0;
constexpr size_t WS_ROPE = 512 * 1024;
constexpr size_t WS_WIN = 1 * MiB;
constexpr size_t WS_WOUT = WS_WIN + 2 * (size_t)NV * DM * 2;
constexpr size_t WS_WMLA = WS_WOUT + 2 * (size_t)DM * DM * 2;
constexpr size_t WS_XB = WS_WMLA + 2 * MiB;
constexpr size_t WS_HB = WS_XB + (size_t)M_TOK * DM * 2;
constexpr size_t WS_CN = WS_HB + (size_t)M_TOK * NV * 2;
constexpr size_t WS_KR = WS_CN + (size_t)M_TOK * 384 * 2;
constexpr size_t WS_MD = WS_KR + (size_t)M_TOK * 32 * 2;
constexpr size_t WS_SEL = WS_MD + (size_t)M_TOK * DM * 2;
constexpr size_t WS_END = WS_SEL + (size_t)M_TOK * 64 * 4;

#define LAS __attribute__((address_space(3)))
typedef unsigned short bf16_t;
typedef short bf16x8 __attribute__((ext_vector_type(8)));
typedef float f32x4 __attribute__((ext_vector_type(4)));
typedef float f32x16 __attribute__((ext_vector_type(16)));
typedef unsigned u32x4 __attribute__((ext_vector_type(4)));
typedef unsigned u32x2 __attribute__((ext_vector_type(2)));
typedef float f32x2_t __attribute__((ext_vector_type(2)));
typedef __bf16 bf16x2_t __attribute__((ext_vector_type(2)));
__device__ __forceinline__ unsigned cvtpk(float lo, float hi) { f32x2_t v = {lo, hi}; bf16x2_t b = __builtin_convertvector(v, bf16x2_t); return __builtin_bit_cast(unsigned, b); }
__device__ __forceinline__ float bf2f(unsigned short h) { return __uint_as_float((unsigned)h << 16); }
__device__ __forceinline__ float bflo(unsigned w) { return __uint_as_float(w << 16); }
__device__ __forceinline__ float bfhi(unsigned w) { return __uint_as_float(w & 0xffff0000u); }
__device__ __forceinline__ float wave_sum(float v) {
#pragma unroll
    for (int o = 1; o < 64; o <<= 1) v += __shfl_xor(v, o);
    return v;
}
namespace pg8 {
#define PG8_LAS __attribute__((address_space(3)))
typedef unsigned short bf16_t;
typedef short bf16x8 __attribute__((ext_vector_type(8)));
typedef float f32x4 __attribute__((ext_vector_type(4)));
typedef unsigned u32x4 __attribute__((ext_vector_type(4)));
constexpr int BM = 256, BK = 64, HALF = 128, HTB = HALF * BK * 2  , STAGE_BYTES = 8 * HTB, NXCD = 8, WGM = 8;

__host__ __device__ __forceinline__ int lds_byte(int r, int c) { const int st = (r >> 4) * 2 + (c >> 5), rr = r & 15, cc = c & 31, ob = rr * 64 + cc * 2; return st * 1024 + (ob ^ (((ob >> 9) & 1) << 5)); }
__host__ __device__ __forceinline__ void stage_rc(int b, int& R, int& C) { const int st = b / 1024, sb = b % 1024, swz = sb ^ (((sb >> 9) & 1) << 5); R = (st >> 1) * 16 + swz / 64; C = (st & 1) * 32 + (swz % 64) / 2; }
__host__ __device__ __forceinline__ int perm32(int rho) { const int n = rho >> 4, i = rho & 15; return 8 * (i >> 2) + 4 * n + (i & 3); }

struct Unit { int pm, pn; };
struct Gemm { const bf16_t* A; const bf16_t* Bt; int M, N, K; };

struct StaticOrder {
    int nM, nN, nwg, G, c;
    __host__ __device__ void init(int M, int N, int G_, int c_) { nM = M / BM; nN = N / BM; nwg = nM * nN; G = G_; c = c_; }
    __host__ __device__ bool next(int i, Unit& u) const {
        const long L = (long)i * G + c; if (L >= nwg) return false;
        int wgid = (int)L; { const int q = nwg / NXCD, r = nwg % NXCD, xcd = wgid % NXCD, off = wgid / NXCD; wgid = (xcd < r ? xcd * (q + 1) : r * (q + 1) + (xcd - r) * q) + off; }
        const int nig = WGM * nN, gid = wgid / nig, fm = gid * WGM, gsz = (nM - fm) < WGM ? (nM - fm) : WGM;
        u.pm = fm + ((wgid % nig) % gsz); u.pn = (wgid % nig) / gsz; return true;
    }
    __device__ __forceinline__ void a_ready(const Unit&) const {}
    __device__ __forceinline__ void done(const Unit&) const {}
};


__device__ __forceinline__ float silu_f(float v) { return v * __builtin_amdgcn_rcpf(1.0f + __builtin_amdgcn_exp2f(-v * 1.4426950408889634f)); }

struct EpiMain {
    static constexpr bool PERM = true, AFTER_DRAIN = false;
    bf16_t* O; int ldc; int gate_from;
    __device__ __forceinline__ void operator()(const f32x4 (&acc)[2][2][4][2], const Unit& u, int wr, int wc, int fr, int fq) const {
        const int row0 = u.pm * BM + wr * 64 + fr, col0 = u.pn * BM + wc * 32 + 8 * fq;
        const bool gate = u.pn >= gate_from;
#pragma unroll
        for (int ai = 0; ai < 2; ++ai)
#pragma unroll
            for (int m = 0; m < 4; ++m) { bf16_t* rowp = O + (size_t)(row0 + ai * HALF + m * 16) * ldc + col0;
#pragma unroll
                for (int bj = 0; bj < 2; ++bj) { f32x4 v0 = acc[ai][bj][m][0], v1 = acc[ai][bj][m][1];
                    if (gate) {
#pragma unroll
                        for (int j = 0; j < 4; ++j) { v0[j] = silu_f(v0[j]); v1[j] = silu_f(v1[j]); } }
                    u32x4 w; w.x = ::cvtpk(v0[0], v0[1]); w.y = ::cvtpk(v0[2], v0[3]); w.z = ::cvtpk(v1[0], v1[1]); w.w = ::cvtpk(v1[2], v1[3]);
                    *(u32x4*)(rowp + bj * HALF) = w; } }
    }
};
struct EpiOut {
    static constexpr bool PERM = false, AFTER_DRAIN = false;
    const float* xres; float* Z; float alpha;
    __device__ __forceinline__ void operator()(const f32x4 (&acc)[2][2][4][2], const Unit& u, int wr, int wc, int fr, int fq) const {
        const int row0 = u.pm * BM + wr * 64 + fr, col0 = u.pn * BM + wc * 32 + 4 * fq;
#pragma unroll
        for (int ai = 0; ai < 2; ++ai)
#pragma unroll
            for (int m = 0; m < 4; ++m) { const size_t off = (size_t)(row0 + ai * HALF + m * 16) * 1024 + col0;
#pragma unroll
                for (int bj = 0; bj < 2; ++bj)
#pragma unroll
                    for (int n = 0; n < 2; ++n) { const f32x4 xr = *(const f32x4*)(xres + off + bj * HALF + n * 16);
                        *(f32x4*)(Z + off + bj * HALF + n * 16) = xr * alpha + acc[ai][bj][m][n]; } }
    }
};
template <class Epi, class Sched, bool ALIGN_EPI = false, bool SP2 = false>
__device__ __forceinline__ void gemm_phase(PG8_LAS unsigned char* lds, const Gemm g, const Sched& S, const Epi& E, int wid_in) {
    int tid_op = wid_in * 64 + (int)__builtin_amdgcn_mbcnt_hi(~0u, __builtin_amdgcn_mbcnt_lo(~0u, 0u)); asm volatile("" : "+v"(tid_op));
    const int tid = tid_op, wid = __builtin_amdgcn_readfirstlane(tid >> 6), lane = tid & 63, wr = wid >> 2, wc = wid & 3, fr = lane & 15, fq = lane >> 4;
    const int K = g.K, nt = K / BK;
    unsigned voffA[2], voffB[2];
#pragma unroll
    for (int i = 0; i < 2; ++i) { int R, C; stage_rc(tid * 16 + i * 8192, R, C); const int Rb = Epi::PERM ? ((R & ~31) + perm32(R & 31)) : R;
        voffA[i] = (unsigned)(R * K + C) * 2u; voffB[i] = (unsigned)(Rb * K + C) * 2u; }
    const size_t kstep = (size_t)(BK * 2);
    const size_t hstep = (size_t)HALF * K * 2;
    const size_t tstep = 2 * hstep;
    const unsigned ldsw = (unsigned)wid * 1024u;
    const int aoff = lds_byte(wr * 64 + fr, fq * 8), boff = lds_byte(wc * 32 + fr, fq * 8);
#define PG8_SA(b, h) (((b) * 2 + (h)) * HTB)
#define PG8_SB(b, h) ((4 + (b) * 2 + (h)) * HTB)
#define PG8_STAGE(bufoff, gbase, voff) do { _Pragma("unroll") for (int _i = 0; _i < 2; ++_i) \
        __builtin_amdgcn_global_load_lds((const unsigned*)((const char*)(gbase) + (voff)[_i]), (PG8_LAS unsigned*)(lds + (bufoff) + ldsw + _i * 8192), 16, 0, 0); } while (0)
#define PG8_LDA(dst, b, h) do { _Pragma("unroll") for (int m = 0; m < 4; ++m) _Pragma("unroll") for (int k = 0; k < 2; ++k) dst[m][k] = *(const PG8_LAS bf16x8*)(lds + PG8_SA(b, h) + aoff + m * 2048 + k * 1024); } while (0)
#define PG8_LDB(dst, b, h) do { _Pragma("unroll") for (int n = 0; n < 2; ++n) _Pragma("unroll") for (int k = 0; k < 2; ++k) dst[n][k] = *(const PG8_LAS bf16x8*)(lds + PG8_SB(b, h) + boff + n * 2048 + k * 1024); } while (0)
#define PG8_MMA(ai, bj, At, Bt) do { __builtin_amdgcn_s_setprio(1); _Pragma("unroll") for (int m = 0; m < 4; ++m) _Pragma("unroll") for (int n = 0; n < 2; ++n) _Pragma("unroll") for (int k = 0; k < 2; ++k) \
        acc[ai][bj][m][n] = __builtin_amdgcn_mfma_f32_16x16x32_bf16(Bt[n][k], At[m][k], acc[ai][bj][m][n], 0, 0, 0); __builtin_amdgcn_s_setprio(0); } while (0)
#define PG8_WAIT_V(n) asm volatile("s_waitcnt vmcnt(" #n ")" ::: "memory")
#define PG8_WAIT_L(n) asm volatile("s_waitcnt lgkmcnt(" #n ")" ::: "memory")
#define PG8_BAR __builtin_amdgcn_s_barrier()
#define PG8_SCHED __builtin_amdgcn_sched_barrier(0)
    Unit cur, nxt; int ui = 0;
    if (!S.next(0, cur)) return;
    f32x4 acc[2][2][4][2];
#pragma unroll
    for (int a = 0; a < 2; ++a)
#pragma unroll
        for (int b = 0; b < 2; ++b)
#pragma unroll
            for (int m = 0; m < 4; ++m)
#pragma unroll
                for (int n = 0; n < 2; ++n) acc[a][b][m][n] = (f32x4){0.f, 0.f, 0.f, 0.f};
    bf16x8 At[4][2], B0[2][2], B1[2][2];
    const char* cA = (const char*)g.A + (size_t)cur.pm * tstep; const char* cB = (const char*)g.Bt + (size_t)cur.pn * tstep;
    S.a_ready(cur);
    if constexpr (SP2) {
        PG8_STAGE(PG8_SB(0, 0), cB, voffB); PG8_STAGE(PG8_SB(0, 1), cB + hstep, voffB); PG8_STAGE(PG8_SA(0, 0), cA, voffA); PG8_STAGE(PG8_SA(0, 1), cA + hstep, voffA);
        if (wr == 1) PG8_BAR;
        PG8_WAIT_V(2); PG8_BAR;
        PG8_STAGE(PG8_SB(1, 0), cB + kstep, voffB); PG8_STAGE(PG8_SA(1, 0), cA + kstep, voffA); PG8_STAGE(PG8_SB(1, 1), cB + hstep + kstep, voffB);
        PG8_WAIT_V(6); PG8_BAR;
    } else {
        PG8_STAGE(PG8_SB(0, 0), cB, voffB); PG8_STAGE(PG8_SA(0, 0), cA, voffA); PG8_STAGE(PG8_SB(0, 1), cB + hstep, voffB); PG8_STAGE(PG8_SA(0, 1), cA + hstep, voffA);
        if (wr == 1) PG8_BAR;
        PG8_WAIT_V(4); PG8_BAR;
        PG8_STAGE(PG8_SB(1, 0), cB + kstep, voffB); PG8_STAGE(PG8_SA(1, 0), cA + kstep, voffA); PG8_STAGE(PG8_SB(1, 1), cB + hstep + kstep, voffB);
        PG8_WAIT_V(6); PG8_BAR;
    }
    for (;;) {
        const bool has_next = S.next(ui + 1, nxt);
        const char* nA = has_next ? (const char*)g.A + (size_t)nxt.pm * tstep : cA; const char* nB = has_next ? (const char*)g.Bt + (size_t)nxt.pn * tstep : cB;
#pragma unroll 1
        for (int t = 0; t < nt; t += 2) {
            const bool last = (t == nt - 2);
            const char* a1 = cA + (size_t)(t + 1) * kstep;
            const char* a2 = last ? nA : cA + (size_t)(t + 2) * kstep; const char* b2 = last ? nB : cB + (size_t)(t + 2) * kstep;
            const char* a3 = a2 + kstep; const char* b3 = b2 + kstep;
            if (last && has_next) S.a_ready(nxt);
            if constexpr (SP2) {
            PG8_LDB(B0, 0, 0); PG8_LDB(B1, 0, 1); PG8_SCHED; PG8_LDA(At, 0, 0); PG8_STAGE(PG8_SA(1, 1), a1 + hstep, voffA);
            PG8_WAIT_V(8); PG8_WAIT_L(0); PG8_BAR; PG8_MMA(0, 0, At, B0); PG8_MMA(0, 1, At, B1); PG8_BAR; PG8_SCHED;
            PG8_LDA(At, 0, 1); PG8_STAGE(PG8_SB(0, 0), b2, voffB); PG8_STAGE(PG8_SB(0, 1), b2 + hstep, voffB); PG8_STAGE(PG8_SA(0, 0), a2, voffA);
            PG8_WAIT_V(8); PG8_WAIT_L(0); PG8_BAR; PG8_MMA(1, 0, At, B0); PG8_MMA(1, 1, At, B1); PG8_BAR; PG8_SCHED;
            PG8_LDB(B0, 1, 0); PG8_LDB(B1, 1, 1); PG8_SCHED; PG8_LDA(At, 1, 0); PG8_STAGE(PG8_SA(0, 1), a2 + hstep, voffA);
            PG8_WAIT_V(8); PG8_WAIT_L(0); PG8_BAR; PG8_MMA(0, 0, At, B0); PG8_MMA(0, 1, At, B1); PG8_BAR; PG8_SCHED;
            PG8_LDA(At, 1, 1); PG8_STAGE(PG8_SB(1, 0), b3, voffB); PG8_STAGE(PG8_SB(1, 1), b3 + hstep, voffB); PG8_STAGE(PG8_SA(1, 0), a3, voffA);
            PG8_WAIT_V(8); PG8_WAIT_L(0); PG8_BAR; PG8_MMA(1, 0, At, B0); PG8_MMA(1, 1, At, B1); PG8_BAR; PG8_SCHED;
            } else {
            PG8_LDB(B0, 0, 0); PG8_SCHED; PG8_LDA(At, 0, 0); PG8_STAGE(PG8_SA(1, 1), a1 + hstep, voffA);
            PG8_WAIT_L(8); PG8_BAR; PG8_WAIT_L(0); PG8_MMA(0, 0, At, B0); PG8_BAR; PG8_SCHED;
            PG8_LDB(B1, 0, 1); PG8_STAGE(PG8_SB(0, 0), b2, voffB);
            PG8_BAR; PG8_WAIT_L(0); PG8_MMA(0, 1, At, B1); PG8_BAR;
            PG8_LDA(At, 0, 1); PG8_STAGE(PG8_SA(0, 0), a2, voffA);
            PG8_BAR; PG8_WAIT_L(0); PG8_MMA(1, 0, At, B0); PG8_BAR; PG8_SCHED;
            PG8_STAGE(PG8_SB(0, 1), b2 + hstep, voffB);
            PG8_WAIT_V(6); PG8_BAR; PG8_MMA(1, 1, At, B1); PG8_BAR;
            PG8_LDB(B0, 1, 0); PG8_SCHED; PG8_LDA(At, 1, 0); PG8_STAGE(PG8_SA(0, 1), a2 + hstep, voffA);
            PG8_WAIT_L(8); PG8_BAR; PG8_WAIT_L(0); PG8_MMA(0, 0, At, B0); PG8_BAR; PG8_SCHED;
            PG8_LDB(B1, 1, 1); PG8_STAGE(PG8_SB(1, 0), b3, voffB);
            PG8_BAR; PG8_WAIT_L(0); PG8_MMA(0, 1, At, B1); PG8_BAR;
            PG8_LDA(At, 1, 1); PG8_STAGE(PG8_SA(1, 0), a3, voffA);
            PG8_BAR; PG8_WAIT_L(0); PG8_MMA(1, 0, At, B0); PG8_BAR; PG8_SCHED;
            PG8_STAGE(PG8_SB(1, 1), b3 + hstep, voffB);
            PG8_WAIT_V(6); PG8_BAR; PG8_MMA(1, 1, At, B1); PG8_BAR;
            }
        }
        if constexpr (ALIGN_EPI) { if (wr == 0) PG8_BAR; }
        if constexpr (!Epi::AFTER_DRAIN) { E(acc, cur, wr, wc, fr, fq); S.done(cur); }
        if (!has_next) break;
#pragma unroll
        for (int a = 0; a < 2; ++a)
#pragma unroll
            for (int b = 0; b < 2; ++b)
#pragma unroll
                for (int m = 0; m < 4; ++m)
#pragma unroll
                    for (int n = 0; n < 2; ++n) acc[a][b][m][n] = (f32x4){0.f, 0.f, 0.f, 0.f};
        cur = nxt; cA = nA; cB = nB; ++ui;
        if constexpr (ALIGN_EPI) { if (wr == 1) PG8_BAR; }
    }
    PG8_WAIT_V(0);
    if constexpr (!ALIGN_EPI) { if (wr == 0) PG8_BAR; }
    PG8_BAR;
    if constexpr (Epi::AFTER_DRAIN) { E.fused(acc, cur, wr, wc, fr, fq, lds, wid, lane); S.done(cur); }
#undef PG8_SA
#undef PG8_SB
#undef PG8_STAGE
#undef PG8_LDA
#undef PG8_LDB
#undef PG8_MMA
#undef PG8_WAIT_V
#undef PG8_WAIT_L
#undef PG8_BAR
#undef PG8_SCHED
}
}

constexpr int NWAVES = 8, NTHREADS = 512;
constexpr int LDS_BYTES = 147456;
constexpr int SEL_RS = 2052;
constexpr int LDS_CTL = 16 * SEL_RS * 4;
constexpr int AL_K = 0, AL_KB = 12288, AL_V = 2 * AL_KB, AL_VB = 8192, AL_BIAS = AL_V + 2 * AL_VB, AL_FLAG = AL_BIAS + 1024, AL_Q = AL_FLAG + 1024;

struct Args {
    const float* x; const float* w_in; const float* w_out; const float* ln_g; const float* ln_b; const float* rel_bias; const float* diff_lambda;
    const float* diff_subln; const float* mla_q_norm; const float* mla_kv_norm; const float* mla_w_uq; const float* mla_w_ukv;
    float* out; unsigned char* ws; int ph_lo, ph_hi;
};

struct Ctx {
    LAS unsigned char* lds; int tid, lane, wid, vcu, G;
};

__device__ __forceinline__ f32x16 mfma32(bf16x8 a, bf16x8 b, f32x16 c) { return __builtin_amdgcn_mfma_f32_32x32x16_bf16(a, b, c, 0, 0, 0); }
__device__ __forceinline__ f32x4 mfma16(bf16x8 a, bf16x8 b, f32x4 c) { return __builtin_amdgcn_mfma_f32_16x16x32_bf16(a, b, c, 0, 0, 0); }
typedef short v4i16_t __attribute__((ext_vector_type(4)));
__device__ __forceinline__ v4i16_t vtr(LAS const unsigned char* p) { return __builtin_amdgcn_ds_read_tr16_b64_v4i16((LAS v4i16_t*)p); }
__device__ __forceinline__ float xhalf_sum(float v) { auto rr = __builtin_amdgcn_permlane32_swap(__float_as_uint(v), __float_as_uint(v), false, false); return __uint_as_float(rr[0]) + __uint_as_float(rr[1]); }
__device__ __forceinline__ float xhalf_max(float v) { auto rr = __builtin_amdgcn_permlane32_swap(__float_as_uint(v), __float_as_uint(v), false, false); return fmaxf(__uint_as_float(rr[0]), __uint_as_float(rr[1])); }
__device__ __forceinline__ float xhalf_other(float v, int hi) { auto rr = __builtin_amdgcn_permlane32_swap(__float_as_uint(v), __float_as_uint(v), false, false); return __uint_as_float(hi ? rr[0] : rr[1]); }
__device__ __forceinline__ int crow(int r, int hi) { return (r & 3) + 8 * (r >> 2) + 4 * hi; }

__device__ __forceinline__ int t5_bucket(int n) {
    if (n < 16) return n;
    int large = 16 + (int)(logf((float)n / 16.0f) / 2.0794415416798357f * 16.0f);
    return large < 31 ? large : 31;
}

template <int MAP>
__device__ __forceinline__ void p0_transpose_item(const float* W, int K, int N, bf16_t* WT, LAS float* scr, int item, int nblk, int lane) {
    const int kb = item / nblk, nb = item % nblk, k0 = 64 * kb, n0 = 32 * nb;
    const int v = n0 + (lane & 31);
    const int sc = MAP ? src_col(v) : v;
#pragma unroll 8
    for (int i = 0; i < 32; ++i) { const int kk = 2 * i + (lane >> 5); scr[kk * 33 + (lane & 31)] = (sc >= 0) ? W[(size_t)(k0 + kk) * N + sc] : 0.f; }
    asm volatile("s_waitcnt lgkmcnt(0)" ::: "memory");
    const int c = lane & 7;
#pragma unroll
    for (int j = 0; j < 4; ++j) { const int n = (lane >> 3) + 8 * j; const LAS float* s = scr + (8 * c) * 33 + n;
        u32x4 o; o.x = cvtpk(s[0 * 33], s[1 * 33]); o.y = cvtpk(s[2 * 33], s[3 * 33]); o.z = cvtpk(s[4 * 33], s[5 * 33]); o.w = cvtpk(s[6 * 33], s[7 * 33]);
        *(u32x4*)(WT + (size_t)(n0 + n) * K + k0 + 8 * c) = o; }
    asm volatile("s_waitcnt lgkmcnt(0)" ::: "memory");
}
__device__ __forceinline__ void p0_prologue(const Ctx& C, const Args& a) {
    unsigned char* ws = a.ws;
    LAS float* scr = (LAS float*)(C.lds + C.wid * 16384);
    const int gw = C.vcu * NWAVES + C.wid, NGW = C.G * NWAVES;
    constexpr int I_IN = (DM / 64) * (NV / 32), I_OUT = (DM / 64) * (DM / 32);
    for (int it = gw; it < 2 * I_IN + 2 * I_OUT; it += NGW) {
        int r = it;
        if (r < 2 * I_IN) { const int l = r / I_IN; r -= l * I_IN;
            p0_transpose_item<1>(a.w_in + (size_t)l * DM * D_IN, DM, D_IN, (bf16_t*)(ws + WS_WIN) + (size_t)l * NV * DM, scr, r, NV / 32, C.lane); continue; }
        r -= 2 * I_IN; { const int l = r / I_OUT; r -= l * I_OUT;
            p0_transpose_item<0>(a.w_out + (size_t)l * DM * DM, DM, DM, (bf16_t*)(ws + WS_WOUT) + (size_t)l * DM * DM, scr, r, DM / 32, C.lane); }
    }
    const int gt = C.vcu * NTHREADS + C.tid, NGT = C.G * NTHREADS;
    for (int e = gt; e < 2 * 1024 * 384; e += NGT) {
        const int l = e / (1024 * 384), rem = e % (1024 * 384), r = rem / 384, k = rem % 384;
        float v = 0.f;
        if (r < 256) { if (k < 256) v = a.mla_w_uq[(size_t)l * 256 * 384 + (size_t)k * 384 + (r >> 6) * 96 + (r & 63)]; }
        else if (r < 384) { if (k < 256) v = a.mla_w_uq[(size_t)l * 256 * 384 + (size_t)k * 384 + ((r - 256) >> 5) * 96 + 64 + ((r - 256) & 31)]; }
        else if (r < 512) { }
        else if (r < 768) { if (k >= 256) v = a.mla_w_ukv[(size_t)l * 128 * 512 + (size_t)(k - 256) * 512 + ((r - 512) >> 6) * 128 + ((r - 512) & 63)]; }
        else { if (k >= 256) v = a.mla_w_ukv[(size_t)l * 128 * 512 + (size_t)(k - 256) * 512 + ((r - 768) >> 6) * 128 + 64 + ((r - 768) & 63)]; }
        ((bf16_t*)(ws + WS_WMLA))[e] = (bf16_t)(cvtpk(v, 0.f) & 0xffffu);
    }
    for (int e = gt; e < SEQ * 16; e += NGT) {
        const int t = e >> 4, i = e & 15;
        const float ang = (float)t * powf(10000.0f, -(float)i / 16.0f);
        ((float*)(ws + WS_ROPE))[2 * e] = cosf(ang); ((float*)(ws + WS_ROPE))[2 * e + 1] = sinf(ang);
    }
    for (size_t e = gt; e < (size_t)M_TOK * DM / 8; e += NGT) {
        const f32x4 v0 = *(const f32x4*)(a.x + e * 8), v1 = *(const f32x4*)(a.x + e * 8 + 4);
        u32x4 o; o.x = cvtpk(v0[0], v0[1]); o.y = cvtpk(v0[2], v0[3]); o.z = cvtpk(v1[0], v1[1]); o.w = cvtpk(v1[2], v1[3]);
        *(u32x4*)((bf16_t*)(ws + WS_XB) + e * 8) = o;
    }
}

__device__ __forceinline__ void p2_mla_prep(const Ctx& C, const Args& a, int layer) {
    const bf16_t* HB = (const bf16_t*)(a.ws + WS_HB); bf16_t* CN = (bf16_t*)(a.ws + WS_CN); bf16_t* KR = (bf16_t*)(a.ws + WS_KR);
    const float* rope = (const float*)(a.ws + WS_ROPE);
    const float* gq = a.mla_q_norm + layer * 256; const float* gkv = a.mla_kv_norm + layer * 128;
    const int gw = C.vcu * NWAVES + C.wid, NGW = C.G * NWAVES, lane = C.lane;
    const f32x4 g4 = *(const f32x4*)(gq + 4 * lane); const float g20 = gkv[2 * lane], g21 = gkv[2 * lane + 1];
    for (int m = gw; m < M_TOK; m += NGW) {
        const bf16_t* hr = HB + (size_t)m * NV;
        const u32x2 q = *(const u32x2*)(hr + V_DCQ + 4 * lane);
        const unsigned kv = *(const unsigned*)(hr + V_DCKV + 2 * lane);
        const float q0 = bflo(q.x), q1 = bfhi(q.x), q2 = bflo(q.y), q3 = bfhi(q.y), k0 = bflo(kv), k1 = bfhi(kv);
        const float sq = wave_sum((q0 * q0 + q1 * q1) + (q2 * q2 + q3 * q3)), sk = wave_sum(k0 * k0 + k1 * k1);
        const float rq = 1.0f / sqrtf(sq * (1.0f / 256.0f) + 1e-6f), rk = 1.0f / sqrtf(sk * (1.0f / 128.0f) + 1e-6f);
        u32x2 oq; oq.x = cvtpk(q0 * rq * g4[0], q1 * rq * g4[1]); oq.y = cvtpk(q2 * rq * g4[2], q3 * rq * g4[3]);
        *(u32x2*)(CN + (size_t)m * 384 + 4 * lane) = oq;
        *(unsigned*)(CN + (size_t)m * 384 + 256 + 2 * lane) = cvtpk(k0 * rk * g20, k1 * rk * g21);
        if (lane < 16) {
            const float x1 = bf2f(hr[V_DKR + lane]), x2 = bf2f(hr[V_DKR + 16 + lane]);
            const float c = rope[((m & (SEQ - 1)) * 16 + lane) * 2], s = rope[((m & (SEQ - 1)) * 16 + lane) * 2 + 1];
            KR[(size_t)m * 32 + lane] = (bf16_t)(cvtpk(x1 * c - x2 * s, 0.f) & 0xffffu);
            KR[(size_t)m * 32 + 16 + lane] = (bf16_t)(cvtpk(x1 * s + x2 * c, 0.f) & 0xffffu);
        }
    }
}

__device__ __forceinline__ void sel_step(const Ctx& C, const Args& a, int b, int j) {
    const bf16_t* HB = (const bf16_t*)(a.ws + WS_HB); unsigned* SEL = (unsigned*)(a.ws + WS_SEL);
    LAS float* sc_lds = (LAS float*)C.lds;
    int lane_op = C.lane; asm volatile("" : "+v"(lane_op));
    const int lane = lane_op, wid = C.wid, t0 = 16 * j;
    const size_t rb = (size_t)b * SEQ;
    if (t0 + 15 < 256) {
#pragma unroll
        for (int rr = 0; rr < 2; ++rr) SEL[(rb + t0 + 2 * wid + rr) * 64 + lane] = 0xFFFFFFFFu;
        return;
    }
    const int nkt = j + 1;
    {
        const int q = lane & 15, kq = lane >> 4;
        const bf16_t* qrow = HB + (rb + t0 + q) * NV;
        bf16x8 bq[8];
#pragma unroll
        for (int h = 0; h < 8; ++h) bq[h] = *(const bf16x8*)(qrow + V_CIQ + h * 32 + 8 * kq);
        const u32x4 wv = *(const u32x4*)(qrow + V_CIW);
        float w[8]; const float wsc = 0.35355339059327373f * 0.17677669529663687f;
        w[0] = bflo(wv.x) * wsc; w[1] = bfhi(wv.x) * wsc; w[2] = bflo(wv.y) * wsc; w[3] = bfhi(wv.y) * wsc;
        w[4] = bflo(wv.z) * wsc; w[5] = bfhi(wv.z) * wsc; w[6] = bflo(wv.w) * wsc; w[7] = bfhi(wv.w) * wsc;
        for (int kt = wid; kt < nkt; kt += 8) {
            const bf16x8 ak = *(const bf16x8*)(HB + (rb + 16 * kt + q) * NV + V_CIK + 8 * kq);
            f32x4 s = {0.f, 0.f, 0.f, 0.f};
#pragma unroll
            for (int h = 0; h < 8; ++h) { const f32x4 d = mfma16(ak, bq[h], (f32x4){0.f, 0.f, 0.f, 0.f});
#pragma unroll
                for (int i = 0; i < 4; ++i) s[i] = fmaf(w[h], fmaxf(d[i], 0.f), s[i]); }
            *(LAS f32x4*)(sc_lds + q * SEL_RS + 16 * kt + 4 * kq) = s;
        }
    }
    __syncthreads();
#pragma unroll 1
    for (int rr = 0; rr < 2; ++rr) {
        const int q = 2 * wid + rr, t = t0 + q;
        unsigned u[32];
#pragma unroll
        for (int i = 0; i < 32; ++i) { const int key = lane + 64 * i; unsigned v = 0u;
            if (key <= t) { const unsigned bits = __float_as_uint(sc_lds[q * SEL_RS + key] + 0.0f); v = (bits & 0x80000000u) ? ~bits : (bits | 0x80000000u); }
            u[i] = v; }
        unsigned T = 0u;
#pragma unroll 1
        for (int bit = 31; bit >= 0; --bit) {
            const unsigned cand = T | (1u << bit);
            int c = 0;
#pragma unroll
            for (int i = 0; i < 32; ++i) c += (u[i] >= cand) ? 1 : 0;
#pragma unroll
            for (int o = 1; o < 64; o <<= 1) c += __shfl_xor(c, o);
            if (c >= 256) T = cand;
        }
        int cgt = 0;
#pragma unroll
        for (int i = 0; i < 32; ++i) cgt += (u[i] > T) ? 1 : 0;
#pragma unroll
        for (int o = 1; o < 64; o <<= 1) cgt += __shfl_xor(cgt, o);
        const int need = 256 - cgt;
        int ceq = 0;
#pragma unroll
        for (int i = 0; i < 32; ++i) ceq += (u[i] == T) ? 1 : 0;
#pragma unroll
        for (int o = 1; o < 64; o <<= 1) ceq += __shfl_xor(ceq, o);
        unsigned myword = 0u;
        if (ceq == need) {
#pragma unroll
            for (int i = 0; i < 32; ++i) {
                const unsigned long long bal = __ballot(u[i] >= T);
                if ((lane >> 1) == i) myword = (lane & 1) ? (unsigned)(bal >> 32) : (unsigned)bal;
                __builtin_amdgcn_sched_barrier(0);
            }
        } else {
            int running = 0;
            const unsigned long long ltmask = (1ull << lane) - 1ull;
#pragma unroll
            for (int i = 0; i < 32; ++i) {
                const unsigned long long eq = __ballot(u[i] == T);
                const int pre = running + __popcll(eq & ltmask);
                const bool selb = (u[i] > T) || ((u[i] == T) && (pre < need));
                const unsigned long long bal = __ballot(selb);
                running += __popcll(eq);
                if ((lane >> 1) == i) myword = (lane & 1) ? (unsigned)(bal >> 32) : (unsigned)bal;
                __builtin_amdgcn_sched_barrier(0);
            }
        }
        SEL[(rb + t) * 64 + lane] = myword;
    }
    __syncthreads();
}
__device__ __forceinline__ void p2_select(const Ctx& C, const Args& a) {
    for (int v = C.vcu; v < NB * 16; v += C.G) {
        const int b = v >> 4, p = v & 15;
#pragma unroll 1
        for (int i = 0; i < 8; ++i) { const int j = (i & 1) ? (32 * (i >> 1) + 31 - p) : (32 * (i >> 1) + p); sel_step(C, a, b, j); }
    }
}

struct TileRegs { u32x4 k0, k1, v; };
struct AttnSrc { const bf16_t* Kp; int kpitch; const bf16_t* Kr; const bf16_t* Vp; int vpitch; };
template <int NCH>
__device__ __forceinline__ void tile_load(TileRegs& r, const AttnSrc& s, int key0, int wid, int lane) {
    r.k0 = *(const u32x4*)(s.Kp + (size_t)(key0 + lane) * s.kpitch + wid * 8);
    if (NCH == 12) { if (wid < 4) r.k1 = *(const u32x4*)(s.Kr + (size_t)(key0 + lane) * 32 + wid * 8); }
    r.v = *(const u32x4*)(s.Vp + (size_t)(key0 + 16 * (wid & 3) + (lane >> 2)) * s.vpitch + (wid >> 2) * 32 + (lane & 3) * 8);
}
template <int NCH>
__device__ __forceinline__ void tile_write(const TileRegs& r, LAS unsigned char* kb, LAS unsigned char* vb, int wid, int lane) {
    *(LAS u32x4*)(kb + wid * 1024 + lane * 16) = r.k0;
    if (NCH == 12) { if (wid < 4) *(LAS u32x4*)(kb + (8 + wid) * 1024 + lane * 16) = r.k1; }
    *(LAS u32x4*)(vb + wid * 1024 + lane * 16) = r.v;
}
template <int ND>
__device__ __forceinline__ void qk_tile(f32x16& p0, f32x16& p1, LAS const unsigned char* kb, int cb, const bf16x8* qf, int r32, int hi) {
#pragma unroll
    for (int d0 = 0; d0 < ND; ++d0) {
        const bf16x8 a0 = *(LAS const bf16x8*)(kb + (cb + 2 * d0 + hi) * 1024 + r32 * 16);
        const bf16x8 a1 = *(LAS const bf16x8*)(kb + (cb + 2 * d0 + hi) * 1024 + 512 + r32 * 16);
        p0 = mfma32(a0, qf[d0], p0); p1 = mfma32(a1, qf[d0], p1);
    }
}
__device__ __forceinline__ bf16x8 pack8(const f32x16& p, int base) {
    u32x4 w; w.x = cvtpk(p[base + 0], p[base + 1]); w.y = cvtpk(p[base + 2], p[base + 3]); w.z = cvtpk(p[base + 4], p[base + 5]); w.w = cvtpk(p[base + 6], p[base + 7]);
    return __builtin_bit_cast(bf16x8, w);
}
__device__ __forceinline__ void pv_half(f32x16 (&o)[2], LAS const unsigned char* vb, int lane, int hi, int ks0, bf16x8 pa, bf16x8 pb) {
    LAS const unsigned char* vp = vb + ((lane >> 4) & 1) * 32 + (lane & 3) * 8 + (4 * hi + ((lane & 15) >> 2)) * 64;
#pragma unroll
    for (int d0 = 0; d0 < 2; ++d0) {
#pragma unroll
        for (int k = 0; k < 2; ++k) {
            const v4i16_t lo = vtr(vp + d0 * 4096 + (ks0 + k) * 1024), hh = vtr(vp + d0 * 4096 + (ks0 + k) * 1024 + 512);
            const bf16x8 vf = {lo[0], lo[1], lo[2], lo[3], hh[0], hh[1], hh[2], hh[3]};
            o[d0] = mfma32(vf, k == 0 ? pa : pb, o[d0]);
        }
    }
}
__device__ __forceinline__ void store_gated(const f32x16 (&o)[2], const bf16_t* HB, bf16_t* OB, size_t row, int colg, int hi) {
#pragma unroll
    for (int d0 = 0; d0 < 2; ++d0)
#pragma unroll
        for (int g4 = 0; g4 < 4; ++g4) {
            const int d = 32 * d0 + 8 * g4 + 4 * hi;
            const u32x2 g = *(const u32x2*)(HB + row * NV + V_GATE + colg + d);
            u32x2 w; w.x = cvtpk(o[d0][4 * g4 + 0] * bflo(g.x), o[d0][4 * g4 + 1] * bfhi(g.x)); w.y = cvtpk(o[d0][4 * g4 + 2] * bflo(g.y), o[d0][4 * g4 + 3] * bfhi(g.y));
            *(u32x2*)(OB + row * DM + colg + d) = w;
        }
}

struct SmState { float m, l; f32x16 o[2]; };
__device__ __forceinline__ void sm_update(SmState& st, f32x16& x0, f32x16& x1, LAS const unsigned char* vb, int lane, int hi) {
    float mx = x0[0];
#pragma unroll
    for (int r = 1; r < 16; ++r) mx = fmaxf(mx, x0[r]);
#pragma unroll
    for (int r = 0; r < 16; ++r) mx = fmaxf(mx, x1[r]);
    mx = xhalf_max(mx);
    const float mn = fmaxf(st.m, mx);
    const float ms = (mn == -INFINITY) ? 0.f : mn;
    const float alpha = __builtin_amdgcn_exp2f(st.m - ms);
    float ls = 0.f;
#pragma unroll
    for (int r = 0; r < 16; ++r) { x0[r] = __builtin_amdgcn_exp2f(x0[r] - ms); x1[r] = __builtin_amdgcn_exp2f(x1[r] - ms); ls += x0[r] + x1[r]; }
    st.l = st.l * alpha + ls; st.m = mn;
#pragma unroll
    for (int r = 0; r < 16; ++r) { st.o[0][r] *= alpha; st.o[1][r] *= alpha; }
    pv_half(st.o, vb, lane, hi, 0, pack8(x0, 0), pack8(x0, 8));
    pv_half(st.o, vb, lane, hi, 2, pack8(x1, 0), pack8(x1, 8));
}

template <int MODE>
__device__ __forceinline__ void attn_unit_sm(const Ctx& C, const Args& a, int layer, int b, int h, int qb) {
    constexpr int NCH = (MODE == 3) ? 12 : 8;
    const bf16_t* HB = (const bf16_t*)(a.ws + WS_HB); const bf16_t* MD = (const bf16_t*)(a.ws + WS_MD); const bf16_t* KR = (const bf16_t*)(a.ws + WS_KR);
    bf16_t* OB = (bf16_t*)(a.ws + WS_XB); const unsigned* SEL = (const unsigned*)(a.ws + WS_SEL);
    int lane_op = C.lane; asm volatile("" : "+v"(lane_op));
    const int lane = lane_op, wid = C.wid, r32 = lane & 31, hi = lane >> 5;
    const size_t rb = (size_t)b * SEQ;
    const int q0 = 256 * qb, tq = q0 + 32 * wid + r32;
    const size_t qrow = rb + tq;
    LAS unsigned char* lds = C.lds;
    LAS float* btab = (LAS float*)(lds + AL_BIAS);
    AttnSrc src;
    if (MODE == 1) { src.Kp = HB + rb * NV + V_BK + h * 64; src.kpitch = NV; src.Kr = nullptr; src.Vp = HB + rb * NV + V_BV + h * 64; src.vpitch = NV; }
    if (MODE == 2) { src.Kp = HB + rb * NV + V_CK + h * 64; src.kpitch = NV; src.Kr = nullptr; src.Vp = HB + rb * NV + V_CV + h * 64; src.vpitch = NV; }
    if (MODE == 3) { src.Kp = MD + rb * DM + MD_KN + h * 64; src.kpitch = DM; src.Kr = KR + rb * 32; src.Vp = MD + rb * DM + MD_V + h * 64; src.vpitch = DM; }
    if (MODE != 3) { if (C.tid <= 128) btab[C.tid] = a.rel_bias[t5_bucket(C.tid) * 8 + (MODE == 2 ? 4 : 0) + h] * LOG2E; }
    constexpr int NQ = (MODE == 3) ? 6 : (MODE == 1 ? 1 : 4);
    bf16x8 qf[NQ];
    LAS bf16x8* qlds = (LAS bf16x8*)(lds + AL_Q) + wid * 256 + lane;
    if (MODE == 1) {
#pragma unroll
        for (int d0 = 0; d0 < 4; ++d0) qlds[64 * d0] = *(const bf16x8*)(HB + qrow * NV + V_BQ + h * 64 + 16 * d0 + 8 * hi); }
    if (MODE == 2) {
#pragma unroll
        for (int d0 = 0; d0 < 4; ++d0) qf[d0] = *(const bf16x8*)(HB + qrow * NV + V_CQ + h * 64 + 16 * d0 + 8 * hi); }
    if (MODE == 3) {
#pragma unroll
        for (int d0 = 0; d0 < 4; ++d0) qf[d0] = *(const bf16x8*)(MD + qrow * DM + MD_QN + h * 64 + 16 * d0 + 8 * hi);
#pragma unroll
        for (int d0 = 0; d0 < 2; ++d0) qf[4 + d0] = *(const bf16x8*)(MD + qrow * DM + MD_QR + h * 32 + 16 * d0 + 8 * hi);
        const f32x2_t* rp = (const f32x2_t*)(a.ws + WS_ROPE) + (size_t)tq * 16 + 8 * hi;
        u32x4 w4 = __builtin_bit_cast(u32x4, qf[4]), w5 = __builtin_bit_cast(u32x4, qf[5]);
#pragma unroll
        for (int jj = 0; jj < 4; ++jj) {
            const f32x2_t cs0 = rp[2 * jj], cs1 = rp[2 * jj + 1];
            const float a0 = bflo(w4[jj]), a1 = bfhi(w4[jj]), b0 = bflo(w5[jj]), b1 = bfhi(w5[jj]);
            w4[jj] = cvtpk(a0 * cs0.x - b0 * cs0.y, a1 * cs1.x - b1 * cs1.y);
            w5[jj] = cvtpk(a0 * cs0.y + b0 * cs0.x, a1 * cs1.y + b1 * cs1.x);
        }
        qf[4] = __builtin_bit_cast(bf16x8, w4); qf[5] = __builtin_bit_cast(bf16x8, w5); }
    const float c1 = (MODE == 1 ? 0.17677669529663687f : (MODE == 2 ? 0.125f : 0.10206207261596577f)) * LOG2E;
    SmState s1, s2;
    s1.m = -INFINITY; s1.l = 0.f; s1.o[0] = f32x16{}; s1.o[1] = f32x16{};
    if (MODE == 1) { s2.m = -INFINITY; s2.l = 0.f; s2.o[0] = f32x16{}; s2.o[1] = f32x16{}; }
    const int NT = 4 * (qb + 1), my_last = 4 * qb + (wid >> 1);
    const int tmin = q0 + 32 * wid;
    TileRegs tr;
    tile_load<NCH>(tr, src, 0, wid, lane);
    tile_write<NCH>(tr, lds + AL_K, lds + AL_V, wid, lane);
    __syncthreads();
#pragma unroll 1
    for (int tt = 0; tt < NT; ++tt) {
        const int cur = tt & 1;
        if (tt + 1 < NT) tile_load<NCH>(tr, src, 64 * (tt + 1), wid, lane);
        if (tt <= my_last) {
            LAS const unsigned char* kb = lds + AL_K + cur * AL_KB; LAS const unsigned char* vb = lds + AL_V + cur * AL_VB;
            const int key0 = 64 * tt;
            const bool diag = (tt == my_last);
            const bool farb = (key0 + 63 + 128 <= tmin);
            u32x2 wsel = {0u, 0u};
            if (MODE == 2) wsel = *(const u32x2*)(SEL + qrow * 64 + 2 * tt);
            auto finish_scores = [&](f32x16& p0, f32x16& p1) {
                if (MODE == 3) {
#pragma unroll
                    for (int r = 0; r < 16; ++r) { p0[r] *= c1; p1[r] *= c1; }
                } else if (farb) { const float bc = btab[128];
#pragma unroll
                    for (int r = 0; r < 16; ++r) { p0[r] = fmaf(p0[r], c1, bc); p1[r] = fmaf(p1[r], c1, bc); }
                } else {
#pragma unroll
                    for (int r = 0; r < 16; ++r) { int d0i = tq - (key0 + crow(r, hi)); int d1i = d0i - 32;
                        d0i = d0i < 0 ? 0 : (d0i > 128 ? 128 : d0i); d1i = d1i < 0 ? 0 : (d1i > 128 ? 128 : d1i);
                        p0[r] = fmaf(p0[r], c1, btab[d0i]); p1[r] = fmaf(p1[r], c1, btab[d1i]); }
                }
                if (diag) {
#pragma unroll
                    for (int r = 0; r < 16; ++r) { const int k0i = key0 + crow(r, hi); if (k0i > tq) p0[r] = -INFINITY; if (k0i + 32 > tq) p1[r] = -INFINITY; }
                }
                if (MODE == 2) {
                    const unsigned w0 = wsel.x >> (4 * hi), w1 = wsel.y >> (4 * hi);
#pragma unroll
                    for (int r = 0; r < 16; ++r) { const int bp = (r & 3) + 8 * (r >> 2); if (!((w0 >> bp) & 1u)) p0[r] = -INFINITY; if (!((w1 >> bp) & 1u)) p1[r] = -INFINITY; }
                }
            };
            {
                f32x16 p0 = f32x16{}, p1 = f32x16{};
                if (MODE == 1) { bf16x8 q2[2] = {qlds[0], qlds[64]}; qk_tile<2>(p0, p1, kb, 0, q2, r32, hi); }
                else qk_tile<(MODE == 3 ? 6 : 4)>(p0, p1, kb, 0, qf, r32, hi);
                finish_scores(p0, p1);
                sm_update(s1, p0, p1, vb, lane, hi);
            }
            if (MODE == 1) {
                f32x16 p0 = f32x16{}, p1 = f32x16{};
                bf16x8 q2[2] = {qlds[128], qlds[192]}; qk_tile<2>(p0, p1, kb, 4, q2, r32, hi);
                finish_scores(p0, p1);
                sm_update(s2, p0, p1, vb, lane, hi);
            }
        }
        if (tt + 1 < NT) tile_write<NCH>(tr, lds + AL_K + (cur ^ 1) * AL_KB, lds + AL_V + (cur ^ 1) * AL_VB, wid, lane);
        __syncthreads();
    }
    const float l1 = xhalf_sum(s1.l), il1 = 1.0f / l1;
    if (MODE == 1) {
        const float* dl = a.diff_lambda + layer * 128;
        float a0 = 0.f, a1 = 0.f;
        if (lane < 32) { a0 = dl[lane] * dl[32 + lane]; a1 = dl[64 + lane] * dl[96 + lane]; }
        const float lam_init = (layer == 0) ? 0.2f : 0.35550906779f;
        const float lam = expf(wave_sum(a0)) - expf(wave_sum(a1)) + lam_init;
        const float l2 = xhalf_sum(s2.l), f2 = lam / l2;
        float ss = 0.f;
#pragma unroll
        for (int d0 = 0; d0 < 2; ++d0)
#pragma unroll
            for (int r = 0; r < 16; ++r) { const float v = s1.o[d0][r] * il1 - s2.o[d0][r] * f2; s1.o[d0][r] = v; ss += v * v; }
        ss = xhalf_sum(ss);
        const float rn = (1.0f / sqrtf(ss * (1.0f / 64.0f) + 1e-6f)) * (1.0f - lam_init);
        const float* sg = a.diff_subln + layer * 64;
#pragma unroll
        for (int d0 = 0; d0 < 2; ++d0)
#pragma unroll
            for (int g4 = 0; g4 < 4; ++g4) { const f32x4 gv = *(const f32x4*)(sg + 32 * d0 + 8 * g4 + 4 * hi);
#pragma unroll
                for (int i = 0; i < 4; ++i) s1.o[d0][4 * g4 + i] *= rn * gv[i]; }
    } else {
#pragma unroll
        for (int d0 = 0; d0 < 2; ++d0)
#pragma unroll
            for (int r = 0; r < 16; ++r) s1.o[d0][r] *= il1;
    }
    store_gated(s1.o, HB, OB, qrow, MODE * 256 + h * 64, hi);
}

__device__ __forceinline__ void attn_unit_sb(const Ctx& C, const Args& a, int b, int h, int qb) {
    const bf16_t* HB = (const bf16_t*)(a.ws + WS_HB); bf16_t* OB = (bf16_t*)(a.ws + WS_XB);
    int lane_op = C.lane; asm volatile("" : "+v"(lane_op));
    const int lane = lane_op, wid = C.wid, r32 = lane & 31, hi = lane >> 5;
    const size_t rb = (size_t)b * SEQ;
    const int q0 = 256 * qb, tq = q0 + 32 * wid + r32;
    const size_t qrow = rb + tq;
    LAS unsigned char* lds = C.lds;
    volatile LAS unsigned* flags = (volatile LAS unsigned*)(lds + AL_FLAG);
    AttnSrc src; src.Kp = HB + rb * NV + V_AK + h * 64; src.kpitch = NV; src.Kr = nullptr; src.Vp = HB + rb * NV + V_AV + h * 64; src.vpitch = NV;
    bf16x8 qf[4];
#pragma unroll
    for (int d0 = 0; d0 < 4; ++d0) qf[d0] = *(const bf16x8*)(HB + qrow * NV + V_AQ + h * 64 + 16 * d0 + 8 * hi);
    f32x16 o[2]; o[0] = f32x16{}; o[1] = f32x16{};
    float carry = 0.f;
    const int my_first = 4 * qb + (wid >> 1);
    bool done = false;
    if (C.tid < 3) flags[C.tid] = 0u;
    TileRegs tr;
    int tt = 4 * qb + 3;
    tile_load<8>(tr, src, 64 * tt, wid, lane);
    tile_write<8>(tr, lds + AL_K, lds + AL_V, wid, lane);
    __syncthreads();
    int it = 0;
#pragma unroll 1
    for (;; ++it) {
        const int cur = it & 1, fi = it % 3;
        if (tt > 0) tile_load<8>(tr, src, 64 * (tt - 1), wid, lane);
        if (C.tid == 0) flags[(it + 1) % 3] = 0u;
        if (tt <= my_first && !done) {
            LAS const unsigned char* kb = lds + AL_K + cur * AL_KB; LAS const unsigned char* vb = lds + AL_V + cur * AL_VB;
            f32x16 p0 = f32x16{}, p1 = f32x16{};
            qk_tile<4>(p0, p1, kb, 0, qf, r32, hi);
            const int key0 = 64 * tt;
#pragma unroll
            for (int sub = 1; sub >= 0; --sub) {
                f32x16& p = sub ? p1 : p0;
                float x[16], ls[16];
#pragma unroll
                for (int r = 0; r < 16; ++r) {
                    const float z = p[r] * 0.125f;
                    const float e = __builtin_amdgcn_exp2f(-fabsf(z) * LOG2E);
                    const float sp = fmaxf(z, 0.f) + __builtin_amdgcn_logf(1.0f + e) * LN2;
                    x[r] = -sp;
                    ls[r] = z - sp;
                }
                if (tt == my_first) {
#pragma unroll
                    for (int r = 0; r < 16; ++r) { const bool valid = (key0 + 32 * sub + crow(r, hi)) < tq; x[r] = valid ? x[r] : 0.f; ls[r] = valid ? ls[r] : -INFINITY; __builtin_amdgcn_sched_barrier(0); }
                }
                float ex[16], gs[4];
#pragma unroll
                for (int g = 0; g < 4; ++g) { ex[4 * g + 3] = 0.f; ex[4 * g + 2] = x[4 * g + 3]; ex[4 * g + 1] = ex[4 * g + 2] + x[4 * g + 2]; ex[4 * g + 0] = ex[4 * g + 1] + x[4 * g + 1]; gs[g] = ex[4 * g] + x[4 * g]; }
                float oth[4], pr[4];
#pragma unroll
                for (int g = 0; g < 4; ++g) { oth[g] = xhalf_other(gs[g], hi); pr[g] = gs[g] + oth[g]; }
                float tail[4]; tail[3] = 0.f; tail[2] = pr[3]; tail[1] = pr[3] + pr[2]; tail[0] = tail[1] + pr[1];
                const float total = tail[0] + pr[0];
#pragma unroll
                for (int g = 0; g < 4; ++g) { const float off = carry + tail[g] + (hi == 0 ? oth[g] : 0.f);
#pragma unroll
                    for (int i = 0; i < 4; ++i) p[4 * g + i] = __builtin_amdgcn_exp2f((ls[4 * g + i] + (off + ex[4 * g + i])) * LOG2E); }
                carry += total;
                pv_half(o, vb, lane, hi, 2 * sub, pack8(p, 0), pack8(p, 8));
            }
            done = __all(carry < -104.0f);
        }
        const bool want = (tt > 0) && !((tt <= my_first) && done);
        if (want && lane == 0) flags[fi] = 1u;
        if (tt > 0) tile_write<8>(tr, lds + AL_K + (cur ^ 1) * AL_KB, lds + AL_V + (cur ^ 1) * AL_VB, wid, lane);
        __syncthreads();
        if (flags[fi] == 0u) break;
        --tt;
    }
    store_gated(o, HB, OB, qrow, 0 * 256 + h * 64, hi);
    __syncthreads();
}

__device__ __forceinline__ void p4_attention(const Ctx& C, const Args& a, int layer) {
    const int npair = 3 * NB * 16;
    for (int u = C.vcu; u < npair; u += C.G) {
        const int g = u / (NB * 16), rem = u % (NB * 16), b = rem >> 4, h = (rem >> 2) & 3, p = rem & 3;
#pragma unroll 1
        for (int k = 0; k < 2; ++k) {
            const int qb = k ? 7 - p : p;
            if (g == 0) { if (HAS(9)) attn_unit_sm<1>(C, a, layer, b, h, qb); }
            else if (g == 1) { if (HAS(10)) attn_unit_sm<2>(C, a, layer, b, h, qb); }
            else { if (HAS(11)) attn_unit_sm<3>(C, a, layer, b, h, qb); }
        }
    }
    for (int u = C.vcu; u < NB * 32; u += C.G) { const int b = u >> 5, h = (u >> 3) & 3, qb = u & 7; if (HAS(8)) attn_unit_sb(C, a, b, h, qb); }
}

__device__ __forceinline__ void p6_layernorm(const Ctx& C, const Args& a, int layer) {
    const float* Z = (const float*)(a.ws + WS_HB); bf16_t* XB = (bf16_t*)(a.ws + WS_XB);
    const float* g = a.ln_g + layer * DM; const float* bb = a.ln_b + layer * DM;
    const int gw = C.vcu * NWAVES + C.wid, NGW = C.G * NWAVES, lane = C.lane;
    f32x4 gv[4], bv[4];
#pragma unroll
    for (int j = 0; j < 4; ++j) { gv[j] = *(const f32x4*)(g + 256 * j + 4 * lane); bv[j] = *(const f32x4*)(bb + 256 * j + 4 * lane); }
    for (int m = gw; m < M_TOK; m += NGW) {
        f32x4 v[4]; float s = 0.f;
#pragma unroll
        for (int j = 0; j < 4; ++j) { v[j] = *(const f32x4*)(Z + (size_t)m * DM + 256 * j + 4 * lane); s += (v[j][0] + v[j][1]) + (v[j][2] + v[j][3]); }
        const float mean = wave_sum(s) * (1.0f / DM); float s2 = 0.f;
#pragma unroll
        for (int j = 0; j < 4; ++j) { v[j] = v[j] - mean; s2 += (v[j][0] * v[j][0] + v[j][1] * v[j][1]) + (v[j][2] * v[j][2] + v[j][3] * v[j][3]); }
        const float rstd = 1.0f / sqrtf(wave_sum(s2) * (1.0f / DM) + 1e-5f);
#pragma unroll
        for (int j = 0; j < 4; ++j) { const f32x4 o = v[j] * rstd * gv[j] + bv[j];
            *(f32x4*)(a.out + (size_t)m * DM + 256 * j + 4 * lane) = o;
            if (layer + 1 < DEPTH) { u32x2 w; w.x = cvtpk(o[0], o[1]); w.y = cvtpk(o[2], o[3]); *(u32x2*)(XB + (size_t)m * DM + 256 * j + 4 * lane) = w; } }
    }
}

constexpr int N_PHASES = 1 + 6 * DEPTH;
#define IN(k) (lo <= (k) && (k) < hi)
#define SEAM(k) do { if (IN(k) && IN((k) + 1)) grid.sync(); } while (0)
#define REFRESH() do { int l_op; asm volatile("v_mbcnt_lo_u32_b32 %0, -1, 0\n\tv_mbcnt_hi_u32_b32 %0, -1, %0" : "=v"(l_op)); C.lane = l_op; C.tid = C.wid * 64 + l_op; \
        unsigned char* w_op = a.ws; asm volatile("" : "+s"(w_op)); al.ws = w_op; } while (0)
template <int layer>
__device__ __forceinline__ void layer_body(Ctx& C, const Args& a, Args& al, const int lo, const int hi, cg::grid_group& grid) {
        const int pb = 1 + 6 * layer;
        if (HAS(1) && IN(pb)) {
            REFRESH();
            pg8::Gemm g{(const pg8::bf16_t*)(al.ws + WS_XB), (const pg8::bf16_t*)(al.ws + WS_WIN) + (size_t)layer * NV * DM, M_TOK, NV, DM};
            pg8::StaticOrder S; S.init(M_TOK, NV, C.G, (int)blockIdx.x);
            pg8::EpiMain E{(pg8::bf16_t*)(al.ws + WS_HB), NV, 12};
            pg8::gemm_phase<pg8::EpiMain, pg8::StaticOrder, true, true>(C.lds, g, S, E, C.wid);
        }
        SEAM(pb);
        if (IN(pb + 1)) { if (HAS(2)) { REFRESH(); p2_mla_prep(C, al, layer); } if (HAS(7)) { REFRESH(); p2_select(C, al); } }
        SEAM(pb + 1);
        if (HAS(3) && IN(pb + 2)) {
            REFRESH();
            pg8::Gemm g{(const pg8::bf16_t*)(al.ws + WS_CN), (const pg8::bf16_t*)(al.ws + WS_WMLA) + (size_t)layer * 1024 * 384, M_TOK, 1024, 384};
            pg8::StaticOrder S; S.init(M_TOK, 1024, C.G, (int)blockIdx.x);
            pg8::EpiMain E{(pg8::bf16_t*)(al.ws + WS_MD), DM, 1 << 30};
            pg8::gemm_phase<pg8::EpiMain, pg8::StaticOrder, true, true>(C.lds, g, S, E, C.wid);
        }
        SEAM(pb + 2);
        if (HAS(4) && IN(pb + 3)) { REFRESH(); p4_attention(C, al, layer); }
        SEAM(pb + 3);
        if (HAS(5) && IN(pb + 4)) {
            REFRESH();
            pg8::Gemm g{(const pg8::bf16_t*)(al.ws + WS_XB), (const pg8::bf16_t*)(al.ws + WS_WOUT) + (size_t)layer * DM * DM, M_TOK, DM, DM};
            pg8::StaticOrder S; S.init(M_TOK, DM, C.G, (int)blockIdx.x);
            pg8::EpiOut E{layer == 0 ? al.x : al.out, (float*)(al.ws + WS_HB), ALPHA_RES};
            pg8::gemm_phase<pg8::EpiOut, pg8::StaticOrder, true, true>(C.lds, g, S, E, C.wid);
        }
        SEAM(pb + 4);
        if (HAS(6) && IN(pb + 5)) { REFRESH(); p6_layernorm(C, al, layer); }
        SEAM(pb + 5);
}
__global__ void __launch_bounds__(NTHREADS, 2) mega_fwd(Args a) {
    extern __shared__ __attribute__((aligned(16))) unsigned char lds_raw[];
    cg::grid_group grid = cg::this_grid();
    Ctx C; C.lds = (LAS unsigned char*)lds_raw; C.tid = threadIdx.x; C.lane = C.tid & 63; C.wid = __builtin_amdgcn_readfirstlane(C.tid >> 6);
    C.G = gridDim.x; { const int bx = blockIdx.x; C.vcu = (C.G % 8 == 0) ? (bx % 8) * (C.G / 8) + bx / 8 : bx; }
    const int lo = a.ph_lo, hi = a.ph_hi;
    Args al = a;
    if (HAS(0) && IN(0)) { REFRESH(); p0_prologue(C, al); } SEAM(0);
    layer_body<0>(C, a, al, lo, hi, grid);
    layer_body<1>(C, a, al, lo, hi, grid);
}
#undef IN
#undef SEAM

#if !DIAG
extern "C" void kernel_launch(void* const* d_in, const int* in_sizes, int n_in, void* d_out, int out_size, void* d_ws, size_t ws_size, hipStream_t stream) {
    static int grid = 0;
    if (grid == 0) {
        if (n_in != 12 || in_sizes[0] != M_TOK * DM || out_size != M_TOK * DM || ws_size < WS_END) {
            fprintf(stderr, "kernel_launch: unexpected shapes (n_in %d, x %d, out %d, ws %zu, need %zu); nothing launched\n", n_in, n_in > 0 ? in_sizes[0] : -1, out_size, ws_size, (size_t)WS_END); grid = -1; return; }
        int dev = 0, cus = 0, per_cu = 0;
        (void)hipGetDevice(&dev); (void)hipDeviceGetAttribute(&cus, hipDeviceAttributeMultiprocessorCount, dev);
        if (hipFuncSetAttribute((const void*)mega_fwd, hipFuncAttributeMaxDynamicSharedMemorySize, LDS_BYTES) != hipSuccess) { fprintf(stderr, "kernel_launch: hipFuncSetAttribute failed\n"); grid = -1; return; }
        if (hipOccupancyMaxActiveBlocksPerMultiprocessor(&per_cu, (const void*)mega_fwd, NTHREADS, LDS_BYTES) != hipSuccess || per_cu < 1) { fprintf(stderr, "kernel_launch: occupancy query says %d blocks per CU\n", per_cu); per_cu = 1; }
        (void)hipGetLastError();
        grid = cus;
    }
    if (grid < 0) return;
    Args a{};
    a.x = (const float*)d_in[0]; a.w_in = (const float*)d_in[1]; a.w_out = (const float*)d_in[2]; a.ln_g = (const float*)d_in[3]; a.ln_b = (const float*)d_in[4];
    a.rel_bias = (const float*)d_in[5]; a.diff_lambda = (const float*)d_in[6]; a.diff_subln = (const float*)d_in[7]; a.mla_q_norm = (const float*)d_in[8];
    a.mla_kv_norm = (const float*)d_in[9]; a.mla_w_uq = (const float*)d_in[10]; a.mla_w_ukv = (const float*)d_in[11];
    a.out = (float*)d_out; a.ws = (unsigned char*)d_ws; a.ph_lo = 0; a.ph_hi = N_PHASES;
    void* args[] = {&a};
    const hipError_t e = hipLaunchCooperativeKernel((const void*)mega_fwd, dim3(grid), dim3(NTHREADS), args, LDS_BYTES, stream);
    if (e != hipSuccess) fprintf(stderr, "kernel_launch: cooperative launch failed: %s (grid %d)\n", hipGetErrorString(e), grid);
}
#endif
```

```cpp
#include <hip/hip_runtime.h>
#include <hip/hip_cooperative_groups.h>
#include <hip/hip_bf16.h>
#include <cstdio>
#include <cstdint>
#include <cmath>
namespace cg = cooperative_groups;

#ifndef NBATCH
#define NBATCH 16
#endif
#ifndef DIAG
#define DIAG 0
#endif

#ifndef PH_MASK
#define PH_MASK 0xFFFF
#endif
#define HAS(k) (((PH_MASK) >> (k)) & 1)

constexpr int NB = NBATCH, SEQ = 2048, DM = 1024, M_TOK = NB * SEQ, DEPTH = 2;
constexpr int D_IN = 4040, NV = 4096;
constexpr int V_AQ = 0, V_AK = 256, V_AV = 512, V_BQ = 768, V_BK = 1024, V_BV = 1280, V_CQ = 1536, V_CK = 1792, V_CV = 2048,
              V_CIQ = 2304, V_DCQ = 2560, V_DCKV = 2816, V_DKR = 2944, V_CIK = 2976, V_CIW = 3008, V_GATE = 3072;
constexpr int MD_QN = 0, MD_QR = 256, MD_KN = 512, MD_V = 768;
constexpr float ALPHA_RES = 1.4142135623730951f;
constexpr float LOG2E = 1.4426950408889634f, LN2 = 0.6931471805599453f;

__host__ __device__ __forceinline__ int src_col(int v) {
    if (v < 2560) return v;
    if (v < 2816) return 2600 + (v - 2560);
    if (v < 2944) return 2856 + (v - 2816);
    if (v < 2976) return 2984 + (v - 2944);
    if (v < 3008) return 2560 + (v - 2976);
    if (v < 3016) return 2592 + (v - 3008);
    if (v < 3072) return -1;
    return 3016 + (v - 3072);
}

constexpr size_t MiB = 1u << 20;
constexpr size_t WS_CTL = 0;
constexpr size_t WS_ROPE = 512 * 1024;
constexpr size_t WS_WIN = 1 * MiB;
constexpr size_t WS_WOUT = WS_WIN + 2 * (size_t)NV * DM * 2;
constexpr size_t WS_WMLA = WS_WOUT + 2 * (size_t)DM * DM * 2;
constexpr size_t WS_XB = WS_WMLA + 2 * MiB;
constexpr size_t WS_HB = WS_XB + (size_t)M_TOK * DM * 2;
constexpr size_t WS_CN = WS_HB + (size_t)M_TOK * NV * 2;
constexpr size_t WS_KR = WS_CN + (size_t)M_TOK * 384 * 2;
constexpr size_t WS_MD = WS_KR + (size_t)M_TOK * 32 * 2;
constexpr size_t WS_SEL = WS_MD + (size_t)M_TOK * DM * 2;
constexpr size_t WS_END = WS_SEL + (size_t)M_TOK * 64 * 4;

#define LAS __attribute__((address_space(3)))
typedef unsigned short bf16_t;
typedef short bf16x8 __attribute__((ext_vector_type(8)));
typedef float f32x4 __attribute__((ext_vector_type(4)));
typedef float f32x16 __attribute__((ext_vector_type(16)));
typedef unsigned u32x4 __attribute__((ext_vector_type(4)));
typedef unsigned u32x2 __attribute__((ext_vector_type(2)));
typedef float f32x2_t __attribute__((ext_vector_type(2)));
typedef __bf16 bf16x2_t __attribute__((ext_vector_type(2)));
__device__ __forceinline__ unsigned cvtpk(float lo, float hi) { f32x2_t v = {lo, hi}; bf16x2_t b = __builtin_convertvector(v, bf16x2_t); return __builtin_bit_cast(unsigned, b); }
__device__ __forceinline__ float bf2f(unsigned short h) { return __uint_as_float((unsigned)h << 16); }
__device__ __forceinline__ float bflo(unsigned w) { return __uint_as_float(w << 16); }
__device__ __forceinline__ float bfhi(unsigned w) { return __uint_as_float(w & 0xffff0000u); }
__device__ __forceinline__ float wave_sum(float v) {
#pragma unroll
    for (int o = 1; o < 64; o <<= 1) v += __shfl_xor(v, o);
    return v;
}
namespace pg8 {
#define PG8_LAS __attribute__((address_space(3)))
typedef unsigned short bf16_t;
typedef short bf16x8 __attribute__((ext_vector_type(8)));
typedef float f32x4 __attribute__((ext_vector_type(4)));
typedef unsigned u32x4 __attribute__((ext_vector_type(4)));
constexpr int BM = 256, BK = 64, HALF = 128, HTB = HALF * BK * 2  , STAGE_BYTES = 8 * HTB, NXCD = 8, WGM = 8;

__host__ __device__ __forceinline__ int lds_byte(int r, int c) { const int st = (r >> 4) * 2 + (c >> 5), rr = r & 15, cc = c & 31, ob = rr * 64 + cc * 2; return st * 1024 + (ob ^ (((ob >> 9) & 1) << 5)); }
__host__ __device__ __forceinline__ void stage_rc(int b, int& R, int& C) { const int st = b / 1024, sb = b % 1024, swz = sb ^ (((sb >> 9) & 1) << 5); R = (st >> 1) * 16 + swz / 64; C = (st & 1) * 32 + (swz % 64) / 2; }
__host__ __device__ __forceinline__ int perm32(int rho) { const int n = rho >> 4, i = rho & 15; return 8 * (i >> 2) + 4 * n + (i & 3); }

struct Unit { int pm, pn; };
struct Gemm { const bf16_t* A; const bf16_t* Bt; int M, N, K; };

struct StaticOrder {
    int nM, nN, nwg, G, c;
    __host__ __device__ void init(int M, int N, int G_, int c_) { nM = M / BM; nN = N / BM; nwg = nM * nN; G = G_; c = c_; }
    __host__ __device__ bool next(int i, Unit& u) const {
        const long L = (long)i * G + c; if (L >= nwg) return false;
        int wgid = (int)L; { const int q = nwg / NXCD, r = nwg % NXCD, xcd = wgid % NXCD, off = wgid / NXCD; wgid = (xcd < r ? xcd * (q + 1) : r * (q + 1) + (xcd - r) * q) + off; }
        const int nig = WGM * nN, gid = wgid / nig, fm = gid * WGM, gsz = (nM - fm) < WGM ? (nM - fm) : WGM;
        u.pm = fm + ((wgid % nig) % gsz); u.pn = (wgid % nig) / gsz; return true;
    }
    __device__ __forceinline__ void a_ready(const Unit&) const {}
    __device__ __forceinline__ void done(const Unit&) const {}
};


__device__ __forceinline__ float silu_f(float v) { return v * __builtin_amdgcn_rcpf(1.0f + __builtin_amdgcn_exp2f(-v * 1.4426950408889634f)); }

struct EpiMain {
    static constexpr bool PERM = true, AFTER_DRAIN = false;
    bf16_t* O; int ldc; int gate_from;
    __device__ __forceinline__ void operator()(const f32x4 (&acc)[2][2][4][2], const Unit& u, int wr, int wc, int fr, int fq) const {
        const int row0 = u.pm * BM + wr * 64 + fr, col0 = u.pn * BM + wc * 32 + 8 * fq;
        const bool gate = u.pn >= gate_from;
#pragma unroll
        for (int ai = 0; ai < 2; ++ai)
#pragma unroll
            for (int m = 0; m < 4; ++m) { bf16_t* rowp = O + (size_t)(row0 + ai * HALF + m * 16) * ldc + col0;
#pragma unroll
                for (int bj = 0; bj < 2; ++bj) { f32x4 v0 = acc[ai][bj][m][0], v1 = acc[ai][bj][m][1];
                    if (gate) {
#pragma unroll
                        for (int j = 0; j < 4; ++j) { v0[j] = silu_f(v0[j]); v1[j] = silu_f(v1[j]); } }
                    u32x4 w; w.x = ::cvtpk(v0[0], v0[1]); w.y = ::cvtpk(v0[2], v0[3]); w.z = ::cvtpk(v1[0], v1[1]); w.w = ::cvtpk(v1[2], v1[3]);
                    *(u32x4*)(rowp + bj * HALF) = w; } }
    }
};
struct EpiOut {
    static constexpr bool PERM = false, AFTER_DRAIN = false;
    const float* xres; float* Z; float alpha;
    __device__ __forceinline__ void operator()(const f32x4 (&acc)[2][2][4][2], const Unit& u, int wr, int wc, int fr, int fq) const {
        const int row0 = u.pm * BM + wr * 64 + fr, col0 = u.pn * BM + wc * 32 + 4 * fq;
#pragma unroll
        for (int ai = 0; ai < 2; ++ai)
#pragma unroll
            for (int m = 0; m < 4; ++m) { const size_t off = (size_t)(row0 + ai * HALF + m * 16) * 1024 + col0;
#pragma unroll
                for (int bj = 0; bj < 2; ++bj)
#pragma unroll
                    for (int n = 0; n < 2; ++n) { const f32x4 xr = *(const f32x4*)(xres + off + bj * HALF + n * 16);
                        *(f32x4*)(Z + off + bj * HALF + n * 16) = xr * alpha + acc[ai][bj][m][n]; } }
    }
};
template <class Epi, class Sched, bool ALIGN_EPI = false, bool SP2 = false>
__device__ __forceinline__ void gemm_phase(PG8_LAS unsigned char* lds, const Gemm g, const Sched& S, const Epi& E, int wid_in) {
    int tid_op = wid_in * 64 + (int)__builtin_amdgcn_mbcnt_hi(~0u, __builtin_amdgcn_mbcnt_lo(~0u, 0u)); asm volatile("" : "+v"(tid_op));
    const int tid = tid_op, wid = __builtin_amdgcn_readfirstlane(tid >> 6), lane = tid & 63, wr = wid >> 2, wc = wid & 3, fr = lane & 15, fq = lane >> 4;
    const int K = g.K, nt = K / BK;
    unsigned voffA[2], voffB[2];
#pragma unroll
    for (int i = 0; i < 2; ++i) { int R, C; stage_rc(tid * 16 + i * 8192, R, C); const int Rb = Epi::PERM ? ((R & ~31) + perm32(R & 31)) : R;
        voffA[i] = (unsigned)(R * K + C) * 2u; voffB[i] = (unsigned)(Rb * K + C) * 2u; }
    const size_t kstep = (size_t)(BK * 2);
    const size_t hstep = (size_t)HALF * K * 2;
    const size_t tstep = 2 * hstep;
    const unsigned ldsw = (unsigned)wid * 1024u;
    const int aoff = lds_byte(wr * 64 + fr, fq * 8), boff = lds_byte(wc * 32 + fr, fq * 8);
#define PG8_SA(b, h) (((b) * 2 + (h)) * HTB)
#define PG8_SB(b, h) ((4 + (b) * 2 + (h)) * HTB)
#define PG8_STAGE(bufoff, gbase, voff) do { _Pragma("unroll") for (int _i = 0; _i < 2; ++_i) \
        __builtin_amdgcn_global_load_lds((const unsigned*)((const char*)(gbase) + (voff)[_i]), (PG8_LAS unsigned*)(lds + (bufoff) + ldsw + _i * 8192), 16, 0, 0); } while (0)
#define PG8_LDA(dst, b, h) do { _Pragma("unroll") for (int m = 0; m < 4; ++m) _Pragma("unroll") for (int k = 0; k < 2; ++k) dst[m][k] = *(const PG8_LAS bf16x8*)(lds + PG8_SA(b, h) + aoff + m * 2048 + k * 1024); } while (0)
#define PG8_LDB(dst, b, h) do { _Pragma("unroll") for (int n = 0; n < 2; ++n) _Pragma("unroll") for (int k = 0; k < 2; ++k) dst[n][k] = *(const PG8_LAS bf16x8*)(lds + PG8_SB(b, h) + boff + n * 2048 + k * 1024); } while (0)
#define PG8_MMA(ai, bj, At, Bt) do { __builtin_amdgcn_s_setprio(1); _Pragma("unroll") for (int m = 0; m < 4; ++m) _Pragma("unroll") for (int n = 0; n < 2; ++n) _Pragma("unroll") for (int k = 0; k < 2; ++k) \
        acc[ai][bj][m][n] = __builtin_amdgcn_mfma_f32_16x16x32_bf16(Bt[n][k], At[m][k], acc[ai][bj][m][n], 0, 0, 0); __builtin_amdgcn_s_setprio(0); } while (0)
#define PG8_WAIT_V(n) asm volatile("s_waitcnt vmcnt(" #n ")" ::: "memory")
#define PG8_WAIT_L(n) asm volatile("s_waitcnt lgkmcnt(" #n ")" ::: "memory")
#define PG8_BAR __builtin_amdgcn_s_barrier()
#define PG8_SCHED __builtin_amdgcn_sched_barrier(0)
    Unit cur, nxt; int ui = 0;
    if (!S.next(0, cur)) return;
    f32x4 acc[2][2][4][2];
#pragma unroll
    for (int a = 0; a < 2; ++a)
#pragma unroll
        for (int b = 0; b < 2; ++b)
#pragma unroll
            for (int m = 0; m < 4; ++m)
#pragma unroll
                for (int n = 0; n < 2; ++n) acc[a][b][m][n] = (f32x4){0.f, 0.f, 0.f, 0.f};
    bf16x8 At[4][2], B0[2][2], B1[2][2];
    const char* cA = (const char*)g.A + (size_t)cur.pm * tstep; const char* cB = (const char*)g.Bt + (size_t)cur.pn * tstep;
    S.a_ready(cur);
    if constexpr (SP2) {
        PG8_STAGE(PG8_SB(0, 0), cB, voffB); PG8_STAGE(PG8_SB(0, 1), cB + hstep, voffB); PG8_STAGE(PG8_SA(0, 0), cA, voffA); PG8_STAGE(PG8_SA(0, 1), cA + hstep, voffA);
        if (wr == 1) PG8_BAR;
        PG8_WAIT_V(2); PG8_BAR;
        PG8_STAGE(PG8_SB(1, 0), cB + kstep, voffB); PG8_STAGE(PG8_SA(1, 0), cA + kstep, voffA); PG8_STAGE(PG8_SB(1, 1), cB + hstep + kstep, voffB);
        PG8_WAIT_V(6); PG8_BAR;
    } else {
        PG8_STAGE(PG8_SB(0, 0), cB, voffB); PG8_STAGE(PG8_SA(0, 0), cA, voffA); PG8_STAGE(PG8_SB(0, 1), cB + hstep, voffB); PG8_STAGE(PG8_SA(0, 1), cA + hstep, voffA);
        if (wr == 1) PG8_BAR;
        PG8_WAIT_V(4); PG8_BAR;
        PG8_STAGE(PG8_SB(1, 0), cB + kstep, voffB); PG8_STAGE(PG8_SA(1, 0), cA + kstep, voffA); PG8_STAGE(PG8_SB(1, 1), cB + hstep + kstep, voffB);
        PG8_WAIT_V(6); PG8_BAR;
    }
    for (;;) {
        const bool has_next = S.next(ui + 1, nxt);
        const char* nA = has_next ? (const char*)g.A + (size_t)nxt.pm * tstep : cA; const char* nB = has_next ? (const char*)g.Bt + (size_t)nxt.pn * tstep : cB;
#pragma unroll 1
        for (int t = 0; t < nt; t += 2) {
            const bool last = (t == nt - 2);
            const char* a1 = cA + (size_t)(t + 1) * kstep;
            const char* a2 = last ? nA : cA + (size_t)(t + 2) * kstep; const char* b2 = last ? nB : cB + (size_t)(t + 2) * kstep;
            const char* a3 = a2 + kstep; const char* b3 = b2 + kstep;
            if (last && has_next) S.a_ready(nxt);
            if constexpr (SP2) {
            PG8_LDB(B0, 0, 0); PG8_LDB(B1, 0, 1); PG8_SCHED; PG8_LDA(At, 0, 0); PG8_STAGE(PG8_SA(1, 1), a1 + hstep, voffA);
            PG8_WAIT_V(8); PG8_WAIT_L(0); PG8_BAR; PG8_MMA(0, 0, At, B0); PG8_MMA(0, 1, At, B1); PG8_BAR; PG8_SCHED;
            PG8_LDA(At, 0, 1); PG8_STAGE(PG8_SB(0, 0), b2, voffB); PG8_STAGE(PG8_SB(0, 1), b2 + hstep, voffB); PG8_STAGE(PG8_SA(0, 0), a2, voffA);
            PG8_WAIT_V(8); PG8_WAIT_L(0); PG8_BAR; PG8_MMA(1, 0, At, B0); PG8_MMA(1, 1, At, B1); PG8_BAR; PG8_SCHED;
            PG8_LDB(B0, 1, 0); PG8_LDB(B1, 1, 1); PG8_SCHED; PG8_LDA(At, 1, 0); PG8_STAGE(PG8_SA(0, 1), a2 + hstep, voffA);
            PG8_WAIT_V(8); PG8_WAIT_L(0); PG8_BAR; PG8_MMA(0, 0, At, B0); PG8_MMA(0, 1, At, B1); PG8_BAR; PG8_SCHED;
            PG8_LDA(At, 1, 1); PG8_STAGE(PG8_SB(1, 0), b3, voffB); PG8_STAGE(PG8_SB(1, 1), b3 + hstep, voffB); PG8_STAGE(PG8_SA(1, 0), a3, voffA);
            PG8_WAIT_V(8); PG8_WAIT_L(0); PG8_BAR; PG8_MMA(1, 0, At, B0); PG8_MMA(1, 1, At, B1); PG8_BAR; PG8_SCHED;
            } else {
            PG8_LDB(B0, 0, 0); PG8_SCHED; PG8_LDA(At, 0, 0); PG8_STAGE(PG8_SA(1, 1), a1 + hstep, voffA);
            PG8_WAIT_L(8); PG8_BAR; PG8_WAIT_L(0); PG8_MMA(0, 0, At, B0); PG8_BAR; PG8_SCHED;
            PG8_LDB(B1, 0, 1); PG8_STAGE(PG8_SB(0, 0), b2, voffB);
            PG8_BAR; PG8_WAIT_L(0); PG8_MMA(0, 1, At, B1); PG8_BAR;
            PG8_LDA(At, 0, 1); PG8_STAGE(PG8_SA(0, 0), a2, voffA);
            PG8_BAR; PG8_WAIT_L(0); PG8_MMA(1, 0, At, B0); PG8_BAR; PG8_SCHED;
            PG8_STAGE(PG8_SB(0, 1), b2 + hstep, voffB);
            PG8_WAIT_V(6); PG8_BAR; PG8_MMA(1, 1, At, B1); PG8_BAR;
            PG8_LDB(B0, 1, 0); PG8_SCHED; PG8_LDA(At, 1, 0); PG8_STAGE(PG8_SA(0, 1), a2 + hstep, voffA);
            PG8_WAIT_L(8); PG8_BAR; PG8_WAIT_L(0); PG8_MMA(0, 0, At, B0); PG8_BAR; PG8_SCHED;
            PG8_LDB(B1, 1, 1); PG8_STAGE(PG8_SB(1, 0), b3, voffB);
            PG8_BAR; PG8_WAIT_L(0); PG8_MMA(0, 1, At, B1); PG8_BAR;
            PG8_LDA(At, 1, 1); PG8_STAGE(PG8_SA(1, 0), a3, voffA);
            PG8_BAR; PG8_WAIT_L(0); PG8_MMA(1, 0, At, B0); PG8_BAR; PG8_SCHED;
            PG8_STAGE(PG8_SB(1, 1), b3 + hstep, voffB);
            PG8_WAIT_V(6); PG8_BAR; PG8_MMA(1, 1, At, B1); PG8_BAR;
            }
        }
        if constexpr (ALIGN_EPI) { if (wr == 0) PG8_BAR; }
        if constexpr (!Epi::AFTER_DRAIN) { E(acc, cur, wr, wc, fr, fq); S.done(cur); }
        if (!has_next) break;
#pragma unroll
        for (int a = 0; a < 2; ++a)
#pragma unroll
            for (int b = 0; b < 2; ++b)
#pragma unroll
                for (int m = 0; m < 4; ++m)
#pragma unroll
                    for (int n = 0; n < 2; ++n) acc[a][b][m][n] = (f32x4){0.f, 0.f, 0.f, 0.f};
        cur = nxt; cA = nA; cB = nB; ++ui;
        if constexpr (ALIGN_EPI) { if (wr == 1) PG8_BAR; }
    }
    PG8_WAIT_V(0);
    if constexpr (!ALIGN_EPI) { if (wr == 0) PG8_BAR; }
    PG8_BAR;
    if constexpr (Epi::AFTER_DRAIN) { E.fused(acc, cur, wr, wc, fr, fq, lds, wid, lane); S.done(cur); }
#undef PG8_SA
#undef PG8_SB
#undef PG8_STAGE
#undef PG8_LDA
#undef PG8_LDB
#undef PG8_MMA
#undef PG8_WAIT_V
#undef PG8_WAIT_L
#undef PG8_BAR
#undef PG8_SCHED
}
}

constexpr int NWAVES = 8, NTHREADS = 512;
constexpr int LDS_BYTES = 147456;
constexpr int SEL_RS = 2052;
constexpr int LDS_CTL = 16 * SEL_RS * 4;
constexpr int AL_K = 0, AL_KB = 12288, AL_V = 2 * AL_KB, AL_VB = 8192, AL_BIAS = AL_V + 2 * AL_VB, AL_FLAG = AL_BIAS + 1024, AL_Q = AL_FLAG + 1024;

struct Args {
    const float* x; const float* w_in; const float* w_out; const float* ln_g; const float* ln_b; const float* rel_bias; const float* diff_lambda;
    const float* diff_subln; const float* mla_q_norm; const float* mla_kv_norm; const float* mla_w_uq; const float* mla_w_ukv;
    float* out; unsigned char* ws; int ph_lo, ph_hi;
};

struct Ctx {
    LAS unsigned char* lds; int tid, lane, wid, vcu, G;
};

__device__ __forceinline__ f32x16 mfma32(bf16x8 a, bf16x8 b, f32x16 c) { return __builtin_amdgcn_mfma_f32_32x32x16_bf16(a, b, c, 0, 0, 0); }
__device__ __forceinline__ f32x4 mfma16(bf16x8 a, bf16x8 b, f32x4 c) { return __builtin_amdgcn_mfma_f32_16x16x32_bf16(a, b, c, 0, 0, 0); }
typedef short v4i16_t __attribute__((ext_vector_type(4)));
__device__ __forceinline__ v4i16_t vtr(LAS const unsigned char* p) { return __builtin_amdgcn_ds_read_tr16_b64_v4i16((LAS v4i16_t*)p); }
__device__ __forceinline__ float xhalf_sum(float v) { auto rr = __builtin_amdgcn_permlane32_swap(__float_as_uint(v), __float_as_uint(v), false, false); return __uint_as_float(rr[0]) + __uint_as_float(rr[1]); }
__device__ __forceinline__ float xhalf_max(float v) { auto rr = __builtin_amdgcn_permlane32_swap(__float_as_uint(v), __float_as_uint(v), false, false); return fmaxf(__uint_as_float(rr[0]), __uint_as_float(rr[1])); }
__device__ __forceinline__ float xhalf_other(float v, int hi) { auto rr = __builtin_amdgcn_permlane32_swap(__float_as_uint(v), __float_as_uint(v), false, false); return __uint_as_float(hi ? rr[0] : rr[1]); }
__device__ __forceinline__ int crow(int r, int hi) { return (r & 3) + 8 * (r >> 2) + 4 * hi; }

__device__ __forceinline__ int t5_bucket(int n) {
    if (n < 16) return n;
    int large = 16 + (int)(logf((float)n / 16.0f) / 2.0794415416798357f * 16.0f);
    return large < 31 ? large : 31;
}

template <int MAP>
__device__ __forceinline__ void p0_transpose_item(const float* W, int K, int N, bf16_t* WT, LAS float* scr, int item, int nblk, int lane) {
    const int kb = item / nblk, nb = item % nblk, k0 = 64 * kb, n0 = 32 * nb;
    const int v = n0 + (lane & 31);
    const int sc = MAP ? src_col(v) : v;
#pragma unroll 8
    for (int i = 0; i < 32; ++i) { const int kk = 2 * i + (lane >> 5); scr[kk * 33 + (lane & 31)] = (sc >= 0) ? W[(size_t)(k0 + kk) * N + sc] : 0.f; }
    asm volatile("s_waitcnt lgkmcnt(0)" ::: "memory");
    const int c = lane & 7;
#pragma unroll
    for (int j = 0; j < 4; ++j) { const int n = (lane >> 3) + 8 * j; const LAS float* s = scr + (8 * c) * 33 + n;
        u32x4 o; o.x = cvtpk(s[0 * 33], s[1 * 33]); o.y = cvtpk(s[2 * 33], s[3 * 33]); o.z = cvtpk(s[4 * 33], s[5 * 33]); o.w = cvtpk(s[6 * 33], s[7 * 33]);
        *(u32x4*)(WT + (size_t)(n0 + n) * K + k0 + 8 * c) = o; }
    asm volatile("s_waitcnt lgkmcnt(0)" ::: "memory");
}
__device__ __forceinline__ void p0_prologue(const Ctx& C, const Args& a) {
    unsigned char* ws = a.ws;
    LAS float* scr = (LAS float*)(C.lds + C.wid * 16384);
    const int gw = C.vcu * NWAVES + C.wid, NGW = C.G * NWAVES;
    constexpr int I_IN = (DM / 64) * (NV / 32), I_OUT = (DM / 64) * (DM / 32);
    for (int it = gw; it < 2 * I_IN + 2 * I_OUT; it += NGW) {
        int r = it;
        if (r < 2 * I_IN) { const int l = r / I_IN; r -= l * I_IN;
            p0_transpose_item<1>(a.w_in + (size_t)l * DM * D_IN, DM, D_IN, (bf16_t*)(ws + WS_WIN) + (size_t)l * NV * DM, scr, r, NV / 32, C.lane); continue; }
        r -= 2 * I_IN; { const int l = r / I_OUT; r -= l * I_OUT;
            p0_transpose_item<0>(a.w_out + (size_t)l * DM * DM, DM, DM, (bf16_t*)(ws + WS_WOUT) + (size_t)l * DM * DM, scr, r, DM / 32, C.lane); }
    }
    const int gt = C.vcu * NTHREADS + C.tid, NGT = C.G * NTHREADS;
    for (int e = gt; e < 2 * 1024 * 384; e += NGT) {
        const int l = e / (1024 * 384), rem = e % (1024 * 384), r = rem / 384, k = rem % 384;
        float v = 0.f;
        if (r < 256) { if (k < 256) v = a.mla_w_uq[(size_t)l * 256 * 384 + (size_t)k * 384 + (r >> 6) * 96 + (r & 63)]; }
        else if (r < 384) { if (k < 256) v = a.mla_w_uq[(size_t)l * 256 * 384 + (size_t)k * 384 + ((r - 256) >> 5) * 96 + 64 + ((r - 256) & 31)]; }
        else if (r < 512) { }
        else if (r < 768) { if (k >= 256) v = a.mla_w_ukv[(size_t)l * 128 * 512 + (size_t)(k - 256) * 512 + ((r - 512) >> 6) * 128 + ((r - 512) & 63)]; }
        else { if (k >= 256) v = a.mla_w_ukv[(size_t)l * 128 * 512 + (size_t)(k - 256) * 512 + ((r - 768) >> 6) * 128 + 64 + ((r - 768) & 63)]; }
        ((bf16_t*)(ws + WS_WMLA))[e] = (bf16_t)(cvtpk(v, 0.f) & 0xffffu);
    }
    for (int e = gt; e < SEQ * 16; e += NGT) {
        const int t = e >> 4, i = e & 15;
        const float ang = (float)t * powf(10000.0f, -(float)i / 16.0f);
        ((float*)(ws + WS_ROPE))[2 * e] = cosf(ang); ((float*)(ws + WS_ROPE))[2 * e + 1] = sinf(ang);
    }
    for (size_t e = gt; e < (size_t)M_TOK * DM / 8; e += NGT) {
        const f32x4 v0 = *(const f32x4*)(a.x + e * 8), v1 = *(const f32x4*)(a.x + e * 8 + 4);
        u32x4 o; o.x = cvtpk(v0[0], v0[1]); o.y = cvtpk(v0[2], v0[3]); o.z = cvtpk(v1[0], v1[1]); o.w = cvtpk(v1[2], v1[3]);
        *(u32x4*)((bf16_t*)(ws + WS_XB) + e * 8) = o;
    }
}

__device__ __forceinline__ void p2_mla_prep(const Ctx& C, const Args& a, int layer) {
    const bf16_t* HB = (const bf16_t*)(a.ws + WS_HB); bf16_t* CN = (bf16_t*)(a.ws + WS_CN); bf16_t* KR = (bf16_t*)(a.ws + WS_KR);
    const float* rope = (const float*)(a.ws + WS_ROPE);
    const float* gq = a.mla_q_norm + layer * 256; const float* gkv = a.mla_kv_norm + layer * 128;
    const int gw = C.vcu * NWAVES + C.wid, NGW = C.G * NWAVES, lane = C.lane;
    const f32x4 g4 = *(const f32x4*)(gq + 4 * lane); const float g20 = gkv[2 * lane], g21 = gkv[2 * lane + 1];
    for (int m = gw; m < M_TOK; m += NGW) {
        const bf16_t* hr = HB + (size_t)m * NV;
        const u32x2 q = *(const u32x2*)(hr + V_DCQ + 4 * lane);
        const unsigned kv = *(const unsigned*)(hr + V_DCKV + 2 * lane);
        const float q0 = bflo(q.x), q1 = bfhi(q.x), q2 = bflo(q.y), q3 = bfhi(q.y), k0 = bflo(kv), k1 = bfhi(kv);
        const float sq = wave_sum((q0 * q0 + q1 * q1) + (q2 * q2 + q3 * q3)), sk = wave_sum(k0 * k0 + k1 * k1);
        const float rq = 1.0f / sqrtf(sq * (1.0f / 256.0f) + 1e-6f), rk = 1.0f / sqrtf(sk * (1.0f / 128.0f) + 1e-6f);
        u32x2 oq; oq.x = cvtpk(q0 * rq * g4[0], q1 * rq * g4[1]); oq.y = cvtpk(q2 * rq * g4[2], q3 * rq * g4[3]);
        *(u32x2*)(CN + (size_t)m * 384 + 4 * lane) = oq;
        *(unsigned*)(CN + (size_t)m * 384 + 256 + 2 * lane) = cvtpk(k0 * rk * g20, k1 * rk * g21);
        if (lane < 16) {
            const float x1 = bf2f(hr[V_DKR + lane]), x2 = bf2f(hr[V_DKR + 16 + lane]);
            const float c = rope[((m & (SEQ - 1)) * 16 + lane) * 2], s = rope[((m & (SEQ - 1)) * 16 + lane) * 2 + 1];
            KR[(size_t)m * 32 + lane] = (bf16_t)(cvtpk(x1 * c - x2 * s, 0.f) & 0xffffu);
            KR[(size_t)m * 32 + 16 + lane] = (bf16_t)(cvtpk(x1 * s + x2 * c, 0.f) & 0xffffu);
        }
    }
}

__device__ __forceinline__ void sel_step(const Ctx& C, const Args& a, int b, int j) {
    const bf16_t* HB = (const bf16_t*)(a.ws + WS_HB); unsigned* SEL = (unsigned*)(a.ws + WS_SEL);
    LAS float* sc_lds = (LAS float*)C.lds;
    int lane_op = C.lane; asm volatile("" : "+v"(lane_op));
    const int lane = lane_op, wid = C.wid, t0 = 16 * j;
    const size_t rb = (size_t)b * SEQ;
    if (t0 + 15 < 256) {
#pragma unroll
        for (int rr = 0; rr < 2; ++rr) SEL[(rb + t0 + 2 * wid + rr) * 64 + lane] = 0xFFFFFFFFu;
        return;
    }
    const int nkt = j + 1;
    {
        const int q = lane & 15, kq = lane >> 4;
        const bf16_t* qrow = HB + (rb + t0 + q) * NV;
        bf16x8 bq[8];
#pragma unroll
        for (int h = 0; h < 8; ++h) bq[h] = *(const bf16x8*)(qrow + V_CIQ + h * 32 + 8 * kq);
        const u32x4 wv = *(const u32x4*)(qrow + V_CIW);
        float w[8]; const float wsc = 0.35355339059327373f * 0.17677669529663687f;
        w[0] = bflo(wv.x) * wsc; w[1] = bfhi(wv.x) * wsc; w[2] = bflo(wv.y) * wsc; w[3] = bfhi(wv.y) * wsc;
        w[4] = bflo(wv.z) * wsc; w[5] = bfhi(wv.z) * wsc; w[6] = bflo(wv.w) * wsc; w[7] = bfhi(wv.w) * wsc;
        for (int kt = wid; kt < nkt; kt += 8) {
            const bf16x8 ak = *(const bf16x8*)(HB + (rb + 16 * kt + q) * NV + V_CIK + 8 * kq);
            f32x4 s = {0.f, 0.f, 0.f, 0.f};
#pragma unroll
            for (int h = 0; h < 8; ++h) { const f32x4 d = mfma16(ak, bq[h], (f32x4){0.f, 0.f, 0.f, 0.f});
#pragma unroll
                for (int i = 0; i < 4; ++i) s[i] = fmaf(w[h], fmaxf(d[i], 0.f), s[i]); }
            *(LAS f32x4*)(sc_lds + q * SEL_RS + 16 * kt + 4 * kq) = s;
        }
    }
    __syncthreads();
#pragma unroll 1
    for (int rr = 0; rr < 2; ++rr) {
        const int q = 2 * wid + rr, t = t0 + q;
        unsigned u[32];
#pragma unroll
        for (int i = 0; i < 32; ++i) { const int key = lane + 64 * i; unsigned v = 0u;
            if (key <= t) { const unsigned bits = __float_as_uint(sc_lds[q * SEL_RS + key] + 0.0f); v = (bits & 0x80000000u) ? ~bits : (bits | 0x80000000u); }
            u[i] = v; }
        unsigned T = 0u; int cge = 2048; bool exact = false;
#pragma unroll 1
        for (int bit = 31; bit >= 0; --bit) {
            const unsigned cand = T | (1u << bit);
            int c = 0;
#pragma unroll
            for (int i = 0; i < 32; ++i) c += __popcll(__ballot(u[i] >= cand));
            if (c >= 256) { T = cand; cge = c; if (c == 256) { exact = true; break; } }
        }
        unsigned myword = 0u;
        if (exact) {
#pragma unroll
            for (int i = 0; i < 32; ++i) {
                const unsigned long long bal = __ballot(u[i] >= T);
                if ((lane >> 1) == i) myword = (lane & 1) ? (unsigned)(bal >> 32) : (unsigned)bal;
                __builtin_amdgcn_sched_barrier(0);
            }
        } else {
            int cgt = 0;
#pragma unroll
            for (int i = 0; i < 32; ++i) cgt += __popcll(__ballot(u[i] > T));
            const int need = 256 - cgt;
            int running = 0;
            const unsigned long long ltmask = (1ull << lane) - 1ull;
#pragma unroll
            for (int i = 0; i < 32; ++i) {
                const unsigned long long eq = __ballot(u[i] == T);
                const int pre = running + __popcll(eq & ltmask);
                const bool selb = (u[i] > T) || ((u[i] == T) && (pre < need));
                const unsigned long long bal = __ballot(selb);
                running += __popcll(eq);
                if ((lane >> 1) == i) myword = (lane & 1) ? (unsigned)(bal >> 32) : (unsigned)bal;
                __builtin_amdgcn_sched_barrier(0);
            }
        }
        (void)cge;
        SEL[(rb + t) * 64 + lane] = myword;
    }
    __syncthreads();
}
__device__ __forceinline__ void p2_select(const Ctx& C, const Args& a) {
    for (int v = C.vcu; v < NB * 16; v += C.G) {
        const int b = v >> 4, p = v & 15;
#pragma unroll 1
        for (int i = 0; i < 8; ++i) { const int j = (i & 1) ? (32 * (i >> 1) + 31 - p) : (32 * (i >> 1) + p); sel_step(C, a, b, j); }
    }
}

struct TileRegs { u32x4 k0, k1, v; };
struct AttnSrc { const bf16_t* Kp; int kpitch; const bf16_t* Kr; const bf16_t* Vp; int vpitch; };
template <int NCH>
__device__ __forceinline__ void tile_load(TileRegs& r, const AttnSrc& s, int key0, int wid, int lane) {
    r.k0 = *(const u32x4*)(s.Kp + (size_t)(key0 + lane) * s.kpitch + wid * 8);
    if (NCH == 12) { if (wid < 4) r.k1 = *(const u32x4*)(s.Kr + (size_t)(key0 + lane) * 32 + wid * 8); }
    r.v = *(const u32x4*)(s.Vp + (size_t)(key0 + 16 * (wid & 3) + (lane >> 2)) * s.vpitch + (wid >> 2) * 32 + (lane & 3) * 8);
}
template <int NCH>
__device__ __forceinline__ void tile_write(const TileRegs& r, LAS unsigned char* kb, LAS unsigned char* vb, int wid, int lane) {
    *(LAS u32x4*)(kb + wid * 1024 + lane * 16) = r.k0;
    if (NCH == 12) { if (wid < 4) *(LAS u32x4*)(kb + (8 + wid) * 1024 + lane * 16) = r.k1; }
    *(LAS u32x4*)(vb + wid * 1024 + lane * 16) = r.v;
}
template <int ND>
__device__ __forceinline__ void qk_tile(f32x16& p0, f32x16& p1, LAS const unsigned char* kb, int cb, const bf16x8* qf, int r32, int hi) {
#pragma unroll
    for (int d0 = 0; d0 < ND; ++d0) {
        const bf16x8 a0 = *(LAS const bf16x8*)(kb + (cb + 2 * d0 + hi) * 1024 + r32 * 16);
        const bf16x8 a1 = *(LAS const bf16x8*)(kb + (cb + 2 * d0 + hi) * 1024 + 512 + r32 * 16);
        p0 = mfma32(a0, qf[d0], p0); p1 = mfma32(a1, qf[d0], p1);
    }
}
__device__ __forceinline__ bf16x8 pack8(const f32x16& p, int base) {
    u32x4 w; w.x = cvtpk(p[base + 0], p[base + 1]); w.y = cvtpk(p[base + 2], p[base + 3]); w.z = cvtpk(p[base + 4], p[base + 5]); w.w = cvtpk(p[base + 6], p[base + 7]);
    return __builtin_bit_cast(bf16x8, w);
}
__device__ __forceinline__ void pv_half(f32x16 (&o)[2], LAS const unsigned char* vb, int lane, int hi, int ks0, bf16x8 pa, bf16x8 pb) {
    LAS const unsigned char* vp = vb + ((lane >> 4) & 1) * 32 + (lane & 3) * 8 + (4 * hi + ((lane & 15) >> 2)) * 64;
#pragma unroll
    for (int d0 = 0; d0 < 2; ++d0) {
#pragma unroll
        for (int k = 0; k < 2; ++k) {
            const v4i16_t lo = vtr(vp + d0 * 4096 + (ks0 + k) * 1024), hh = vtr(vp + d0 * 4096 + (ks0 + k) * 1024 + 512);
            const bf16x8 vf = {lo[0], lo[1], lo[2], lo[3], hh[0], hh[1], hh[2], hh[3]};
            o[d0] = mfma32(vf, k == 0 ? pa : pb, o[d0]);
        }
    }
}
__device__ __forceinline__ void store_gated(const f32x16 (&o)[2], const bf16_t* HB, bf16_t* OB, size_t row, int colg, int hi) {
#pragma unroll
    for (int d0 = 0; d0 < 2; ++d0)
#pragma unroll
        for (int g4 = 0; g4 < 4; ++g4) {
            const int d = 32 * d0 + 8 * g4 + 4 * hi;
            const u32x2 g = *(const u32x2*)(HB + row * NV + V_GATE + colg + d);
            u32x2 w; w.x = cvtpk(o[d0][4 * g4 + 0] * bflo(g.x), o[d0][4 * g4 + 1] * bfhi(g.x)); w.y = cvtpk(o[d0][4 * g4 + 2] * bflo(g.y), o[d0][4 * g4 + 3] * bfhi(g.y));
            *(u32x2*)(OB + row * DM + colg + d) = w;
        }
}

struct SmState { float m, l; f32x16 o[2]; };
__device__ __forceinline__ void sm_update(SmState& st, f32x16& x0, f32x16& x1, LAS const unsigned char* vb, int lane, int hi) {
    float mx = x0[0];
#pragma unroll
    for (int r = 1; r < 16; ++r) mx = fmaxf(mx, x0[r]);
#pragma unroll
    for (int r = 0; r < 16; ++r) mx = fmaxf(mx, x1[r]);
    mx = xhalf_max(mx);
    const float mn = fmaxf(st.m, mx);
    const float ms = (mn == -INFINITY) ? 0.f : mn;
    const float alpha = __builtin_amdgcn_exp2f(st.m - ms);
    float ls = 0.f;
#pragma unroll
    for (int r = 0; r < 16; ++r) { x0[r] = __builtin_amdgcn_exp2f(x0[r] - ms); x1[r] = __builtin_amdgcn_exp2f(x1[r] - ms); ls += x0[r] + x1[r]; }
    st.l = st.l * alpha + ls; st.m = mn;
#pragma unroll
    for (int r = 0; r < 16; ++r) { st.o[0][r] *= alpha; st.o[1][r] *= alpha; }
    pv_half(st.o, vb, lane, hi, 0, pack8(x0, 0), pack8(x0, 8));
    pv_half(st.o, vb, lane, hi, 2, pack8(x1, 0), pack8(x1, 8));
}

template <int MODE>
__device__ __forceinline__ void attn_unit_sm(const Ctx& C, const Args& a, int layer, int b, int h, int qb) {
    constexpr int NCH = (MODE == 3) ? 12 : 8;
    const bf16_t* HB = (const bf16_t*)(a.ws + WS_HB); const bf16_t* MD = (const bf16_t*)(a.ws + WS_MD); const bf16_t* KR = (const bf16_t*)(a.ws + WS_KR);
    bf16_t* OB = (bf16_t*)(a.ws + WS_XB); const unsigned* SEL = (const unsigned*)(a.ws + WS_SEL);
    int lane_op = C.lane; asm volatile("" : "+v"(lane_op));
    const int lane = lane_op, wid = C.wid, r32 = lane & 31, hi = lane >> 5;
    const size_t rb = (size_t)b * SEQ;
    const int q0 = 256 * qb, tq = q0 + 32 * wid + r32;
    const size_t qrow = rb + tq;
    LAS unsigned char* lds = C.lds;
    LAS float* btab = (LAS float*)(lds + AL_BIAS);
    AttnSrc src;
    if (MODE == 1) { src.Kp = HB + rb * NV + V_BK + h * 64; src.kpitch = NV; src.Kr = nullptr; src.Vp = HB + rb * NV + V_BV + h * 64; src.vpitch = NV; }
    if (MODE == 2) { src.Kp = HB + rb * NV + V_CK + h * 64; src.kpitch = NV; src.Kr = nullptr; src.Vp = HB + rb * NV + V_CV + h * 64; src.vpitch = NV; }
    if (MODE == 3) { src.Kp = MD + rb * DM + MD_KN + h * 64; src.kpitch = DM; src.Kr = KR + rb * 32; src.Vp = MD + rb * DM + MD_V + h * 64; src.vpitch = DM; }
    if (MODE != 3) { if (C.tid <= 128) btab[C.tid] = a.rel_bias[t5_bucket(C.tid) * 8 + (MODE == 2 ? 4 : 0) + h] * LOG2E; }
    constexpr int NQ = (MODE == 3) ? 6 : (MODE == 1 ? 1 : 4);
    bf16x8 qf[NQ];
    LAS bf16x8* qlds = (LAS bf16x8*)(lds + AL_Q) + wid * 256 + lane;
    if (MODE == 1) {
#pragma unroll
        for (int d0 = 0; d0 < 4; ++d0) qlds[64 * d0] = *(const bf16x8*)(HB + qrow * NV + V_BQ + h * 64 + 16 * d0 + 8 * hi); }
    if (MODE == 2) {
#pragma unroll
        for (int d0 = 0; d0 < 4; ++d0) qf[d0] = *(const bf16x8*)(HB + qrow * NV + V_CQ + h * 64 + 16 * d0 + 8 * hi); }
    if (MODE == 3) {
#pragma unroll
        for (int d0 = 0; d0 < 4; ++d0) qf[d0] = *(const bf16x8*)(MD + qrow * DM + MD_QN + h * 64 + 16 * d0 + 8 * hi);
#pragma unroll
        for (int d0 = 0; d0 < 2; ++d0) qf[4 + d0] = *(const bf16x8*)(MD + qrow * DM + MD_QR + h * 32 + 16 * d0 + 8 * hi);
        const f32x2_t* rp = (const f32x2_t*)(a.ws + WS_ROPE) + (size_t)tq * 16 + 8 * hi;
        u32x4 w4 = __builtin_bit_cast(u32x4, qf[4]), w5 = __builtin_bit_cast(u32x4, qf[5]);
#pragma unroll
        for (int jj = 0; jj < 4; ++jj) {
            const f32x2_t cs0 = rp[2 * jj], cs1 = rp[2 * jj + 1];
            const float a0 = bflo(w4[jj]), a1 = bfhi(w4[jj]), b0 = bflo(w5[jj]), b1 = bfhi(w5[jj]);
            w4[jj] = cvtpk(a0 * cs0.x - b0 * cs0.y, a1 * cs1.x - b1 * cs1.y);
            w5[jj] = cvtpk(a0 * cs0.y + b0 * cs0.x, a1 * cs1.y + b1 * cs1.x);
        }
        qf[4] = __builtin_bit_cast(bf16x8, w4); qf[5] = __builtin_bit_cast(bf16x8, w5); }
    const float c1 = (MODE == 1 ? 0.17677669529663687f : (MODE == 2 ? 0.125f : 0.10206207261596577f)) * LOG2E;
    SmState s1, s2;
    s1.m = -INFINITY; s1.l = 0.f; s1.o[0] = f32x16{}; s1.o[1] = f32x16{};
    if (MODE == 1) { s2.m = -INFINITY; s2.l = 0.f; s2.o[0] = f32x16{}; s2.o[1] = f32x16{}; }
    const int NT = 4 * (qb + 1), my_last = 4 * qb + (wid >> 1);
    const int tmin = q0 + 32 * wid;
    TileRegs tr;
    tile_load<NCH>(tr, src, 0, wid, lane);
    tile_write<NCH>(tr, lds + AL_K, lds + AL_V, wid, lane);
    __syncthreads();
#pragma unroll 1
    for (int tt = 0; tt < NT; ++tt) {
        const int cur = tt & 1;
        if (tt + 1 < NT) tile_load<NCH>(tr, src, 64 * (tt + 1), wid, lane);
        if (tt <= my_last) {
            LAS const unsigned char* kb = lds + AL_K + cur * AL_KB; LAS const unsigned char* vb = lds + AL_V + cur * AL_VB;
            const int key0 = 64 * tt;
            const bool diag = (tt == my_last);
            const bool farb = (key0 + 63 + 128 <= tmin);
            u32x2 wsel = {0u, 0u};
            if (MODE == 2) wsel = *(const u32x2*)(SEL + qrow * 64 + 2 * tt);
            auto finish_scores = [&](f32x16& p0, f32x16& p1) {
                if (MODE == 3) {
#pragma unroll
                    for (int r = 0; r < 16; ++r) { p0[r] *= c1; p1[r] *= c1; }
                } else if (farb) { const float bc = btab[128];
#pragma unroll
                    for (int r = 0; r < 16; ++r) { p0[r] = fmaf(p0[r], c1, bc); p1[r] = fmaf(p1[r], c1, bc); }
                } else {
#pragma unroll
                    for (int r = 0; r < 16; ++r) { int d0i = tq - (key0 + crow(r, hi)); int d1i = d0i - 32;
                        d0i = d0i < 0 ? 0 : (d0i > 128 ? 128 : d0i); d1i = d1i < 0 ? 0 : (d1i > 128 ? 128 : d1i);
                        p0[r] = fmaf(p0[r], c1, btab[d0i]); p1[r] = fmaf(p1[r], c1, btab[d1i]); }
                }
                if (diag) {
#pragma unroll
                    for (int r = 0; r < 16; ++r) { const int k0i = key0 + crow(r, hi); if (k0i > tq) p0[r] = -INFINITY; if (k0i + 32 > tq) p1[r] = -INFINITY; }
                }
                if (MODE == 2) {
                    const unsigned w0 = wsel.x >> (4 * hi), w1 = wsel.y >> (4 * hi);
#pragma unroll
                    for (int r = 0; r < 16; ++r) { const int bp = (r & 3) + 8 * (r >> 2); if (!((w0 >> bp) & 1u)) p0[r] = -INFINITY; if (!((w1 >> bp) & 1u)) p1[r] = -INFINITY; }
                }
            };
            {
                f32x16 p0 = f32x16{}, p1 = f32x16{};
                if (MODE == 1) { bf16x8 q2[2] = {qlds[0], qlds[64]}; qk_tile<2>(p0, p1, kb, 0, q2, r32, hi); }
                else qk_tile<(MODE == 3 ? 6 : 4)>(p0, p1, kb, 0, qf, r32, hi);
                finish_scores(p0, p1);
                sm_update(s1, p0, p1, vb, lane, hi);
            }
            if (MODE == 1) {
                f32x16 p0 = f32x16{}, p1 = f32x16{};
                bf16x8 q2[2] = {qlds[128], qlds[192]}; qk_tile<2>(p0, p1, kb, 4, q2, r32, hi);
                finish_scores(p0, p1);
                sm_update(s2, p0, p1, vb, lane, hi);
            }
        }
        if (tt + 1 < NT) tile_write<NCH>(tr, lds + AL_K + (cur ^ 1) * AL_KB, lds + AL_V + (cur ^ 1) * AL_VB, wid, lane);
        __syncthreads();
    }
    const float l1 = xhalf_sum(s1.l), il1 = 1.0f / l1;
    if (MODE == 1) {
        const float* dl = a.diff_lambda + layer * 128;
        float a0 = 0.f, a1 = 0.f;
        if (lane < 32) { a0 = dl[lane] * dl[32 + lane]; a1 = dl[64 + lane] * dl[96 + lane]; }
        const float lam_init = (layer == 0) ? 0.2f : 0.35550906779f;
        const float lam = expf(wave_sum(a0)) - expf(wave_sum(a1)) + lam_init;
        const float l2 = xhalf_sum(s2.l), f2 = lam / l2;
        float ss = 0.f;
#pragma unroll
        for (int d0 = 0; d0 < 2; ++d0)
#pragma unroll
            for (int r = 0; r < 16; ++r) { const float v = s1.o[d0][r] * il1 - s2.o[d0][r] * f2; s1.o[d0][r] = v; ss += v * v; }
        ss = xhalf_sum(ss);
        const float rn = (1.0f / sqrtf(ss * (1.0f / 64.0f) + 1e-6f)) * (1.0f - lam_init);
        const float* sg = a.diff_subln + layer * 64;
#pragma unroll
        for (int d0 = 0; d0 < 2; ++d0)
#pragma unroll
            for (int g4 = 0; g4 < 4; ++g4) { const f32x4 gv = *(const f32x4*)(sg + 32 * d0 + 8 * g4 + 4 * hi);
#pragma unroll
                for (int i = 0; i < 4; ++i) s1.o[d0][4 * g4 + i] *= rn * gv[i]; }
    } else {
#pragma unroll
        for (int d0 = 0; d0 < 2; ++d0)
#pragma unroll
            for (int r = 0; r < 16; ++r) s1.o[d0][r] *= il1;
    }
    store_gated(s1.o, HB, OB, qrow, MODE * 256 + h * 64, hi);
}

__device__ __forceinline__ void attn_unit_sb(const Ctx& C, const Args& a, int b, int h, int qb) {
    const bf16_t* HB = (const bf16_t*)(a.ws + WS_HB); bf16_t* OB = (bf16_t*)(a.ws + WS_XB);
    int lane_op = C.lane; asm volatile("" : "+v"(lane_op));
    const int lane = lane_op, wid = C.wid, r32 = lane & 31, hi = lane >> 5;
    const size_t rb = (size_t)b * SEQ;
    const int q0 = 256 * qb, tq = q0 + 32 * wid + r32;
    const size_t qrow = rb + tq;
    LAS unsigned char* lds = C.lds;
    volatile LAS unsigned* flags = (volatile LAS unsigned*)(lds + AL_FLAG);
    AttnSrc src; src.Kp = HB + rb * NV + V_AK + h * 64; src.kpitch = NV; src.Kr = nullptr; src.Vp = HB + rb * NV + V_AV + h * 64; src.vpitch = NV;
    bf16x8 qf[4];
#pragma unroll
    for (int d0 = 0; d0 < 4; ++d0) qf[d0] = *(const bf16x8*)(HB + qrow * NV + V_AQ + h * 64 + 16 * d0 + 8 * hi);
    f32x16 o[2]; o[0] = f32x16{}; o[1] = f32x16{};
    float carry = 0.f;
    const int my_first = 4 * qb + (wid >> 1);
    bool done = false;
    if (C.tid < 3) flags[C.tid] = 0u;
    TileRegs tr;
    int tt = 4 * qb + 3;
    tile_load<8>(tr, src, 64 * tt, wid, lane);
    tile_write<8>(tr, lds + AL_K, lds + AL_V, wid, lane);
    __syncthreads();
    int it = 0;
#pragma unroll 1
    for (;; ++it) {
        const int cur = it & 1, fi = it % 3;
        if (tt > 0) tile_load<8>(tr, src, 64 * (tt - 1), wid, lane);
        if (C.tid == 0) flags[(it + 1) % 3] = 0u;
        if (tt <= my_first && !done) {
            LAS const unsigned char* kb = lds + AL_K + cur * AL_KB; LAS const unsigned char* vb = lds + AL_V + cur * AL_VB;
            f32x16 p0 = f32x16{}, p1 = f32x16{};
            qk_tile<4>(p0, p1, kb, 0, qf, r32, hi);
            const int key0 = 64 * tt;
#pragma unroll
            for (int sub = 1; sub >= 0; --sub) {
                f32x16& p = sub ? p1 : p0;
                float x[16], ls[16];
#pragma unroll
                for (int r = 0; r < 16; ++r) {
                    const float z = p[r] * 0.125f;
                    const float e = __builtin_amdgcn_exp2f(-fabsf(z) * LOG2E);
                    const float sp = fmaxf(z, 0.f) + __builtin_amdgcn_logf(1.0f + e) * LN2;
                    x[r] = -sp;
                    ls[r] = z - sp;
                }
                if (tt == my_first) {
#pragma unroll
                    for (int r = 0; r < 16; ++r) { const bool valid = (key0 + 32 * sub + crow(r, hi)) < tq; x[r] = valid ? x[r] : 0.f; ls[r] = valid ? ls[r] : -INFINITY; __builtin_amdgcn_sched_barrier(0); }
                }
                float ex[16], gs[4];
#pragma unroll
                for (int g = 0; g < 4; ++g) { ex[4 * g + 3] = 0.f; ex[4 * g + 2] = x[4 * g + 3]; ex[4 * g + 1] = ex[4 * g + 2] + x[4 * g + 2]; ex[4 * g + 0] = ex[4 * g + 1] + x[4 * g + 1]; gs[g] = ex[4 * g] + x[4 * g]; }
                float oth[4], pr[4];
#pragma unroll
                for (int g = 0; g < 4; ++g) { oth[g] = xhalf_other(gs[g], hi); pr[g] = gs[g] + oth[g]; }
                float tail[4]; tail[3] = 0.f; tail[2] = pr[3]; tail[1] = pr[3] + pr[2]; tail[0] = tail[1] + pr[1];
                const float total = tail[0] + pr[0];
#pragma unroll
                for (int g = 0; g < 4; ++g) { const float off = carry + tail[g] + (hi == 0 ? oth[g] : 0.f);
#pragma unroll
                    for (int i = 0; i < 4; ++i) p[4 * g + i] = __builtin_amdgcn_exp2f((ls[4 * g + i] + (off + ex[4 * g + i])) * LOG2E); }
                carry += total;
                pv_half(o, vb, lane, hi, 2 * sub, pack8(p, 0), pack8(p, 8));
            }
            done = __all(carry < -104.0f);
        }
        const bool want = (tt > 0) && !((tt <= my_first) && done);
        if (want && lane == 0) flags[fi] = 1u;
        if (tt > 0) tile_write<8>(tr, lds + AL_K + (cur ^ 1) * AL_KB, lds + AL_V + (cur ^ 1) * AL_VB, wid, lane);
        __syncthreads();
        if (flags[fi] == 0u) break;
        --tt;
    }
    store_gated(o, HB, OB, qrow, 0 * 256 + h * 64, hi);
    __syncthreads();
}

__device__ __forceinline__ void p4_attention(const Ctx& C, const Args& a, int layer) {
    const int npair = 3 * NB * 16;
    for (int u = C.vcu; u < npair; u += C.G) {
        const int g = u / (NB * 16), rem = u % (NB * 16), b = rem >> 4, h = (rem >> 2) & 3, p = rem & 3;
#pragma unroll 1
        for (int k = 0; k < 2; ++k) {
            const int qb = k ? 7 - p : p;
            if (g == 0) { if (HAS(9)) attn_unit_sm<1>(C, a, layer, b, h, qb); }
            else if (g == 1) { if (HAS(10)) attn_unit_sm<2>(C, a, layer, b, h, qb); }
            else { if (HAS(11)) attn_unit_sm<3>(C, a, layer, b, h, qb); }
        }
    }
    for (int u = C.vcu; u < NB * 32; u += C.G) { const int b = u >> 5, h = (u >> 3) & 3, qb = u & 7; if (HAS(8)) attn_unit_sb(C, a, b, h, qb); }
}

__device__ __forceinline__ void p6_layernorm(const Ctx& C, const Args& a, int layer) {
    const float* Z = (const float*)(a.ws + WS_HB); bf16_t* XB = (bf16_t*)(a.ws + WS_XB);
    const float* g = a.ln_g + layer * DM; const float* bb = a.ln_b + layer * DM;
    const int gw = C.vcu * NWAVES + C.wid, NGW = C.G * NWAVES, lane = C.lane;
    f32x4 gv[4], bv[4];
#pragma unroll
    for (int j = 0; j < 4; ++j) { gv[j] = *(const f32x4*)(g + 256 * j + 4 * lane); bv[j] = *(const f32x4*)(bb + 256 * j + 4 * lane); }
    for (int m = gw; m < M_TOK; m += NGW) {
        f32x4 v[4]; float s = 0.f;
#pragma unroll
        for (int j = 0; j < 4; ++j) { v[j] = *(const f32x4*)(Z + (size_t)m * DM + 256 * j + 4 * lane); s += (v[j][0] + v[j][1]) + (v[j][2] + v[j][3]); }
        const float mean = wave_sum(s) * (1.0f / DM); float s2 = 0.f;
#pragma unroll
        for (int j = 0; j < 4; ++j) { v[j] = v[j] - mean; s2 += (v[j][0] * v[j][0] + v[j][1] * v[j][1]) + (v[j][2] * v[j][2] + v[j][3] * v[j][3]); }
        const float rstd = 1.0f / sqrtf(wave_sum(s2) * (1.0f / DM) + 1e-5f);
#pragma unroll
        for (int j = 0; j < 4; ++j) { const f32x4 o = v[j] * rstd * gv[j] + bv[j];
            *(f32x4*)(a.out + (size_t)m * DM + 256 * j + 4 * lane) = o;
            if (layer + 1 < DEPTH) { u32x2 w; w.x = cvtpk(o[0], o[1]); w.y = cvtpk(o[2], o[3]); *(u32x2*)(XB + (size_t)m * DM + 256 * j + 4 * lane) = w; } }
    }
}

#define RLX_AGENT __ATOMIC_RELAXED, __HIP_MEMORY_SCOPE_AGENT
#define XB_TMO      128
#define XB_XCNT(j)  (256  + 64 * (j))
#define XB_XSUB(j)  (1280 + 64 * (j))
#define XB_XGEN(j)  (2304 + 64 * (j))
#define XB_TOP      3328
#define XB_TOPGEN   3392
#define XCD_BAR_WORDS 3456
#define XB_SPIN_CAP (1u << 18)

__device__ __forceinline__ unsigned xb_ld(unsigned* p)              { return __hip_atomic_load(p, __ATOMIC_RELAXED, __HIP_MEMORY_SCOPE_AGENT); }
__device__ __forceinline__ unsigned xb_add(unsigned* p, unsigned v) { return __hip_atomic_fetch_add(p, v, __ATOMIC_RELAXED, __HIP_MEMORY_SCOPE_AGENT); }
__device__ __forceinline__ unsigned xb_xcc_id() { return (unsigned)__builtin_amdgcn_s_getreg((3 << 11) | 20) & 0xFu; }
#define XB_SPIN(cond, bar) do { unsigned _sp = 0; while (cond) { __builtin_amdgcn_s_sleep(1); \
    if ((++_sp & 255u) == 0u) { if (xb_ld(&(bar)[XB_TMO])) break; if (_sp > XB_SPIN_CAP) { atomicAdd(&(bar)[XB_TMO], 1u); break; } } } } while (0)

struct XcdBarrier {
    unsigned* bar; unsigned x;
    volatile LAS unsigned* st;
};

__device__ __forceinline__ XcdBarrier xcd_barrier_post(unsigned* bar, volatile LAS unsigned* st, bool leader) {
    XcdBarrier b; b.bar = bar; b.x = xb_xcc_id(); b.st = st;
    if (leader) (void)xb_add(&bar[XB_XCNT(b.x)], 1u);
    return b;
}
__device__ __forceinline__ void xcd_barrier_complete(unsigned* bar, unsigned x, unsigned& nloc, unsigned& nx) {
    const unsigned G = gridDim.x * gridDim.y * gridDim.z;
    unsigned sum, cnt, mine, sp = 0u;
    for (;;) {
        sum = 0u; cnt = 0u; mine = 0u;
#pragma unroll
        for (unsigned j = 0; j < 16; ++j) { const unsigned c = xb_ld(&bar[XB_XCNT(j)]); sum += c; cnt += (c > 0u) ? 1u : 0u; mine = (j == x) ? c : mine; }
        if (sum == G) break;
        __builtin_amdgcn_s_sleep(1);
        if ((++sp & 255u) == 0u) { if (xb_ld(&bar[XB_TMO])) break; if (sp > XB_SPIN_CAP) { atomicAdd(&bar[XB_TMO], 1u); break; } }
    }
    nloc = mine > 0u ? mine : 1u; nx = cnt > 0u ? cnt : 1u;
}

__device__ __forceinline__ void xcd_barrier(const XcdBarrier& b, bool leader) {
    asm volatile("s_waitcnt vmcnt(0)" ::: "memory");
    __syncthreads();
    if (leader) {
        unsigned* bar = b.bar;
        __builtin_amdgcn_s_waitcnt(0);
        unsigned nloc = b.st[0], nx = b.st[1];
        if (nloc == 0u) { xcd_barrier_complete(bar, b.x, nloc, nx); b.st[0] = nloc; b.st[1] = nx; }
        const unsigned old = xb_add(&bar[XB_XSUB(b.x)], 1u);
        const unsigned gen = old / nloc;
        if (old + 1u == (gen + 1u) * nloc) {
            __builtin_amdgcn_fence(__ATOMIC_RELEASE, "agent");
            asm volatile("s_waitcnt vmcnt(0)" ::: "memory");
            const unsigned og = xb_add(&bar[XB_TOP], 1u);
            const unsigned tg = og / nx;
            if (og + 1u == (tg + 1u) * nx) xb_add(&bar[XB_TOPGEN], 1u);
            else XB_SPIN(xb_ld(&bar[XB_TOPGEN]) == tg, bar);
            __builtin_amdgcn_fence(__ATOMIC_ACQUIRE, "agent");
            xb_add(&bar[XB_XGEN(b.x)], 1u);
            asm volatile("s_waitcnt vmcnt(0)" ::: "memory");
        } else {
            XB_SPIN(xb_ld(&bar[XB_XGEN(b.x)]) == gen, bar);
            __builtin_amdgcn_fence(__ATOMIC_ACQUIRE, "agent");
            asm volatile("s_waitcnt vmcnt(0)" ::: "memory");
        }
    }
    __syncthreads();
}

constexpr int N_PHASES = 1 + 6 * DEPTH;
#ifndef REP_PH
#define REP_PH -1
#endif
#define NREP(k) ((REP_PH) == (k) ? 2 : 1)
#define IN(k) (lo <= (k) && (k) < hi)
#if DIAG
#define SEAM(k) do { } while (0)
#else
#define SEAM(k) do { if (IN(k) && IN((k) + 1)) { if ((k) == 0) grid.sync(); else { xcd_barrier(bar, C.wid == 0 && C.lane == 0); if (REP_PH == 8) xcd_barrier(bar, C.wid == 0 && C.lane == 0); } } } while (0)
#endif
#define REFRESH() do { int l_op; asm volatile("v_mbcnt_lo_u32_b32 %0, -1, 0\n\tv_mbcnt_hi_u32_b32 %0, -1, %0" : "=v"(l_op)); C.lane = l_op; C.tid = C.wid * 64 + l_op; \
        unsigned char* w_op = a.ws; asm volatile("" : "+s"(w_op)); al.ws = w_op; } while (0)
template <int layer>
__device__ __forceinline__ void layer_body(Ctx& C, const Args& a, Args& al, const int lo, const int hi, cg::grid_group& grid, const XcdBarrier& bar) {
        const int pb = 1 + 6 * layer;
        for (int rep = 0; rep < NREP(1); ++rep) if (HAS(1) && IN(pb)) {
            REFRESH();
            pg8::Gemm g{(const pg8::bf16_t*)(al.ws + WS_XB), (const pg8::bf16_t*)(al.ws + WS_WIN) + (size_t)layer * NV * DM, M_TOK, NV, DM};
            pg8::StaticOrder S; S.init(M_TOK, NV, C.G, (int)blockIdx.x);
            pg8::EpiMain E{(pg8::bf16_t*)(al.ws + WS_HB), NV, 12};
            pg8::gemm_phase<pg8::EpiMain, pg8::StaticOrder, true, true>(C.lds, g, S, E, C.wid);
        }
        SEAM(pb);
        if (IN(pb + 1)) { for (int rep = 0; rep < NREP(2); ++rep) if (HAS(2)) { REFRESH(); p2_mla_prep(C, al, layer); } for (int rep = 0; rep < NREP(7); ++rep) if (HAS(7)) { REFRESH(); p2_select(C, al); } }
        SEAM(pb + 1);
        for (int rep = 0; rep < NREP(3); ++rep) if (HAS(3) && IN(pb + 2)) {
            REFRESH();
            pg8::Gemm g{(const pg8::bf16_t*)(al.ws + WS_CN), (const pg8::bf16_t*)(al.ws + WS_WMLA) + (size_t)layer * 1024 * 384, M_TOK, 1024, 384};
            pg8::StaticOrder S; S.init(M_TOK, 1024, C.G, (int)blockIdx.x);
            pg8::EpiMain E{(pg8::bf16_t*)(al.ws + WS_MD), DM, 1 << 30};
            pg8::gemm_phase<pg8::EpiMain, pg8::StaticOrder, true, true>(C.lds, g, S, E, C.wid);
        }
        SEAM(pb + 2);
        for (int rep = 0; rep < NREP(4); ++rep) if (HAS(4) && IN(pb + 3)) { REFRESH(); p4_attention(C, al, layer); }
        SEAM(pb + 3);
        for (int rep = 0; rep < NREP(5); ++rep) if (HAS(5) && IN(pb + 4)) {
            REFRESH();
            pg8::Gemm g{(const pg8::bf16_t*)(al.ws + WS_XB), (const pg8::bf16_t*)(al.ws + WS_WOUT) + (size_t)layer * DM * DM, M_TOK, DM, DM};
            pg8::StaticOrder S; S.init(M_TOK, DM, C.G, (int)blockIdx.x);
            pg8::EpiOut E{layer == 0 ? al.x : al.out, (float*)(al.ws + WS_HB), ALPHA_RES};
            pg8::gemm_phase<pg8::EpiOut, pg8::StaticOrder, true, true>(C.lds, g, S, E, C.wid);
        }
        SEAM(pb + 4);
        for (int rep = 0; rep < NREP(6); ++rep) if (HAS(6) && IN(pb + 5)) { REFRESH(); p6_layernorm(C, al, layer); }
        SEAM(pb + 5);
}
__global__ void __launch_bounds__(NTHREADS, 2) mega_fwd(Args a) {
    extern __shared__ __attribute__((aligned(16))) unsigned char lds_raw[];
    cg::grid_group grid = cg::this_grid();
    Ctx C; C.lds = (LAS unsigned char*)lds_raw; C.tid = threadIdx.x; C.lane = C.tid & 63; C.wid = __builtin_amdgcn_readfirstlane(C.tid >> 6);
    C.G = gridDim.x; { const int bx = blockIdx.x; C.vcu = (C.G % 8 == 0) ? (bx % 8) * (C.G / 8) + bx / 8 : bx; }
    const int lo = a.ph_lo, hi = a.ph_hi;
    Args al = a;
    volatile LAS unsigned* MISC = (volatile LAS unsigned*)(C.lds + LDS_CTL);
    if (C.tid < 16) MISC[C.tid] = 0u;
    __syncthreads();
    XcdBarrier bar = xcd_barrier_post((unsigned*)(a.ws + WS_CTL), MISC, C.tid == 0);
    for (int rep = 0; rep < NREP(0); ++rep) if (HAS(0) && IN(0)) { REFRESH(); p0_prologue(C, al); } SEAM(0);
    layer_body<0>(C, a, al, lo, hi, grid, bar);
    layer_body<1>(C, a, al, lo, hi, grid, bar);
}
#undef IN
#undef SEAM

#if !DIAG
extern "C" void kernel_launch(void* const* d_in, const int* in_sizes, int n_in, void* d_out, int out_size, void* d_ws, size_t ws_size, hipStream_t stream) {
    static int grid = 0;
    if (grid == 0) {
        if (n_in != 12 || in_sizes[0] != M_TOK * DM || out_size != M_TOK * DM || ws_size < WS_END) {
            fprintf(stderr, "kernel_launch: unexpected shapes (n_in %d, x %d, out %d, ws %zu, need %zu); nothing launched\n", n_in, n_in > 0 ? in_sizes[0] : -1, out_size, ws_size, (size_t)WS_END); grid = -1; return; }
        int dev = 0, cus = 0, per_cu = 0;
        (void)hipGetDevice(&dev); (void)hipDeviceGetAttribute(&cus, hipDeviceAttributeMultiprocessorCount, dev);
        if (hipFuncSetAttribute((const void*)mega_fwd, hipFuncAttributeMaxDynamicSharedMemorySize, LDS_BYTES) != hipSuccess) { fprintf(stderr, "kernel_launch: hipFuncSetAttribute failed\n"); grid = -1; return; }
        if (hipOccupancyMaxActiveBlocksPerMultiprocessor(&per_cu, (const void*)mega_fwd, NTHREADS, LDS_BYTES) != hipSuccess || per_cu < 1) { fprintf(stderr, "kernel_launch: occupancy query says %d blocks per CU\n", per_cu); per_cu = 1; }
        (void)hipGetLastError();
        grid = cus;
    }
    if (grid < 0) return;
    Args a{};
    a.x = (const float*)d_in[0]; a.w_in = (const float*)d_in[1]; a.w_out = (const float*)d_in[2]; a.ln_g = (const float*)d_in[3]; a.ln_b = (const float*)d_in[4];
    a.rel_bias = (const float*)d_in[5]; a.diff_lambda = (const float*)d_in[6]; a.diff_subln = (const float*)d_in[7]; a.mla_q_norm = (const float*)d_in[8];
    a.mla_kv_norm = (const float*)d_in[9]; a.mla_w_uq = (const float*)d_in[10]; a.mla_w_ukv = (const float*)d_in[11];
    a.out = (float*)d_out; a.ws = (unsigned char*)d_ws; a.ph_lo = 0; a.ph_hi = N_PHASES;
    if (hipMemsetAsync(d_ws, 0, 16384, stream) != hipSuccess) { fprintf(stderr, "kernel_launch: hipMemsetAsync of the barrier words failed\n"); return; }
    void* args[] = {&a};
    const hipError_t e = hipLaunchCooperativeKernel((const void*)mega_fwd, dim3(grid), dim3(NTHREADS), args, LDS_BYTES, stream);
    if (e != hipSuccess) fprintf(stderr, "kernel_launch: cooperative launch failed: %s (grid %d)\n", hipGetErrorString(e), grid);
}
#endif
#if DIAG
namespace nv {
constexpr int D_MODEL = 1024, BATCH = 16, SEQ = 2048, DEPTH = 2, H = 4, HD = 64;
constexpr int D_IN = 4040;
constexpr int O_AQ = 0, O_AK = 256, O_AV = 512, O_BQ = 768, O_BK = 1024, O_BV = 1280, O_CQ = 1536, O_CK = 1792, O_CV = 2048,
              O_CIQ = 2304, O_CIK = 2560, O_CIW = 2592, O_DCQ = 2600, O_DCKV = 2856, O_DKR = 2984, O_GATE = 3016;
constexpr int CB = 1;
constexpr int MC = CB * SEQ;
constexpr float ALPHA = 1.4142135623730951f;

__global__ void __launch_bounds__(256) gemm_f32(const float* __restrict__ A, int lda, const float* __restrict__ B, int ldb,
                                                float* __restrict__ C, int ldc, int M, int N, int K) {
    __shared__ float As[16][65];
    __shared__ float Bs[16][65];
    const int tx = threadIdx.x & 15, ty = threadIdx.x >> 4;
    const int m0 = blockIdx.y * 64, n0 = blockIdx.x * 64;
    float acc[4][4];
#pragma unroll
    for (int i = 0; i < 4; ++i)
#pragma unroll
        for (int j = 0; j < 4; ++j) acc[i][j] = 0.f;
    for (int k0 = 0; k0 < K; k0 += 16) {
#pragma unroll
        for (int i = 0; i < 4; ++i) {
            const int e = threadIdx.x + i * 256, r = e >> 4, kk = e & 15;
            As[kk][r] = A[(size_t)(m0 + r) * lda + k0 + kk];
        }
#pragma unroll
        for (int i = 0; i < 4; ++i) {
            const int e = threadIdx.x + i * 256, kk = e >> 6, c = e & 63;
            Bs[kk][c] = (n0 + c < N) ? B[(size_t)(k0 + kk) * ldb + n0 + c] : 0.f;
        }
        __syncthreads();
#pragma unroll
        for (int kk = 0; kk < 16; ++kk) {
            float a[4], b[4];
#pragma unroll
            for (int i = 0; i < 4; ++i) a[i] = As[kk][ty * 4 + i];
#pragma unroll
            for (int j = 0; j < 4; ++j) b[j] = Bs[kk][tx * 4 + j];
#pragma unroll
            for (int i = 0; i < 4; ++i)
#pragma unroll
                for (int j = 0; j < 4; ++j) acc[i][j] = fmaf(a[i], b[j], acc[i][j]);
        }
        __syncthreads();
    }
#pragma unroll
    for (int i = 0; i < 4; ++i)
#pragma unroll
        for (int j = 0; j < 4; ++j) {
            const int c = n0 + tx * 4 + j;
            if (c < N) C[(size_t)(m0 + ty * 4 + i) * ldc + c] = acc[i][j];
        }
}

__device__ __forceinline__ float wave_sum(float v) {
#pragma unroll
    for (int o = 1; o < 64; o <<= 1) v += __shfl_xor(v, o);
    return v;
}

__global__ void __launch_bounds__(256) rms_rows(const float* __restrict__ src, int ld, int off, int W, const float* __restrict__ g, float* __restrict__ dst, int M) {
    const int row = blockIdx.x * 4 + (threadIdx.x >> 6), lane = threadIdx.x & 63;
    if (row >= M) return;
    const float* p = src + (size_t)row * ld + off;
    float s = 0.f;
    for (int c = lane; c < W; c += 64) { const float v = p[c]; s += v * v; }
    s = wave_sum(s);
    const float r = 1.0f / sqrtf(s / (float)W + 1e-6f);
    for (int c = lane; c < W; c += 64) dst[(size_t)row * W + c] = p[c] * r * g[c];
}

__device__ __forceinline__ float inv_freq(int i) { return powf(10000.0f, -(float)i / 16.0f); }

__global__ void __launch_bounds__(256) rope_k(float* __restrict__ dq, const float* __restrict__ hbuf, float* __restrict__ kr, int M) {
    const int idx = blockIdx.x * 256 + threadIdx.x;
    if (idx >= M * 16 * 5) return;
    const int i = idx & 15, which = (idx >> 4) % 5, m = idx / 80;
    const int t = m % SEQ;
    const float ang = (float)t * inv_freq(i);
    const float c = cosf(ang), s = sinf(ang);
    if (which < 4) {
        float* p = dq + (size_t)m * 384 + which * 96 + 64;
        const float x1 = p[i], x2 = p[16 + i];
        p[i] = x1 * c - x2 * s; p[16 + i] = x1 * s + x2 * c;
    } else {
        const float* p = hbuf + (size_t)m * D_IN + O_DKR;
        const float x1 = p[i], x2 = p[16 + i];
        kr[(size_t)m * 32 + i] = x1 * c - x2 * s; kr[(size_t)m * 32 + 16 + i] = x1 * s + x2 * c;
    }
}

__device__ __forceinline__ int t5_bucket(int dist) {
    const int n = dist > 0 ? dist : 0;
    if (n < 16) return n;
    const float nf = (float)n;
    int large = 16 + (int)(logf(nf / 16.0f) / 2.0794415416798357f * 16.0f);
    return large < 31 ? large : 31;
}

__device__ __forceinline__ float softplusf(float z) { return fmaxf(z, 0.f) + log1pf(expf(-fabsf(z))); }

__global__ void __launch_bounds__(256) attn_A(const float* __restrict__ hb, float* __restrict__ o) {
    const int b = blockIdx.z, hd = blockIdx.y, t = blockIdx.x * 256 + threadIdx.x;
    const float* qp = hb + (size_t)(b * SEQ + t) * D_IN + O_AQ + hd * 64;
    float q[64], acc[64];
#pragma unroll
    for (int d = 0; d < 64; ++d) { q[d] = qp[d]; acc[d] = 0.f; }
    float cum = 0.f;
    const int tmax = blockIdx.x * 256 + 255;
    for (int s = tmax - 1; s >= 0; --s) {
        const float* kp = hb + (size_t)(b * SEQ + s) * D_IN + O_AK + hd * 64;
        const float* vp = hb + (size_t)(b * SEQ + s) * D_IN + O_AV + hd * 64;
        float z = 0.f;
#pragma unroll
        for (int d = 0; d < 64; ++d) z = fmaf(q[d], kp[d], z);
        z *= 0.125f;
        if (s < t) {
            const float sp = softplusf(z);
            const float w = expf((z - sp) + cum);
#pragma unroll
            for (int d = 0; d < 64; ++d) acc[d] = fmaf(w, vp[d], acc[d]);
            cum -= sp;
        }
    }
    float* op = o + (size_t)(b * SEQ + t) * 1024 + 0 * 256 + hd * 64;
#pragma unroll
    for (int d = 0; d < 64; ++d) op[d] = acc[d];
}

__global__ void __launch_bounds__(256) attn_B(const float* __restrict__ hb, float* __restrict__ o, const float* __restrict__ rel_bias,
                                              const float* __restrict__ dlam, const float* __restrict__ subln, float lam_init) {
    const int b = blockIdx.z, hd = blockIdx.y, t = blockIdx.x * 256 + threadIdx.x;
    const float* qp = hb + (size_t)(b * SEQ + t) * D_IN + O_BQ + hd * 64;
    float q[64], o1[64], o2[64];
#pragma unroll
    for (int d = 0; d < 64; ++d) { q[d] = qp[d]; o1[d] = 0.f; o2[d] = 0.f; }
    float m1 = -INFINITY, m2 = -INFINITY, l1 = 0.f, l2 = 0.f;
    const int tmax = blockIdx.x * 256 + 255;
    const float sc = 0.17677669529663687f;
    for (int s = 0; s <= tmax; ++s) {
        const float* kp = hb + (size_t)(b * SEQ + s) * D_IN + O_BK + hd * 64;
        const float* vp = hb + (size_t)(b * SEQ + s) * D_IN + O_BV + hd * 64;
        float s1 = 0.f, s2 = 0.f;
#pragma unroll
        for (int d = 0; d < 32; ++d) { s1 = fmaf(q[d], kp[d], s1); s2 = fmaf(q[32 + d], kp[32 + d], s2); }
        if (s <= t) {
            const float bias = rel_bias[t5_bucket(t - s) * 8 + hd];
            s1 = s1 * sc + bias; s2 = s2 * sc + bias;
            {
                const float mn = fmaxf(m1, s1), a = expf(m1 - mn), p = expf(s1 - mn);
                l1 = l1 * a + p; m1 = mn;
#pragma unroll
                for (int d = 0; d < 64; ++d) o1[d] = fmaf(p, vp[d], o1[d] * a);
            }
            {
                const float mn = fmaxf(m2, s2), a = expf(m2 - mn), p = expf(s2 - mn);
                l2 = l2 * a + p; m2 = mn;
#pragma unroll
                for (int d = 0; d < 64; ++d) o2[d] = fmaf(p, vp[d], o2[d] * a);
            }
        }
    }
    float a0 = 0.f, a1 = 0.f;
    for (int d = 0; d < 32; ++d) { a0 += dlam[d] * dlam[32 + d]; a1 += dlam[64 + d] * dlam[96 + d]; }
    const float lam = expf(a0) - expf(a1) + lam_init;
    float ss = 0.f;
#pragma unroll
    for (int d = 0; d < 64; ++d) { o1[d] = o1[d] / l1 - lam * (o2[d] / l2); ss += o1[d] * o1[d]; }
    const float r = 1.0f / sqrtf(ss / 64.0f + 1e-6f);
    float* op = o + (size_t)(b * SEQ + t) * 1024 + 1 * 256 + hd * 64;
#pragma unroll
    for (int d = 0; d < 64; ++d) op[d] = o1[d] * r * subln[d] * (1.0f - lam_init);
}

__global__ void __launch_bounds__(256) c_score(const float* __restrict__ hb, float* __restrict__ score) {
    const int b = blockIdx.z, t = blockIdx.y, s = blockIdx.x * 256 + threadIdx.x;
    if (blockIdx.x * 256 > t) return;
    const float* iq = hb + (size_t)(b * SEQ + t) * D_IN + O_CIQ;
    const float* iw = hb + (size_t)(b * SEQ + t) * D_IN + O_CIW;
    const float* ik = hb + (size_t)(b * SEQ + s) * D_IN + O_CIK;
    float k[32];
#pragma unroll
    for (int d = 0; d < 32; ++d) k[d] = ik[d];
    float sc = 0.f;
#pragma unroll
    for (int hh = 0; hh < 8; ++hh) {
        float dot = 0.f;
#pragma unroll
        for (int d = 0; d < 32; ++d) dot = fmaf(iq[hh * 32 + d], k[d], dot);
        dot *= 0.17677669529663687f;
        sc += (iw[hh] * 0.35355339059327373f) * fmaxf(dot, 0.f);
    }
    score[((size_t)b * SEQ + t) * SEQ + s] = sc;
}

__global__ void __launch_bounds__(256) c_select(const float* __restrict__ score, unsigned* __restrict__ selbits) {
    const int row = blockIdx.x * 4 + (threadIdx.x >> 6), lane = threadIdx.x & 63;
    const int t = row % SEQ;
    unsigned* out = selbits + (size_t)row * 64;
    if (t < 256) {
        const int lo = lane * 32;
        unsigned w = 0u;
        if (t >= lo + 31) w = 0xFFFFFFFFu; else if (t >= lo) w = (2u << (t - lo)) - 1u;
        out[lane] = w;
        return;
    }
    const float* sp = score + (size_t)row * SEQ;
    unsigned u[32];
#pragma unroll
    for (int i = 0; i < 32; ++i) {
        const int key = lane * 32 + i;
        unsigned v = 0u;
        if (key <= t) { const unsigned bits = __float_as_uint(sp[key] + 0.0f); v = (bits & 0x80000000u) ? ~bits : (bits | 0x80000000u); }
        u[i] = v;
    }
    unsigned T = 0u;
    for (int bit = 31; bit >= 0; --bit) {
        const unsigned cand = T | (1u << bit);
        int c = 0;
#pragma unroll
        for (int i = 0; i < 32; ++i) c += (u[i] >= cand) ? 1 : 0;
        c = (int)wave_sum((float)c);
        if (c >= 256) T = cand;
    }
    int cg = 0, ce = 0;
#pragma unroll
    for (int i = 0; i < 32; ++i) { cg += (u[i] > T) ? 1 : 0; ce += (u[i] == T) ? 1 : 0; }
    const int G = (int)wave_sum((float)cg);
    int need = 256 - G;
    int pre = ce;
#pragma unroll
    for (int o = 1; o < 64; o <<= 1) { const int v = __shfl_up(pre, o); if (lane >= o) pre += v; }
    pre -= ce;
    unsigned w = 0u;
    int taken = pre;
#pragma unroll
    for (int i = 0; i < 32; ++i) {
        if (u[i] > T) w |= (1u << i);
        else if (u[i] == T) { if (taken < need) w |= (1u << i); ++taken; }
    }
    out[lane] = w;
}

__global__ void __launch_bounds__(256) attn_C(const float* __restrict__ hb, float* __restrict__ o, const float* __restrict__ rel_bias, const unsigned* __restrict__ selbits) {
    const int b = blockIdx.z, hd = blockIdx.y, t = blockIdx.x * 256 + threadIdx.x;
    const float* qp = hb + (size_t)(b * SEQ + t) * D_IN + O_CQ + hd * 64;
    const unsigned* sb = selbits + (size_t)(b * SEQ + t) * 64;
    float q[64], acc[64];
#pragma unroll
    for (int d = 0; d < 64; ++d) { q[d] = qp[d]; acc[d] = 0.f; }
    float m = -INFINITY, l = 0.f;
    const int tmax = blockIdx.x * 256 + 255;
    unsigned word = 0u;
    for (int s = 0; s <= tmax; ++s) {
        if ((s & 31) == 0) word = sb[s >> 5];
        const float* kp = hb + (size_t)(b * SEQ + s) * D_IN + O_CK + hd * 64;
        const float* vp = hb + (size_t)(b * SEQ + s) * D_IN + O_CV + hd * 64;
        float z = 0.f;
#pragma unroll
        for (int d = 0; d < 64; ++d) z = fmaf(q[d], kp[d], z);
        if (s <= t && ((word >> (s & 31)) & 1u)) {
            z = z * 0.125f + rel_bias[t5_bucket(t - s) * 8 + 4 + hd];
            const float mn = fmaxf(m, z), a = expf(m - mn), p = expf(z - mn);
            l = l * a + p; m = mn;
#pragma unroll
            for (int d = 0; d < 64; ++d) acc[d] = fmaf(p, vp[d], acc[d] * a);
        }
    }
    float* op = o + (size_t)(b * SEQ + t) * 1024 + 2 * 256 + hd * 64;
    const float il = 1.0f / l;
#pragma unroll
    for (int d = 0; d < 64; ++d) op[d] = acc[d] * il;
}

__global__ void __launch_bounds__(256) attn_D(const float* __restrict__ dq, const float* __restrict__ dkv, const float* __restrict__ kr, float* __restrict__ o) {
    const int b = blockIdx.z, hd = blockIdx.y, t = blockIdx.x * 256 + threadIdx.x;
    const float* qp = dq + (size_t)(b * SEQ + t) * 384 + hd * 96;
    float q[96], acc[64];
#pragma unroll
    for (int d = 0; d < 96; ++d) q[d] = qp[d];
#pragma unroll
    for (int d = 0; d < 64; ++d) acc[d] = 0.f;
    float m = -INFINITY, l = 0.f;
    const int tmax = blockIdx.x * 256 + 255;
    const float sc = 0.10206207261596577f;
    for (int s = 0; s <= tmax; ++s) {
        const float* kp = dkv + (size_t)(b * SEQ + s) * 512 + hd * 128;
        const float* vp = kp + 64;
        const float* rp = kr + (size_t)(b * SEQ + s) * 32;
        float z = 0.f;
#pragma unroll
        for (int d = 0; d < 64; ++d) z = fmaf(q[d], kp[d], z);
#pragma unroll
        for (int d = 0; d < 32; ++d) z = fmaf(q[64 + d], rp[d], z);
        if (s <= t) {
            z *= sc;
            const float mn = fmaxf(m, z), a = expf(m - mn), p = expf(z - mn);
            l = l * a + p; m = mn;
#pragma unroll
            for (int d = 0; d < 64; ++d) acc[d] = fmaf(p, vp[d], acc[d] * a);
        }
    }
    float* op = o + (size_t)(b * SEQ + t) * 1024 + 3 * 256 + hd * 64;
    const float il = 1.0f / l;
#pragma unroll
    for (int d = 0; d < 64; ++d) op[d] = acc[d] * il;
}

__global__ void __launch_bounds__(256) gate_mul(float* __restrict__ o, const float* __restrict__ hb, int M) {
    const size_t idx = (size_t)blockIdx.x * 256 + threadIdx.x;
    if (idx >= (size_t)M * 1024) return;
    const int m = (int)(idx >> 10), c = (int)(idx & 1023);
    const float g = hb[(size_t)m * D_IN + O_GATE + c];
    o[idx] = o[idx] * (g / (1.0f + expf(-g)));
}

__global__ void __launch_bounds__(256) ln_res(const float* __restrict__ x, const float* __restrict__ y, const float* __restrict__ g, const float* __restrict__ bb, float* __restrict__ out, int M) {
    const int row = blockIdx.x * 4 + (threadIdx.x >> 6), lane = threadIdx.x & 63;
    if (row >= M) return;
    float v[16]; float s = 0.f;
#pragma unroll
    for (int i = 0; i < 16; ++i) { const int c = i * 64 + lane; v[i] = ALPHA * x[(size_t)row * 1024 + c] + y[(size_t)row * 1024 + c]; s += v[i]; }
    const float mean = wave_sum(s) * (1.0f / 1024.0f);
    float s2 = 0.f;
#pragma unroll
    for (int i = 0; i < 16; ++i) { v[i] -= mean; s2 += v[i] * v[i]; }
    const float r = 1.0f / sqrtf(wave_sum(s2) * (1.0f / 1024.0f) + 1e-5f);
#pragma unroll
    for (int i = 0; i < 16; ++i) { const int c = i * 64 + lane; out[(size_t)row * 1024 + c] = v[i] * r * g[c] + bb[c]; }
}
}

#ifndef DIAG_SEL
#define DIAG_SEL -1
#endif
namespace dg {
constexpr int NITEM = 32;
struct P { const bf16_t* CN; const float* cq; const bf16_t* HB; const bf16_t* MD; const bf16_t* KR; const unsigned* SEL; const bf16_t* OB; const float* OUTOPT;
           const float* hb; const float* dq; const float* dkv; const float* kr; const unsigned* selbits; const float* ob; const float* outn; };
__device__ __forceinline__ bool pair(const P& p, int it, int r, int c, float& av, float& bv) {
    if (it < 16) { const int v = it * 256 + c, s = src_col(v); if (s < 0) return false; av = bf2f(p.HB[(size_t)r * NV + v]); bv = p.hb[(size_t)r * nv::D_IN + s];
        if (it >= 12) bv = bv / (1.0f + expf(-bv)); return true; }
    if (it == 16) { if (c >= 32) return false; av = bf2f(p.HB[(size_t)r * NV + V_DKR + c]); bv = p.hb[(size_t)r * nv::D_IN + nv::O_DKR + c]; return true; }
    if (it == 17) { if (c >= 32) return false; av = bf2f(p.HB[(size_t)r * NV + V_CIK + c]); bv = p.hb[(size_t)r * nv::D_IN + nv::O_CIK + c]; return true; }
    if (it == 18) { if (c >= 8) return false; av = bf2f(p.HB[(size_t)r * NV + V_CIW + c]); bv = p.hb[(size_t)r * nv::D_IN + nv::O_CIW + c]; return true; }
    if (it == 19) { av = bf2f(p.MD[(size_t)r * DM + MD_QN + c]); bv = p.dq[(size_t)r * 384 + (c >> 6) * 96 + (c & 63)]; return true; }
    if (it == 20) { return false; }
    if (it == 21) { av = bf2f(p.MD[(size_t)r * DM + MD_KN + c]); bv = p.dkv[(size_t)r * 512 + (c >> 6) * 128 + (c & 63)]; return true; }
    if (it == 22) { av = bf2f(p.MD[(size_t)r * DM + MD_V + c]); bv = p.dkv[(size_t)r * 512 + (c >> 6) * 128 + 64 + (c & 63)]; return true; }
    if (it == 23) { if (c >= 32) return false; av = bf2f(p.KR[(size_t)r * 32 + c]); bv = p.kr[(size_t)r * 32 + c]; return true; }
    if (it == 24) { if (c >= 64) return false; const unsigned x = p.SEL[(size_t)r * 64 + c], y = p.selbits[(size_t)r * 64 + c];
        unsigned cm = 0xFFFFFFFFu; const int t = r & 2047, lo = c * 32; if (t < lo) cm = 0u; else if (t < lo + 31) cm = (2u << (t - lo)) - 1u;
        av = (float)__popc((x ^ y) & cm); bv = 0.f; if (c == 0) bv = (t < 256) ? (float)(t + 1) : 256.f; av = sqrtf(av); bv = sqrtf(bv); av += bv; return true; }
    if (it == 31) { av = bf2f(p.CN[(size_t)r * 384 + c]); bv = p.cq[(size_t)r * 256 + c]; return true; }
    if (it == 30) { av = bf2f(p.MD[(size_t)r * DM + MD_QN + c]); bv = p.dq[(size_t)r * 384 + (c >> 6) * 96 + (c & 63)]; return true; }
    if (it >= 25 && it < 29) { const int g = it - 25; av = bf2f(p.OB[(size_t)r * DM + g * 256 + c]); bv = p.ob[(size_t)r * 1024 + g * 256 + c]; return true; }
    return false;
}
__global__ void __launch_bounds__(256) cmp_item(P p, int it, int rows, float* acc) {
    float num = 0.f, den = 0.f;
    for (size_t e = (size_t)blockIdx.x * 256 + threadIdx.x; e < (size_t)rows * 256; e += (size_t)gridDim.x * 256) {
        const int r = (int)(e >> 8), c = (int)(e & 255); float av, bv;
        if (pair(p, it, r, c, av, bv)) { const float d = av - bv; num += d * d; den += bv * bv; }
    }
    num = ::wave_sum(num); den = ::wave_sum(den);
    if ((threadIdx.x & 63) == 0) { atomicAdd(acc + 2 * it, num); atomicAdd(acc + 2 * it + 1, den); }
}
__global__ void __launch_bounds__(256) cmp_final(const float* a, const float* b, size_t n, float* acc, int it) {
    float num = 0.f, den = 0.f;
    for (size_t e = (size_t)blockIdx.x * 256 + threadIdx.x; e < n; e += (size_t)gridDim.x * 256) { const float d = a[e] - b[e]; num += d * d; den += b[e] * b[e]; }
    num = ::wave_sum(num); den = ::wave_sum(den);
    if ((threadIdx.x & 63) == 0) { atomicAdd(acc + 2 * it, num); atomicAdd(acc + 2 * it + 1, den); }
}
#ifndef DIAG_SEL2
#define DIAG_SEL2 -1
#endif
#ifndef DIAG_MAXHI
#define DIAG_MAXHI 24
#endif
__global__ void finalize(float* acc) {
    float E = 0.f; int arg = 0; float e2 = 0.f;
    for (int i = 0; i < NITEM; ++i) { const float den = acc[2 * i + 1]; float e = den > 0.f ? sqrtf(acc[2 * i] / den) : 0.f; if (!(e == e)) e = 9.f;
        if (DIAG_SEL >= 0) { if (i == DIAG_SEL) { E = e; arg = i; } } else if (i < DIAG_MAXHI && e > E) { E = e; arg = i; }
        if (i == DIAG_SEL2) e2 = e; }
    acc[2 * NITEM] = E; acc[2 * NITEM + 1] = (DIAG_SEL2 >= 0) ? fmaxf(1.0e6f * e2, 100.f) : (float)((10 + arg) * 10);
}
__global__ void __launch_bounds__(256) perturb(float* out, size_t n, const float* acc) {
    const float E = acc[2 * NITEM], spike = acc[2 * NITEM + 1];
    for (size_t e = (size_t)blockIdx.x * 256 + threadIdx.x; e < n; e += (size_t)gridDim.x * 256) { float v = out[e] * (1.0f + 1000.0f * E);     if (e == 0) v += spike; out[e] = v; }
}
}

extern "C" void kernel_launch(void* const* d_in, const int* in_sizes, int n_in, void* d_out, int out_size, void* d_ws, size_t ws_size, hipStream_t stream) {
    constexpr int MC = nv::MC, CB = nv::CB, BATCH = nv::BATCH, H = nv::H, O_DCQ = nv::O_DCQ, O_DCKV = nv::O_DCKV;
    using nv::gemm_f32; using nv::rms_rows; using nv::rope_k; using nv::attn_A; using nv::attn_B; using nv::c_score; using nv::c_select; using nv::attn_C; using nv::attn_D; using nv::gate_mul; using nv::ln_res;
    const float* x = (const float*)d_in[0]; const float* w_in = (const float*)d_in[1]; const float* w_out = (const float*)d_in[2]; const float* ln_g = (const float*)d_in[3];
    const float* ln_b = (const float*)d_in[4]; const float* rel_bias = (const float*)d_in[5]; const float* diff_lambda = (const float*)d_in[6]; const float* diff_subln = (const float*)d_in[7];
    const float* mla_q_norm = (const float*)d_in[8]; const float* mla_kv_norm = (const float*)d_in[9]; const float* mla_w_uq = (const float*)d_in[10]; const float* mla_w_ukv = (const float*)d_in[11];
    float* out = (float*)d_out; char* ws = (char*)d_ws;
    size_t off = (WS_END + 255) & ~(size_t)255;
    auto carve = [&](size_t bytes) { char* p = ws + off; off += (bytes + 255) & ~(size_t)255; return p; };
    float* outopt = (float*)carve((size_t)M_TOK * DM * 4);
    float* acc = (float*)carve(4096);
    float* hb = (float*)carve((size_t)MC * D_IN * 4); float* cq = (float*)carve((size_t)MC * 256 * 4); float* ckv = (float*)carve((size_t)MC * 128 * 4);
    float* dq = (float*)carve((size_t)MC * 384 * 4); float* dkv = (float*)carve((size_t)MC * 512 * 4); float* kr = (float*)carve((size_t)MC * 32 * 4);
    float* score = (float*)carve((size_t)CB * SEQ * SEQ * 4); unsigned* selbits = (unsigned*)carve((size_t)MC * 64 * 4);
    float* ob = (float*)carve((size_t)MC * 1024 * 4); float* yb = (float*)carve((size_t)MC * 1024 * 4); float* x1 = (float*)carve((size_t)MC * 1024 * 4);
    if (off > ws_size) { fprintf(stderr, "DIAG workspace too small: need %zu have %zu\n", off, ws_size); return; }
    (void)hipMemsetAsync(acc, 0, 4096, stream);
    auto naive_layer = [&](const float* xin, float* xout, int l, bool upto_y_only) {
        const float* wi = w_in + (size_t)l * 1024 * D_IN; const float* wo = w_out + (size_t)l * 1024 * 1024;
        const float lam_init = (float)(0.8 - 0.6 * exp(-0.3 * (double)l));
        gemm_f32<<<dim3((D_IN + 63) / 64, MC / 64), 256, 0, stream>>>(xin, 1024, wi, D_IN, hb, D_IN, MC, D_IN, 1024);
        rms_rows<<<MC / 4, 256, 0, stream>>>(hb, D_IN, O_DCQ, 256, mla_q_norm + l * 256, cq, MC);
        rms_rows<<<MC / 4, 256, 0, stream>>>(hb, D_IN, O_DCKV, 128, mla_kv_norm + l * 128, ckv, MC);
        gemm_f32<<<dim3(384 / 64, MC / 64), 256, 0, stream>>>(cq, 256, mla_w_uq + (size_t)l * 256 * 384, 384, dq, 384, MC, 384, 256);
        gemm_f32<<<dim3(512 / 64, MC / 64), 256, 0, stream>>>(ckv, 128, mla_w_ukv + (size_t)l * 128 * 512, 512, dkv, 512, MC, 512, 128);
        rope_k<<<(MC * 80 + 255) / 256, 256, 0, stream>>>(dq, hb, kr, MC);
        attn_A<<<dim3(SEQ / 256, H, CB), 256, 0, stream>>>(hb, ob);
        attn_B<<<dim3(SEQ / 256, H, CB), 256, 0, stream>>>(hb, ob, rel_bias, diff_lambda + l * 128, diff_subln + l * 64, lam_init);
        c_score<<<dim3(SEQ / 256, SEQ, CB), 256, 0, stream>>>(hb, score);
        c_select<<<MC / 4, 256, 0, stream>>>(score, selbits);
        attn_C<<<dim3(SEQ / 256, H, CB), 256, 0, stream>>>(hb, ob, rel_bias, selbits);
        attn_D<<<dim3(SEQ / 256, H, CB), 256, 0, stream>>>(dq, dkv, kr, ob);
        gate_mul<<<MC * 1024 / 256, 256, 0, stream>>>(ob, hb, MC);
        if (upto_y_only) return;
        gemm_f32<<<dim3(1024 / 64, MC / 64), 256, 0, stream>>>(ob, 1024, wo, 1024, yb, 1024, MC, 1024, 1024);
        ln_res<<<MC / 4, 256, 0, stream>>>(xin, yb, ln_g + l * 1024, ln_b + l * 1024, xout, MC);
    };
    for (int c = 0; c < BATCH / CB; ++c) {
        naive_layer(x + (size_t)c * MC * 1024, x1, 0, false);
        naive_layer(x1, out + (size_t)c * MC * 1024, 1, false);
    }
    naive_layer(x, x1, 0, true);
    (void)hipFuncSetAttribute((const void*)mega_fwd, hipFuncAttributeMaxDynamicSharedMemorySize, LDS_BYTES);
    Args a{};
    a.x = x; a.w_in = w_in; a.w_out = w_out; a.ln_g = ln_g; a.ln_b = ln_b; a.rel_bias = rel_bias; a.diff_lambda = diff_lambda; a.diff_subln = diff_subln;
    a.mla_q_norm = mla_q_norm; a.mla_kv_norm = mla_kv_norm; a.mla_w_uq = mla_w_uq; a.mla_w_ukv = mla_w_ukv; a.out = outopt; a.ws = (unsigned char*)d_ws;
    dg::P p{(const bf16_t*)(ws + WS_CN), cq, (const bf16_t*)(ws + WS_HB), (const bf16_t*)(ws + WS_MD), (const bf16_t*)(ws + WS_KR), (const unsigned*)(ws + WS_SEL), (const bf16_t*)(ws + WS_XB), outopt,
            hb, dq, dkv, kr, selbits, ob, out};
    auto run = [&](int lo, int hi) { for (int ph = lo; ph < hi; ++ph) { a.ph_lo = ph; a.ph_hi = ph + 1; hipLaunchKernelGGL(mega_fwd, dim3(256), dim3(NTHREADS), LDS_BYTES, stream, a); } };
    auto cmp = [&](int it) { dg::cmp_item<<<512, 256, 0, stream>>>(p, it, SEQ, acc); };
    run(0, 2); for (int it = 0; it < 19; ++it) cmp(it);
    run(2, 4); for (int it = 19; it < 25; ++it) cmp(it); cmp(31); run(3, 4); cmp(30);
#ifdef DIAG_COPYSEL
    (void)hipMemcpyAsync(ws + WS_SEL, selbits, (size_t)SEQ * 64 * 4, hipMemcpyDeviceToDevice, stream);
#endif
    run(4, 5); for (int it = 25; it < 29; ++it) cmp(it);
    run(5, N_PHASES);
    dg::cmp_final<<<1024, 256, 0, stream>>>(outopt, out, (size_t)M_TOK * DM, acc, 29);
    dg::finalize<<<1, 1, 0, stream>>>(acc);
    dg::perturb<<<2048, 256, 0, stream>>>(out, (size_t)BATCH * SEQ * 1024, acc);
}
#endif
```

```cpp
#include <hip/hip_runtime.h>
#include <hip/hip_cooperative_groups.h>
#include <hip/hip_bf16.h>
#include <cstdio>
#include <cstdint>
#include <cmath>
namespace cg = cooperative_groups;

#ifndef NBATCH
#define NBATCH 16
#endif
#ifndef DIAG
#define DIAG 0
#endif

#ifndef PH_MASK
#define PH_MASK 0xFFFF
#endif
#define HAS(k) (((PH_MASK) >> (k)) & 1)

constexpr int NB = NBATCH, SEQ = 2048, DM = 1024, M_TOK = NB * SEQ, DEPTH = 2;
constexpr int D_IN = 4040, NV = 4096;
constexpr int V_AQ = 0, V_AK = 256, V_AV = 512, V_BQ = 768, V_BK = 1024, V_BV = 1280, V_CQ = 1536, V_CK = 1792, V_CV = 2048,
              V_CIQ = 2304, V_DCQ = 2560, V_DCKV = 2816, V_DKR = 2944, V_CIK = 2976, V_CIW = 3008, V_GATE = 3072;
constexpr int MD_QN = 0, MD_QR = 256, MD_KN = 512, MD_V = 768;
constexpr float ALPHA_RES = 1.4142135623730951f;
constexpr float LOG2E = 1.4426950408889634f, LN2 = 0.6931471805599453f;

__host__ __device__ __forceinline__ int src_col(int v) {
    if (v < 2560) return v;
    if (v < 2816) return 2600 + (v - 2560);
    if (v < 2944) return 2856 + (v - 2816);
    if (v < 2976) return 2984 + (v - 2944);
    if (v < 3008) return 2560 + (v - 2976);
    if (v < 3016) return 2592 + (v - 3008);
    if (v < 3072) return -1;
    return 3016 + (v - 3072);
}

constexpr size_t MiB = 1u << 20;
constexpr size_t WS_CTL = 0;
constexpr size_t WS_ROPE = 512 * 1024;
constexpr size_t WS_WIN = 1 * MiB;
constexpr size_t WS_WOUT = WS_WIN + 2 * (size_t)NV * DM * 2;
constexpr size_t WS_WMLA = WS_WOUT + 2 * (size_t)DM * DM * 2;
constexpr size_t WS_XB = WS_WMLA + 2 * MiB;
constexpr size_t WS_HB = WS_XB + (size_t)M_TOK * DM * 2;
constexpr size_t WS_CN = WS_HB + (size_t)M_TOK * NV * 2;
constexpr size_t WS_KR = WS_CN + (size_t)M_TOK * 384 * 2;
constexpr size_t WS_MD = WS_KR + (size_t)M_TOK * 32 * 2;
constexpr size_t WS_SEL = WS_MD + (size_t)M_TOK * DM * 2;
constexpr size_t WS_END = WS_SEL + (size_t)M_TOK * 64 * 4;

#define LAS __attribute__((address_space(3)))
typedef unsigned short bf16_t;
typedef short bf16x8 __attribute__((ext_vector_type(8)));
typedef float f32x4 __attribute__((ext_vector_type(4)));
typedef float f32x16 __attribute__((ext_vector_type(16)));
typedef unsigned u32x4 __attribute__((ext_vector_type(4)));
typedef unsigned u32x2 __attribute__((ext_vector_type(2)));
typedef float f32x2_t __attribute__((ext_vector_type(2)));
typedef __bf16 bf16x2_t __attribute__((ext_vector_type(2)));
__device__ __forceinline__ unsigned cvtpk(float lo, float hi) { f32x2_t v = {lo, hi}; bf16x2_t b = __builtin_convertvector(v, bf16x2_t); return __builtin_bit_cast(unsigned, b); }
__device__ __forceinline__ float bf2f(unsigned short h) { return __uint_as_float((unsigned)h << 16); }
__device__ __forceinline__ float bflo(unsigned w) { return __uint_as_float(w << 16); }
__device__ __forceinline__ float bfhi(unsigned w) { return __uint_as_float(w & 0xffff0000u); }
__device__ __forceinline__ float wave_sum(float v) {
#pragma unroll
    for (int o = 1; o < 64; o <<= 1) v += __shfl_xor(v, o);
    return v;
}
namespace pg8 {
#define PG8_LAS __attribute__((address_space(3)))
typedef unsigned short bf16_t;
typedef short bf16x8 __attribute__((ext_vector_type(8)));
typedef float f32x4 __attribute__((ext_vector_type(4)));
typedef unsigned u32x4 __attribute__((ext_vector_type(4)));
constexpr int BM = 256, BK = 64, HALF = 128, HTB = HALF * BK * 2  , STAGE_BYTES = 8 * HTB, NXCD = 8, WGM = 8;

__host__ __device__ __forceinline__ int lds_byte(int r, int c) { const int st = (r >> 4) * 2 + (c >> 5), rr = r & 15, cc = c & 31, ob = rr * 64 + cc * 2; return st * 1024 + (ob ^ (((ob >> 9) & 1) << 5)); }
__host__ __device__ __forceinline__ void stage_rc(int b, int& R, int& C) { const int st = b / 1024, sb = b % 1024, swz = sb ^ (((sb >> 9) & 1) << 5); R = (st >> 1) * 16 + swz / 64; C = (st & 1) * 32 + (swz % 64) / 2; }
__host__ __device__ __forceinline__ int perm32(int rho) { const int n = rho >> 4, i = rho & 15; return 8 * (i >> 2) + 4 * n + (i & 3); }

struct Unit { int pm, pn; };
struct Gemm { const bf16_t* A; const bf16_t* Bt; int M, N, K; };

struct StaticOrder {
    int nM, nN, nwg, G, c;
    __host__ __device__ void init(int M, int N, int G_, int c_) { nM = M / BM; nN = N / BM; nwg = nM * nN; G = G_; c = c_; }
    __host__ __device__ bool next(int i, Unit& u) const {
        const long L = (long)i * G + c; if (L >= nwg) return false;
        int wgid = (int)L; { const int q = nwg / NXCD, r = nwg % NXCD, xcd = wgid % NXCD, off = wgid / NXCD; wgid = (xcd < r ? xcd * (q + 1) : r * (q + 1) + (xcd - r) * q) + off; }
        const int nig = WGM * nN, gid = wgid / nig, fm = gid * WGM, gsz = (nM - fm) < WGM ? (nM - fm) : WGM;
        u.pm = fm + ((wgid % nig) % gsz); u.pn = (wgid % nig) / gsz; return true;
    }
    __device__ __forceinline__ void a_ready(const Unit&) const {}
    __device__ __forceinline__ void done(const Unit&) const {}
};


__device__ __forceinline__ float silu_f(float v) { return v * __builtin_amdgcn_rcpf(1.0f + __builtin_amdgcn_exp2f(-v * 1.4426950408889634f)); }

struct EpiMain {
    static constexpr bool PERM = true, AFTER_DRAIN = false;
    bf16_t* O; int ldc; int gate_from;
    __device__ __forceinline__ void operator()(const f32x4 (&acc)[2][2][4][2], const Unit& u, int wr, int wc, int fr, int fq) const {
        const int row0 = u.pm * BM + wr * 64 + fr, col0 = u.pn * BM + wc * 32 + 8 * fq;
        const bool gate = u.pn >= gate_from;
#pragma unroll
        for (int ai = 0; ai < 2; ++ai)
#pragma unroll
            for (int m = 0; m < 4; ++m) { bf16_t* rowp = O + (size_t)(row0 + ai * HALF + m * 16) * ldc + col0;
#pragma unroll
                for (int bj = 0; bj < 2; ++bj) { f32x4 v0 = acc[ai][bj][m][0], v1 = acc[ai][bj][m][1];
                    if (gate) {
#pragma unroll
                        for (int j = 0; j < 4; ++j) { v0[j] = silu_f(v0[j]); v1[j] = silu_f(v1[j]); } }
                    u32x4 w; w.x = ::cvtpk(v0[0], v0[1]); w.y = ::cvtpk(v0[2], v0[3]); w.z = ::cvtpk(v1[0], v1[1]); w.w = ::cvtpk(v1[2], v1[3]);
                    *(u32x4*)(rowp + bj * HALF) = w; } }
    }
};
struct EpiOut {
    static constexpr bool PERM = false, AFTER_DRAIN = false;
    const float* xres; float* Z; float alpha;
    __device__ __forceinline__ void operator()(const f32x4 (&acc)[2][2][4][2], const Unit& u, int wr, int wc, int fr, int fq) const {
        const int row0 = u.pm * BM + wr * 64 + fr, col0 = u.pn * BM + wc * 32 + 4 * fq;
#pragma unroll
        for (int ai = 0; ai < 2; ++ai)
#pragma unroll
            for (int m = 0; m < 4; ++m) { const size_t off = (size_t)(row0 + ai * HALF + m * 16) * 1024 + col0;
#pragma unroll
                for (int bj = 0; bj < 2; ++bj)
#pragma unroll
                    for (int n = 0; n < 2; ++n) { const f32x4 xr = *(const f32x4*)(xres + off + bj * HALF + n * 16);
                        *(f32x4*)(Z + off + bj * HALF + n * 16) = xr * alpha + acc[ai][bj][m][n]; } }
    }
};
template <class Epi, class Sched, bool ALIGN_EPI = false, bool SP2 = false>
__device__ __forceinline__ void gemm_phase(PG8_LAS unsigned char* lds, const Gemm g, const Sched& S, const Epi& E, int wid_in) {
    int tid_op = wid_in * 64 + (int)__builtin_amdgcn_mbcnt_hi(~0u, __builtin_amdgcn_mbcnt_lo(~0u, 0u)); asm volatile("" : "+v"(tid_op));
    const int tid = tid_op, wid = __builtin_amdgcn_readfirstlane(tid >> 6), lane = tid & 63, wr = wid >> 2, wc = wid & 3, fr = lane & 15, fq = lane >> 4;
    const int K = g.K, nt = K / BK;
    unsigned voffA[2], voffB[2];
#pragma unroll
    for (int i = 0; i < 2; ++i) { int R, C; stage_rc(tid * 16 + i * 8192, R, C); const int Rb = Epi::PERM ? ((R & ~31) + perm32(R & 31)) : R;
        voffA[i] = (unsigned)(R * K + C) * 2u; voffB[i] = (unsigned)(Rb * K + C) * 2u; }
    const size_t kstep = (size_t)(BK * 2);
    const size_t hstep = (size_t)HALF * K * 2;
    const size_t tstep = 2 * hstep;
    const unsigned ldsw = (unsigned)wid * 1024u;
    const int aoff = lds_byte(wr * 64 + fr, fq * 8), boff = lds_byte(wc * 32 + fr, fq * 8);
#define PG8_SA(b, h) (((b) * 2 + (h)) * HTB)
#define PG8_SB(b, h) ((4 + (b) * 2 + (h)) * HTB)
#define PG8_STAGE(bufoff, gbase, voff) do { _Pragma("unroll") for (int _i = 0; _i < 2; ++_i) \
        __builtin_amdgcn_global_load_lds((const unsigned*)((const char*)(gbase) + (voff)[_i]), (PG8_LAS unsigned*)(lds + (bufoff) + ldsw + _i * 8192), 16, 0, 0); } while (0)
#define PG8_LDA(dst, b, h) do { _Pragma("unroll") for (int m = 0; m < 4; ++m) _Pragma("unroll") for (int k = 0; k < 2; ++k) dst[m][k] = *(const PG8_LAS bf16x8*)(lds + PG8_SA(b, h) + aoff + m * 2048 + k * 1024); } while (0)
#define PG8_LDB(dst, b, h) do { _Pragma("unroll") for (int n = 0; n < 2; ++n) _Pragma("unroll") for (int k = 0; k < 2; ++k) dst[n][k] = *(const PG8_LAS bf16x8*)(lds + PG8_SB(b, h) + boff + n * 2048 + k * 1024); } while (0)
#define PG8_MMA(ai, bj, At, Bt) do { __builtin_amdgcn_s_setprio(1); _Pragma("unroll") for (int m = 0; m < 4; ++m) _Pragma("unroll") for (int n = 0; n < 2; ++n) _Pragma("unroll") for (int k = 0; k < 2; ++k) \
        acc[ai][bj][m][n] = __builtin_amdgcn_mfma_f32_16x16x32_bf16(Bt[n][k], At[m][k], acc[ai][bj][m][n], 0, 0, 0); __builtin_amdgcn_s_setprio(0); } while (0)
#define PG8_WAIT_V(n) asm volatile("s_waitcnt vmcnt(" #n ")" ::: "memory")
#define PG8_WAIT_L(n) asm volatile("s_waitcnt lgkmcnt(" #n ")" ::: "memory")
#define PG8_BAR __builtin_amdgcn_s_barrier()
#define PG8_SCHED __builtin_amdgcn_sched_barrier(0)
    Unit cur, nxt; int ui = 0;
    if (!S.next(0, cur)) return;
    f32x4 acc[2][2][4][2];
#pragma unroll
    for (int a = 0; a < 2; ++a)
#pragma unroll
        for (int b = 0; b < 2; ++b)
#pragma unroll
            for (int m = 0; m < 4; ++m)
#pragma unroll
                for (int n = 0; n < 2; ++n) acc[a][b][m][n] = (f32x4){0.f, 0.f, 0.f, 0.f};
    bf16x8 At[4][2], B0[2][2], B1[2][2];
    const char* cA = (const char*)g.A + (size_t)cur.pm * tstep; const char* cB = (const char*)g.Bt + (size_t)cur.pn * tstep;
    S.a_ready(cur);
    if constexpr (SP2) {
        PG8_STAGE(PG8_SB(0, 0), cB, voffB); PG8_STAGE(PG8_SB(0, 1), cB + hstep, voffB); PG8_STAGE(PG8_SA(0, 0), cA, voffA); PG8_STAGE(PG8_SA(0, 1), cA + hstep, voffA);
        if (wr == 1) PG8_BAR;
        PG8_WAIT_V(2); PG8_BAR;
        PG8_STAGE(PG8_SB(1, 0), cB + kstep, voffB); PG8_STAGE(PG8_SA(1, 0), cA + kstep, voffA); PG8_STAGE(PG8_SB(1, 1), cB + hstep + kstep, voffB);
        PG8_WAIT_V(6); PG8_BAR;
    } else {
        PG8_STAGE(PG8_SB(0, 0), cB, voffB); PG8_STAGE(PG8_SA(0, 0), cA, voffA); PG8_STAGE(PG8_SB(0, 1), cB + hstep, voffB); PG8_STAGE(PG8_SA(0, 1), cA + hstep, voffA);
        if (wr == 1) PG8_BAR;
        PG8_WAIT_V(4); PG8_BAR;
        PG8_STAGE(PG8_SB(1, 0), cB + kstep, voffB); PG8_STAGE(PG8_SA(1, 0), cA + kstep, voffA); PG8_STAGE(PG8_SB(1, 1), cB + hstep + kstep, voffB);
        PG8_WAIT_V(6); PG8_BAR;
    }
    for (;;) {
        const bool has_next = S.next(ui + 1, nxt);
        const char* nA = has_next ? (const char*)g.A + (size_t)nxt.pm * tstep : cA; const char* nB = has_next ? (const char*)g.Bt + (size_t)nxt.pn * tstep : cB;
#pragma unroll 1
        for (int t = 0; t < nt; t += 2) {
            const bool last = (t == nt - 2);
            const char* a1 = cA + (size_t)(t + 1) * kstep;
            const char* a2 = last ? nA : cA + (size_t)(t + 2) * kstep; const char* b2 = last ? nB : cB + (size_t)(t + 2) * kstep;
            const char* a3 = a2 + kstep; const char* b3 = b2 + kstep;
            if (last && has_next) S.a_ready(nxt);
            if constexpr (SP2) {
            PG8_LDB(B0, 0, 0); PG8_LDB(B1, 0, 1); PG8_SCHED; PG8_LDA(At, 0, 0); PG8_STAGE(PG8_SA(1, 1), a1 + hstep, voffA);
            PG8_WAIT_V(8); PG8_WAIT_L(0); PG8_BAR; PG8_MMA(0, 0, At, B0); PG8_MMA(0, 1, At, B1); PG8_BAR; PG8_SCHED;
            PG8_LDA(At, 0, 1); PG8_STAGE(PG8_SB(0, 0), b2, voffB); PG8_STAGE(PG8_SB(0, 1), b2 + hstep, voffB); PG8_STAGE(PG8_SA(0, 0), a2, voffA);
            PG8_WAIT_V(8); PG8_WAIT_L(0); PG8_BAR; PG8_MMA(1, 0, At, B0); PG8_MMA(1, 1, At, B1); PG8_BAR; PG8_SCHED;
            PG8_LDB(B0, 1, 0); PG8_LDB(B1, 1, 1); PG8_SCHED; PG8_LDA(At, 1, 0); PG8_STAGE(PG8_SA(0, 1), a2 + hstep, voffA);
            PG8_WAIT_V(8); PG8_WAIT_L(0); PG8_BAR; PG8_MMA(0, 0, At, B0); PG8_MMA(0, 1, At, B1); PG8_BAR; PG8_SCHED;
            PG8_LDA(At, 1, 1); PG8_STAGE(PG8_SB(1, 0), b3, voffB); PG8_STAGE(PG8_SB(1, 1), b3 + hstep, voffB); PG8_STAGE(PG8_SA(1, 0), a3, voffA);
            PG8_WAIT_V(8); PG8_WAIT_L(0); PG8_BAR; PG8_MMA(1, 0, At, B0); PG8_MMA(1, 1, At, B1); PG8_BAR; PG8_SCHED;
            } else {
            PG8_LDB(B0, 0, 0); PG8_SCHED; PG8_LDA(At, 0, 0); PG8_STAGE(PG8_SA(1, 1), a1 + hstep, voffA);
            PG8_WAIT_L(8); PG8_BAR; PG8_WAIT_L(0); PG8_MMA(0, 0, At, B0); PG8_BAR; PG8_SCHED;
            PG8_LDB(B1, 0, 1); PG8_STAGE(PG8_SB(0, 0), b2, voffB);
            PG8_BAR; PG8_WAIT_L(0); PG8_MMA(0, 1, At, B1); PG8_BAR;
            PG8_LDA(At, 0, 1); PG8_STAGE(PG8_SA(0, 0), a2, voffA);
            PG8_BAR; PG8_WAIT_L(0); PG8_MMA(1, 0, At, B0); PG8_BAR; PG8_SCHED;
            PG8_STAGE(PG8_SB(0, 1), b2 + hstep, voffB);
            PG8_WAIT_V(6); PG8_BAR; PG8_MMA(1, 1, At, B1); PG8_BAR;
            PG8_LDB(B0, 1, 0); PG8_SCHED; PG8_LDA(At, 1, 0); PG8_STAGE(PG8_SA(0, 1), a2 + hstep, voffA);
            PG8_WAIT_L(8); PG8_BAR; PG8_WAIT_L(0); PG8_MMA(0, 0, At, B0); PG8_BAR; PG8_SCHED;
            PG8_LDB(B1, 1, 1); PG8_STAGE(PG8_SB(1, 0), b3, voffB);
            PG8_BAR; PG8_WAIT_L(0); PG8_MMA(0, 1, At, B1); PG8_BAR;
            PG8_LDA(At, 1, 1); PG8_STAGE(PG8_SA(1, 0), a3, voffA);
            PG8_BAR; PG8_WAIT_L(0); PG8_MMA(1, 0, At, B0); PG8_BAR; PG8_SCHED;
            PG8_STAGE(PG8_SB(1, 1), b3 + hstep, voffB);
            PG8_WAIT_V(6); PG8_BAR; PG8_MMA(1, 1, At, B1); PG8_BAR;
            }
        }
        if constexpr (ALIGN_EPI) { if (wr == 0) PG8_BAR; }
        if constexpr (!Epi::AFTER_DRAIN) { E(acc, cur, wr, wc, fr, fq); S.done(cur); }
        if (!has_next) break;
#pragma unroll
        for (int a = 0; a < 2; ++a)
#pragma unroll
            for (int b = 0; b < 2; ++b)
#pragma unroll
                for (int m = 0; m < 4; ++m)
#pragma unroll
                    for (int n = 0; n < 2; ++n) acc[a][b][m][n] = (f32x4){0.f, 0.f, 0.f, 0.f};
        cur = nxt; cA = nA; cB = nB; ++ui;
        if constexpr (ALIGN_EPI) { if (wr == 1) PG8_BAR; }
    }
    PG8_WAIT_V(0);
    if constexpr (!ALIGN_EPI) { if (wr == 0) PG8_BAR; }
    PG8_BAR;
    if constexpr (Epi::AFTER_DRAIN) { E.fused(acc, cur, wr, wc, fr, fq, lds, wid, lane); S.done(cur); }
#undef PG8_SA
#undef PG8_SB
#undef PG8_STAGE
#undef PG8_LDA
#undef PG8_LDB
#undef PG8_MMA
#undef PG8_WAIT_V
#undef PG8_WAIT_L
#undef PG8_BAR
#undef PG8_SCHED
}
}

#ifndef REP_PH
#define REP_PH -1
#endif
#define NREP(k) ((REP_PH) == (k) ? 2 : 1)
constexpr int NWAVES = 8, NTHREADS = 512;
constexpr int LDS_BYTES = 147456;
constexpr int SEL_RS = 2052;
constexpr int LDS_CTL = 16 * SEL_RS * 4;
constexpr int AL_K = 0, AL_KB = 12288, AL_V = 2 * AL_KB, AL_VB = 8192, AL_BIAS = AL_V + 2 * AL_VB, AL_FLAG = AL_BIAS + 1024, AL_Q = AL_FLAG + 1024;

struct Args {
    const float* x; const float* w_in; const float* w_out; const float* ln_g; const float* ln_b; const float* rel_bias; const float* diff_lambda;
    const float* diff_subln; const float* mla_q_norm; const float* mla_kv_norm; const float* mla_w_uq; const float* mla_w_ukv;
    float* out; unsigned char* ws; int ph_lo, ph_hi;
};

struct Ctx {
    LAS unsigned char* lds; int tid, lane, wid, vcu, G;
};

__device__ __forceinline__ f32x16 mfma32(bf16x8 a, bf16x8 b, f32x16 c) { return __builtin_amdgcn_mfma_f32_32x32x16_bf16(a, b, c, 0, 0, 0); }
__device__ __forceinline__ f32x4 mfma16(bf16x8 a, bf16x8 b, f32x4 c) { return __builtin_amdgcn_mfma_f32_16x16x32_bf16(a, b, c, 0, 0, 0); }
typedef short v4i16_t __attribute__((ext_vector_type(4)));
__device__ __forceinline__ v4i16_t vtr(LAS const unsigned char* p) { return __builtin_amdgcn_ds_read_tr16_b64_v4i16((LAS v4i16_t*)p); }
__device__ __forceinline__ float xhalf_sum(float v) { auto rr = __builtin_amdgcn_permlane32_swap(__float_as_uint(v), __float_as_uint(v), false, false); return __uint_as_float(rr[0]) + __uint_as_float(rr[1]); }
__device__ __forceinline__ float xhalf_max(float v) { auto rr = __builtin_amdgcn_permlane32_swap(__float_as_uint(v), __float_as_uint(v), false, false); return fmaxf(__uint_as_float(rr[0]), __uint_as_float(rr[1])); }
__device__ __forceinline__ float xhalf_other(float v, int hi) { auto rr = __builtin_amdgcn_permlane32_swap(__float_as_uint(v), __float_as_uint(v), false, false); return __uint_as_float(hi ? rr[0] : rr[1]); }
__device__ __forceinline__ int crow(int r, int hi) { return (r & 3) + 8 * (r >> 2) + 4 * hi; }

__device__ __forceinline__ int t5_bucket(int n) {
    if (n < 16) return n;
    int large = 16 + (int)(logf((float)n / 16.0f) / 2.0794415416798357f * 16.0f);
    return large < 31 ? large : 31;
}

template <int MAP>
__device__ __forceinline__ void p0_transpose_item(const float* W, int K, int N, bf16_t* WT, LAS float* scr, int item, int nblk, int lane) {
    const int kb = item / nblk, nb = item % nblk, k0 = 64 * kb, n0 = 32 * nb;
    const int v = n0 + (lane & 31);
    const int sc = MAP ? src_col(v) : v;
#pragma unroll 8
    for (int i = 0; i < 32; ++i) { const int kk = 2 * i + (lane >> 5); scr[kk * 33 + (lane & 31)] = (sc >= 0) ? W[(size_t)(k0 + kk) * N + sc] : 0.f; }
    asm volatile("s_waitcnt lgkmcnt(0)" ::: "memory");
    const int c = lane & 7;
#pragma unroll
    for (int j = 0; j < 4; ++j) { const int n = (lane >> 3) + 8 * j; const LAS float* s = scr + (8 * c) * 33 + n;
        u32x4 o; o.x = cvtpk(s[0 * 33], s[1 * 33]); o.y = cvtpk(s[2 * 33], s[3 * 33]); o.z = cvtpk(s[4 * 33], s[5 * 33]); o.w = cvtpk(s[6 * 33], s[7 * 33]);
        *(u32x4*)(WT + (size_t)(n0 + n) * K + k0 + 8 * c) = o; }
    asm volatile("s_waitcnt lgkmcnt(0)" ::: "memory");
}
__device__ __forceinline__ void p0_prologue(const Ctx& C, const Args& a) {
    unsigned char* ws = a.ws;
    LAS float* scr = (LAS float*)(C.lds + C.wid * 16384);
    const int gw = C.vcu * NWAVES + C.wid, NGW = C.G * NWAVES;
    constexpr int I_IN = (DM / 64) * (NV / 32), I_OUT = (DM / 64) * (DM / 32);
    for (int it = gw; it < 2 * I_IN + 2 * I_OUT; it += NGW) {
        int r = it;
        if (r < 2 * I_IN) { const int l = r / I_IN; r -= l * I_IN;
            p0_transpose_item<1>(a.w_in + (size_t)l * DM * D_IN, DM, D_IN, (bf16_t*)(ws + WS_WIN) + (size_t)l * NV * DM, scr, r, NV / 32, C.lane); continue; }
        r -= 2 * I_IN; { const int l = r / I_OUT; r -= l * I_OUT;
            p0_transpose_item<0>(a.w_out + (size_t)l * DM * DM, DM, DM, (bf16_t*)(ws + WS_WOUT) + (size_t)l * DM * DM, scr, r, DM / 32, C.lane); }
    }
    const int gt = C.vcu * NTHREADS + C.tid, NGT = C.G * NTHREADS;
    for (int e = gt; e < 2 * 1024 * 384; e += NGT) {
        const int l = e / (1024 * 384), rem = e % (1024 * 384), r = rem / 384, k = rem % 384;
        float v = 0.f;
        if (r < 256) { if (k < 256) v = a.mla_w_uq[(size_t)l * 256 * 384 + (size_t)k * 384 + (r >> 6) * 96 + (r & 63)]; }
        else if (r < 384) { if (k < 256) v = a.mla_w_uq[(size_t)l * 256 * 384 + (size_t)k * 384 + ((r - 256) >> 5) * 96 + 64 + ((r - 256) & 31)]; }
        else if (r < 512) { }
        else if (r < 768) { if (k >= 256) v = a.mla_w_ukv[(size_t)l * 128 * 512 + (size_t)(k - 256) * 512 + ((r - 512) >> 6) * 128 + ((r - 512) & 63)]; }
        else { if (k >= 256) v = a.mla_w_ukv[(size_t)l * 128 * 512 + (size_t)(k - 256) * 512 + ((r - 768) >> 6) * 128 + 64 + ((r - 768) & 63)]; }
        ((bf16_t*)(ws + WS_WMLA))[e] = (bf16_t)(cvtpk(v, 0.f) & 0xffffu);
    }
    for (int e = gt; e < SEQ * 16; e += NGT) {
        const int t = e >> 4, i = e & 15;
        const float ang = (float)t * powf(10000.0f, -(float)i / 16.0f);
        ((float*)(ws + WS_ROPE))[2 * e] = cosf(ang); ((float*)(ws + WS_ROPE))[2 * e + 1] = sinf(ang);
    }
    for (size_t e = gt; e < (size_t)M_TOK * DM / 8; e += NGT) {
        const f32x4 v0 = *(const f32x4*)(a.x + e * 8), v1 = *(const f32x4*)(a.x + e * 8 + 4);
        u32x4 o; o.x = cvtpk(v0[0], v0[1]); o.y = cvtpk(v0[2], v0[3]); o.z = cvtpk(v1[0], v1[1]); o.w = cvtpk(v1[2], v1[3]);
        *(u32x4*)((bf16_t*)(ws + WS_XB) + e * 8) = o;
    }
}

__device__ __forceinline__ void p2_mla_prep(const Ctx& C, const Args& a, int layer) {
    const bf16_t* HB = (const bf16_t*)(a.ws + WS_HB); bf16_t* CN = (bf16_t*)(a.ws + WS_CN); bf16_t* KR = (bf16_t*)(a.ws + WS_KR);
    const float* rope = (const float*)(a.ws + WS_ROPE);
    const float* gq = a.mla_q_norm + layer * 256; const float* gkv = a.mla_kv_norm + layer * 128;
    const int gw = C.vcu * NWAVES + C.wid, NGW = C.G * NWAVES, lane = C.lane;
    const f32x4 g4 = *(const f32x4*)(gq + 4 * lane); const float g20 = gkv[2 * lane], g21 = gkv[2 * lane + 1];
    for (int m = gw; m < M_TOK; m += NGW) {
        const bf16_t* hr = HB + (size_t)m * NV;
        const u32x2 q = *(const u32x2*)(hr + V_DCQ + 4 * lane);
        const unsigned kv = *(const unsigned*)(hr + V_DCKV + 2 * lane);
        const float q0 = bflo(q.x), q1 = bfhi(q.x), q2 = bflo(q.y), q3 = bfhi(q.y), k0 = bflo(kv), k1 = bfhi(kv);
        const float sq = wave_sum((q0 * q0 + q1 * q1) + (q2 * q2 + q3 * q3)), sk = wave_sum(k0 * k0 + k1 * k1);
        const float rq = 1.0f / sqrtf(sq * (1.0f / 256.0f) + 1e-6f), rk = 1.0f / sqrtf(sk * (1.0f / 128.0f) + 1e-6f);
        u32x2 oq; oq.x = cvtpk(q0 * rq * g4[0], q1 * rq * g4[1]); oq.y = cvtpk(q2 * rq * g4[2], q3 * rq * g4[3]);
        *(u32x2*)(CN + (size_t)m * 384 + 4 * lane) = oq;
        *(unsigned*)(CN + (size_t)m * 384 + 256 + 2 * lane) = cvtpk(k0 * rk * g20, k1 * rk * g21);
        if (lane < 16) {
            const float x1 = bf2f(hr[V_DKR + lane]), x2 = bf2f(hr[V_DKR + 16 + lane]);
            const float c = rope[((m & (SEQ - 1)) * 16 + lane) * 2], s = rope[((m & (SEQ - 1)) * 16 + lane) * 2 + 1];
            KR[(size_t)m * 32 + lane] = (bf16_t)(cvtpk(x1 * c - x2 * s, 0.f) & 0xffffu);
            KR[(size_t)m * 32 + 16 + lane] = (bf16_t)(cvtpk(x1 * s + x2 * c, 0.f) & 0xffffu);
        }
    }
}

__device__ __forceinline__ int wave_sum_dpp(int v) {
    v += __builtin_amdgcn_update_dpp(0, v, 0xB1, 0xf, 0xf, false);
    v += __builtin_amdgcn_update_dpp(0, v, 0x4E, 0xf, 0xf, false);
    v += __builtin_amdgcn_update_dpp(0, v, 0x141, 0xf, 0xf, false);
    v += __builtin_amdgcn_update_dpp(0, v, 0x140, 0xf, 0xf, false);
    return __builtin_amdgcn_readlane(v, 0) + __builtin_amdgcn_readlane(v, 16) + __builtin_amdgcn_readlane(v, 32) + __builtin_amdgcn_readlane(v, 48);
}
__device__ __forceinline__ unsigned wave_max_dpp(unsigned v) {
    unsigned o;
    o = (unsigned)__builtin_amdgcn_update_dpp(0, (int)v, 0xB1, 0xf, 0xf, false); v = v > o ? v : o;
    o = (unsigned)__builtin_amdgcn_update_dpp(0, (int)v, 0x4E, 0xf, 0xf, false); v = v > o ? v : o;
    o = (unsigned)__builtin_amdgcn_update_dpp(0, (int)v, 0x141, 0xf, 0xf, false); v = v > o ? v : o;
    o = (unsigned)__builtin_amdgcn_update_dpp(0, (int)v, 0x140, 0xf, 0xf, false); v = v > o ? v : o;
    const unsigned a = __builtin_amdgcn_readlane((int)v, 0), b = __builtin_amdgcn_readlane((int)v, 16), c = __builtin_amdgcn_readlane((int)v, 32), d = __builtin_amdgcn_readlane((int)v, 48);
    const unsigned ab = a > b ? a : b, cd = c > d ? c : d; return ab > cd ? ab : cd;
}
__device__ __forceinline__ unsigned wave_min_dpp(unsigned v) { return ~wave_max_dpp(~v); }
__device__ __forceinline__ unsigned sel_key(float v) { const unsigned bits = __float_as_uint(v + 0.0f); return (bits & 0x80000000u) ? ~bits : (bits | 0x80000000u); }
__device__ __forceinline__ unsigned sel_words(const unsigned (&u)[32], unsigned T, bool exact, int lane) {
    unsigned myword = 0u;
    if (exact) {
#pragma unroll
        for (int i = 0; i < 32; ++i) {
            const unsigned long long bal = __ballot(u[i] >= T);
            if ((lane >> 1) == i) myword = (lane & 1) ? (unsigned)(bal >> 32) : (unsigned)bal;
            __builtin_amdgcn_sched_barrier(0);
        }
    } else {
        int cgt = 0;
#pragma unroll
        for (int i = 0; i < 32; ++i) cgt += __popcll(__ballot(u[i] > T));
        const int need = 256 - cgt;
        int running = 0;
        const unsigned long long ltmask = (1ull << lane) - 1ull;
#pragma unroll
        for (int i = 0; i < 32; ++i) {
            const unsigned long long eq = __ballot(u[i] == T);
            const int pre = running + __popcll(eq & ltmask);
            const bool selb = (u[i] > T) || ((u[i] == T) && (pre < need));
            const unsigned long long bal = __ballot(selb);
            running += __popcll(eq);
            if ((lane >> 1) == i) myword = (lane & 1) ? (unsigned)(bal >> 32) : (unsigned)bal;
            __builtin_amdgcn_sched_barrier(0);
        }
    }
    return myword;
}
__device__ __forceinline__ void sel_step(const Ctx& C, const Args& a, int b, int j) {
    const bf16_t* HB = (const bf16_t*)(a.ws + WS_HB); unsigned* SEL = (unsigned*)(a.ws + WS_SEL);
    LAS float* sc_lds = (LAS float*)C.lds;
    int lane_op = C.lane; asm volatile("" : "+v"(lane_op));
    const int lane = lane_op, wid = C.wid, t0 = 16 * j;
    const size_t rb = (size_t)b * SEQ;
    if (t0 + 15 < 256) {
#pragma unroll
        for (int rr = 0; rr < 2; ++rr) SEL[(rb + t0 + 2 * wid + rr) * 64 + lane] = 0xFFFFFFFFu;
        return;
    }
    const int nkt = j + 1;
    {
        const int q = lane & 15, kq = lane >> 4;
        const bf16_t* qrow = HB + (rb + t0 + q) * NV;
        bf16x8 ak[16];
#pragma unroll
        for (int i = 0; i < 16; ++i) { const int kt = wid + 8 * i; if (kt < nkt) ak[i] = *(const bf16x8*)(HB + (rb + 16 * kt + q) * NV + V_CIK + 8 * kq); }
        bf16x8 bq[8];
#pragma unroll
        for (int h = 0; h < 8; ++h) bq[h] = *(const bf16x8*)(qrow + V_CIQ + h * 32 + 8 * kq);
        const u32x4 wv = *(const u32x4*)(qrow + V_CIW);
        float w[8]; const float wsc = 0.35355339059327373f * 0.17677669529663687f;
        w[0] = bflo(wv.x) * wsc; w[1] = bfhi(wv.x) * wsc; w[2] = bflo(wv.y) * wsc; w[3] = bfhi(wv.y) * wsc;
        w[4] = bflo(wv.z) * wsc; w[5] = bfhi(wv.z) * wsc; w[6] = bflo(wv.w) * wsc; w[7] = bfhi(wv.w) * wsc;
        for (int rep = 0; rep < NREP(9); ++rep)
#pragma unroll
        for (int i = 0; i < 16; ++i) { const int kt = wid + 8 * i;
            if (kt < nkt) {
                f32x4 s = {0.f, 0.f, 0.f, 0.f};
#pragma unroll
                for (int h = 0; h < 8; ++h) { const f32x4 d = mfma16(ak[i], bq[h], (f32x4){0.f, 0.f, 0.f, 0.f});
#pragma unroll
                    for (int e = 0; e < 4; ++e) s[e] = fmaf(w[h], fmaxf(d[e], 0.f), s[e]); }
                *(LAS f32x4*)(sc_lds + q * SEL_RS + 16 * kt + 4 * kq) = s;
            } }
    }
    __syncthreads();
    {
        const int qa = 2 * wid, ta = t0 + qa, tb = ta + 1;
        unsigned ua[32], ub[32];
#pragma unroll
        for (int i = 0; i < 32; ++i) { const int key = lane + 64 * i;
            const int kca = key <= ta ? key : ta, kcb = key <= tb ? key : tb;
            const float va = sc_lds[qa * SEL_RS + kca], vb = sc_lds[(qa + 1) * SEL_RS + kcb];
            const unsigned ka = sel_key(va), kb = sel_key(vb);
            ua[i] = (key <= ta) ? ka : 0u; ub[i] = (key <= tb) ? kb : 0u; }
        unsigned Ta = 0u, Tb = 0u; bool ea = false, eb = false;
        for (int rep = 0; rep < NREP(10); ++rep) { Ta = 0u; Tb = 0u; ea = false; eb = false;
#pragma unroll 1
        for (int bit = 31; bit >= 0; --bit) {
            const unsigned xa = ea ? Ta : (Ta | (1u << bit)), xb = eb ? Tb : (Tb | (1u << bit));
            int la = 0, lb = 0;
#pragma unroll
            for (int g = 0; g < 8; ++g) {
                unsigned long long m0, m1, m2, m3, n0, n1, n2, n3;
                asm("v_cmp_le_u32 %2, %10, %12\n\tv_cmp_le_u32 %6, %11, %16\n\tv_cmp_le_u32 %3, %10, %13\n\tv_cmp_le_u32 %7, %11, %17\n\t"
                    "v_cmp_le_u32 %4, %10, %14\n\tv_cmp_le_u32 %8, %11, %18\n\tv_cmp_le_u32 %5, %10, %15\n\tv_cmp_le_u32 %9, %11, %19\n\t"
                    "v_addc_co_u32_e64 %0, vcc, 0, %0, %2\n\tv_addc_co_u32_e64 %1, vcc, 0, %1, %6\n\tv_addc_co_u32_e64 %0, vcc, 0, %0, %3\n\tv_addc_co_u32_e64 %1, vcc, 0, %1, %7\n\t"
                    "v_addc_co_u32_e64 %0, vcc, 0, %0, %4\n\tv_addc_co_u32_e64 %1, vcc, 0, %1, %8\n\tv_addc_co_u32_e64 %0, vcc, 0, %0, %5\n\tv_addc_co_u32_e64 %1, vcc, 0, %1, %9"
                    : "+v"(la), "+v"(lb), "=&s"(m0), "=&s"(m1), "=&s"(m2), "=&s"(m3), "=&s"(n0), "=&s"(n1), "=&s"(n2), "=&s"(n3)
                    : "v"(xa), "v"(xb), "v"(ua[4 * g]), "v"(ua[4 * g + 1]), "v"(ua[4 * g + 2]), "v"(ua[4 * g + 3]), "v"(ub[4 * g]), "v"(ub[4 * g + 1]), "v"(ub[4 * g + 2]), "v"(ub[4 * g + 3]) : "vcc");
            }
            const int ca = wave_sum_dpp(la), cb = wave_sum_dpp(lb);
            if (!ea && ca >= 256) { Ta = xa; ea = (ca == 256); }
            if (!eb && cb >= 256) { Tb = xb; eb = (cb == 256); }
            if (ea && eb) break;
        }
        }
        SEL[(rb + ta) * 64 + lane] = sel_words(ua, Ta, ea, lane);
        SEL[(rb + tb) * 64 + lane] = sel_words(ub, Tb, eb, lane);
    }
    __syncthreads();
}
__device__ __forceinline__ void p2_select(const Ctx& C, const Args& a) {
    for (int v = C.vcu; v < NB * 16; v += C.G) {
        const int b = v >> 4, p = v & 15;
#pragma unroll 1
        for (int i = 0; i < 8; ++i) { const int j = (i & 1) ? (32 * (i >> 1) + 31 - p) : (32 * (i >> 1) + p); sel_step(C, a, b, j); }
    }
}

struct TileRegs { u32x4 k0, k1, v; };
struct AttnSrc { const bf16_t* Kp; int kpitch; const bf16_t* Kr; const bf16_t* Vp; int vpitch; };
template <int NCH>
__device__ __forceinline__ void tile_load(TileRegs& r, const AttnSrc& s, int key0, int wid, int lane) {
    r.k0 = *(const u32x4*)(s.Kp + (size_t)(key0 + lane) * s.kpitch + wid * 8);
    if (NCH == 12) { if (wid < 4) r.k1 = *(const u32x4*)(s.Kr + (size_t)(key0 + lane) * 32 + wid * 8); }
    r.v = *(const u32x4*)(s.Vp + (size_t)(key0 + 16 * (wid & 3) + (lane >> 2)) * s.vpitch + (wid >> 2) * 32 + (lane & 3) * 8);
}
template <int NCH>
__device__ __forceinline__ void tile_write(const TileRegs& r, LAS unsigned char* kb, LAS unsigned char* vb, int wid, int lane) {
    *(LAS u32x4*)(kb + wid * 1024 + lane * 16) = r.k0;
    if (NCH == 12) { if (wid < 4) *(LAS u32x4*)(kb + (8 + wid) * 1024 + lane * 16) = r.k1; }
    *(LAS u32x4*)(vb + wid * 1024 + lane * 16) = r.v;
}
template <int ND>
__device__ __forceinline__ void qk_tile(f32x16& p0, f32x16& p1, LAS const unsigned char* kb, int cb, const bf16x8* qf, int r32, int hi) {
#pragma unroll
    for (int d0 = 0; d0 < ND; ++d0) {
        const bf16x8 a0 = *(LAS const bf16x8*)(kb + (cb + 2 * d0 + hi) * 1024 + r32 * 16);
        const bf16x8 a1 = *(LAS const bf16x8*)(kb + (cb + 2 * d0 + hi) * 1024 + 512 + r32 * 16);
        p0 = mfma32(a0, qf[d0], p0); p1 = mfma32(a1, qf[d0], p1);
    }
}
__device__ __forceinline__ bf16x8 pack8(const f32x16& p, int base) {
    u32x4 w; w.x = cvtpk(p[base + 0], p[base + 1]); w.y = cvtpk(p[base + 2], p[base + 3]); w.z = cvtpk(p[base + 4], p[base + 5]); w.w = cvtpk(p[base + 6], p[base + 7]);
    return __builtin_bit_cast(bf16x8, w);
}
__device__ __forceinline__ void pv_half(f32x16 (&o)[2], LAS const unsigned char* vb, int lane, int hi, int ks0, bf16x8 pa, bf16x8 pb) {
    LAS const unsigned char* vp = vb + ((lane >> 4) & 1) * 32 + (lane & 3) * 8 + (4 * hi + ((lane & 15) >> 2)) * 64;
#pragma unroll
    for (int d0 = 0; d0 < 2; ++d0) {
#pragma unroll
        for (int k = 0; k < 2; ++k) {
            const v4i16_t lo = vtr(vp + d0 * 4096 + (ks0 + k) * 1024), hh = vtr(vp + d0 * 4096 + (ks0 + k) * 1024 + 512);
            const bf16x8 vf = {lo[0], lo[1], lo[2], lo[3], hh[0], hh[1], hh[2], hh[3]};
            o[d0] = mfma32(vf, k == 0 ? pa : pb, o[d0]);
        }
    }
}
__device__ __forceinline__ void store_gated(const f32x16 (&o)[2], const bf16_t* HB, bf16_t* OB, size_t row, int colg, int hi) {
#pragma unroll
    for (int d0 = 0; d0 < 2; ++d0)
#pragma unroll
        for (int g4 = 0; g4 < 4; ++g4) {
            const int d = 32 * d0 + 8 * g4 + 4 * hi;
            const u32x2 g = *(const u32x2*)(HB + row * NV + V_GATE + colg + d);
            u32x2 w; w.x = cvtpk(o[d0][4 * g4 + 0] * bflo(g.x), o[d0][4 * g4 + 1] * bfhi(g.x)); w.y = cvtpk(o[d0][4 * g4 + 2] * bflo(g.y), o[d0][4 * g4 + 3] * bfhi(g.y));
            *(u32x2*)(OB + row * DM + colg + d) = w;
        }
}

struct SmState { float m, l; f32x16 o[2]; };
__device__ __forceinline__ void sm_stats(SmState& st, f32x16& x0, f32x16& x1) {
    float mx = x0[0];
#pragma unroll
    for (int r = 1; r < 16; ++r) mx = fmaxf(mx, x0[r]);
#pragma unroll
    for (int r = 0; r < 16; ++r) mx = fmaxf(mx, x1[r]);
    mx = xhalf_max(mx);
    const float mn = fmaxf(st.m, mx);
    const float ms = (mn == -INFINITY) ? 0.f : mn;
    float ls = 0.f;
#pragma unroll
    for (int r = 0; r < 16; ++r) { x0[r] = __builtin_amdgcn_exp2f(x0[r] - ms); x1[r] = __builtin_amdgcn_exp2f(x1[r] - ms); ls += x0[r] + x1[r]; }
    if (__any(mn != st.m)) {
        const float alpha = __builtin_amdgcn_exp2f(st.m - ms);
        st.l *= alpha;
#pragma unroll
        for (int r = 0; r < 16; ++r) { st.o[0][r] *= alpha; st.o[1][r] *= alpha; }
    }
    st.l += ls; st.m = mn;
}
__device__ __forceinline__ void v_frags(bf16x8 (&vf)[2][4], LAS const unsigned char* vb, int lane, int hi) {
    LAS const unsigned char* vp = vb + ((lane >> 4) & 1) * 32 + (lane & 3) * 8 + (4 * hi + ((lane & 15) >> 2)) * 64;
#pragma unroll
    for (int d0 = 0; d0 < 2; ++d0)
#pragma unroll
        for (int ks = 0; ks < 4; ++ks) {
            const v4i16_t lo = vtr(vp + d0 * 4096 + ks * 1024), hh = vtr(vp + d0 * 4096 + ks * 1024 + 512);
            vf[d0][ks] = (bf16x8){lo[0], lo[1], lo[2], lo[3], hh[0], hh[1], hh[2], hh[3]};
        }
}
__device__ __forceinline__ void pv_tile(f32x16 (&o)[2], const bf16x8 (&vf)[2][4], const f32x16& x0, const f32x16& x1) {
    const bf16x8 p0 = pack8(x0, 0), p1 = pack8(x0, 8), p2 = pack8(x1, 0), p3 = pack8(x1, 8);
#pragma unroll
    for (int d0 = 0; d0 < 2; ++d0) { o[d0] = mfma32(vf[d0][0], p0, o[d0]); o[d0] = mfma32(vf[d0][1], p1, o[d0]); o[d0] = mfma32(vf[d0][2], p2, o[d0]); o[d0] = mfma32(vf[d0][3], p3, o[d0]); }
}

template <int MODE>
__device__ __forceinline__ void attn_unit_sm(const Ctx& C, const Args& a, int layer, int b, int h, int qb) {
    constexpr int NCH = (MODE == 3) ? 12 : 8;
    const bf16_t* HB = (const bf16_t*)(a.ws + WS_HB); const bf16_t* MD = (const bf16_t*)(a.ws + WS_MD); const bf16_t* KR = (const bf16_t*)(a.ws + WS_KR);
    bf16_t* OB = (bf16_t*)(a.ws + WS_XB); const unsigned* SEL = (const unsigned*)(a.ws + WS_SEL);
    int lane_op = C.lane; asm volatile("" : "+v"(lane_op));
    const int lane = lane_op, wid = C.wid, r32 = lane & 31, hi = lane >> 5;
    const size_t rb = (size_t)b * SEQ;
    const int q0 = 256 * qb, tq = q0 + 32 * wid + r32;
    const size_t qrow = rb + tq;
    LAS unsigned char* lds = C.lds;
    LAS float* btab = (LAS float*)(lds + AL_BIAS);
    AttnSrc src;
    if (MODE == 1) { src.Kp = HB + rb * NV + V_BK + h * 64; src.kpitch = NV; src.Kr = nullptr; src.Vp = HB + rb * NV + V_BV + h * 64; src.vpitch = NV; }
    if (MODE == 2) { src.Kp = HB + rb * NV + V_CK + h * 64; src.kpitch = NV; src.Kr = nullptr; src.Vp = HB + rb * NV + V_CV + h * 64; src.vpitch = NV; }
    if (MODE == 3) { src.Kp = MD + rb * DM + MD_KN + h * 64; src.kpitch = DM; src.Kr = KR + rb * 32; src.Vp = MD + rb * DM + MD_V + h * 64; src.vpitch = DM; }
    if (MODE != 3) { if (C.tid <= 128) btab[C.tid] = a.rel_bias[t5_bucket(C.tid) * 8 + (MODE == 2 ? 4 : 0) + h] * LOG2E; }
    const float c1 = (MODE == 1 ? 0.17677669529663687f : (MODE == 2 ? 0.125f : 0.10206207261596577f)) * LOG2E;
    auto qscale = [&](bf16x8 q) { u32x4 w = __builtin_bit_cast(u32x4, q);
#pragma unroll
        for (int i = 0; i < 4; ++i) w[i] = cvtpk(bflo(w[i]) * c1, bfhi(w[i]) * c1);
        return __builtin_bit_cast(bf16x8, w); };
    constexpr int NQ = (MODE == 3) ? 6 : (MODE == 1 ? 1 : 4);
    bf16x8 qf[NQ];
    LAS bf16x8* qlds = (LAS bf16x8*)(lds + AL_Q) + wid * 256 + lane;
    if (MODE == 1) {
#pragma unroll
        for (int d0 = 0; d0 < 4; ++d0) qlds[64 * d0] = qscale(*(const bf16x8*)(HB + qrow * NV + V_BQ + h * 64 + 16 * d0 + 8 * hi)); }
    if (MODE == 2) {
#pragma unroll
        for (int d0 = 0; d0 < 4; ++d0) qf[d0] = qscale(*(const bf16x8*)(HB + qrow * NV + V_CQ + h * 64 + 16 * d0 + 8 * hi)); }
    if (MODE == 3) {
#pragma unroll
        for (int d0 = 0; d0 < 4; ++d0) qf[d0] = qscale(*(const bf16x8*)(MD + qrow * DM + MD_QN + h * 64 + 16 * d0 + 8 * hi));
#pragma unroll
        for (int d0 = 0; d0 < 2; ++d0) qf[4 + d0] = *(const bf16x8*)(MD + qrow * DM + MD_QR + h * 32 + 16 * d0 + 8 * hi);
        const f32x2_t* rp = (const f32x2_t*)(a.ws + WS_ROPE) + (size_t)tq * 16 + 8 * hi;
        u32x4 w4 = __builtin_bit_cast(u32x4, qf[4]), w5 = __builtin_bit_cast(u32x4, qf[5]);
#pragma unroll
        for (int jj = 0; jj < 4; ++jj) {
            const f32x2_t cs0 = rp[2 * jj], cs1 = rp[2 * jj + 1];
            const float a0 = bflo(w4[jj]), a1 = bfhi(w4[jj]), b0 = bflo(w5[jj]), b1 = bfhi(w5[jj]);
            w4[jj] = cvtpk((a0 * cs0.x - b0 * cs0.y) * c1, (a1 * cs1.x - b1 * cs1.y) * c1);
            w5[jj] = cvtpk((a0 * cs0.y + b0 * cs0.x) * c1, (a1 * cs1.y + b1 * cs1.x) * c1);
        }
        qf[4] = __builtin_bit_cast(bf16x8, w4); qf[5] = __builtin_bit_cast(bf16x8, w5); }
    SmState s1, s2;
    s1.m = -INFINITY; s1.l = 0.f; s1.o[0] = f32x16{}; s1.o[1] = f32x16{};
    if (MODE == 1) { s2.m = -INFINITY; s2.l = 0.f; s2.o[0] = f32x16{}; s2.o[1] = f32x16{}; }
    const int NT = 4 * (qb + 1), my_last = 4 * qb + (wid >> 1);
    const int tmin = q0 + 32 * wid;
    TileRegs tr;
    tile_load<NCH>(tr, src, 0, wid, lane);
    tile_write<NCH>(tr, lds + AL_K, lds + AL_V, wid, lane);
    __syncthreads();
#pragma unroll 1
    for (int tt = 0; tt < NT; ++tt) {
        const int cur = tt & 1;
        if (tt + 1 < NT) tile_load<NCH>(tr, src, 64 * (tt + 1), wid, lane);
        if (tt <= my_last) {
            LAS const unsigned char* kb = lds + AL_K + cur * AL_KB; LAS const unsigned char* vb = lds + AL_V + cur * AL_VB;
            const int key0 = 64 * tt;
            const bool diag = (tt == my_last);
            const bool farb = (MODE != 3) && (key0 + 63 + 128 <= tmin);
            const float pinit = farb ? btab[128] : 0.f;
            u32x2 wsel = {0u, 0u};
            if (MODE == 2) wsel = *(const u32x2*)(SEL + qrow * 64 + 2 * tt);
            auto finish_scores = [&](f32x16& p0, f32x16& p1) {
                if (MODE != 3 && !farb) {
#pragma unroll
                    for (int r = 0; r < 16; ++r) { int d0i = tq - (key0 + crow(r, hi)); int d1i = d0i - 32;
                        d0i = d0i < 0 ? 0 : (d0i > 128 ? 128 : d0i); d1i = d1i < 0 ? 0 : (d1i > 128 ? 128 : d1i);
                        p0[r] += btab[d0i]; p1[r] += btab[d1i]; }
                }
                if (diag) {
#pragma unroll
                    for (int r = 0; r < 16; ++r) { const int k0i = key0 + crow(r, hi); if (k0i > tq) p0[r] = -INFINITY; if (k0i + 32 > tq) p1[r] = -INFINITY; }
                }
                if (MODE == 2) {
                    const unsigned w0 = wsel.x >> (4 * hi), w1 = wsel.y >> (4 * hi);
#pragma unroll
                    for (int r = 0; r < 16; ++r) { const int bp = (r & 3) + 8 * (r >> 2); if (!((w0 >> bp) & 1u)) p0[r] = -INFINITY; if (!((w1 >> bp) & 1u)) p1[r] = -INFINITY; }
                }
            };
            f32x16 pz;
#pragma unroll
            for (int r = 0; r < 16; ++r) pz[r] = pinit;
            bf16x8 vf[2][4];
            if (MODE == 1) {
                f32x16 a0 = pz, a1 = pz, b0 = pz, b1 = pz;
                { bf16x8 q2[2] = {qlds[0], qlds[64]}; qk_tile<2>(a0, a1, kb, 0, q2, r32, hi); }
                { bf16x8 q2[2] = {qlds[128], qlds[192]}; qk_tile<2>(b0, b1, kb, 4, q2, r32, hi); }
                finish_scores(a0, a1); sm_stats(s1, a0, a1);
                finish_scores(b0, b1); sm_stats(s2, b0, b1);
                v_frags(vf, vb, lane, hi);
                pv_tile(s1.o, vf, a0, a1); pv_tile(s2.o, vf, b0, b1);
            } else {
                f32x16 p0 = pz, p1 = pz;
                qk_tile<(MODE == 3 ? 6 : 4)>(p0, p1, kb, 0, qf, r32, hi);
                finish_scores(p0, p1); sm_stats(s1, p0, p1);
                v_frags(vf, vb, lane, hi);
                pv_tile(s1.o, vf, p0, p1);
            }
        }
        if (tt + 1 < NT) tile_write<NCH>(tr, lds + AL_K + (cur ^ 1) * AL_KB, lds + AL_V + (cur ^ 1) * AL_VB, wid, lane);
        __syncthreads();
    }
    const float l1 = xhalf_sum(s1.l), il1 = 1.0f / l1;
    if (MODE == 1) {
        const float* dl = a.diff_lambda + layer * 128;
        float a0 = 0.f, a1 = 0.f;
        if (lane < 32) { a0 = dl[lane] * dl[32 + lane]; a1 = dl[64 + lane] * dl[96 + lane]; }
        const float lam_init = (layer == 0) ? 0.2f : 0.35550906779f;
        const float lam = expf(wave_sum(a0)) - expf(wave_sum(a1)) + lam_init;
        const float l2 = xhalf_sum(s2.l), f2 = lam / l2;
        float ss = 0.f;
#pragma unroll
        for (int d0 = 0; d0 < 2; ++d0)
#pragma unroll
            for (int r = 0; r < 16; ++r) { const float v = s1.o[d0][r] * il1 - s2.o[d0][r] * f2; s1.o[d0][r] = v; ss += v * v; }
        ss = xhalf_sum(ss);
        const float rn = (1.0f / sqrtf(ss * (1.0f / 64.0f) + 1e-6f)) * (1.0f - lam_init);
        const float* sg = a.diff_subln + layer * 64;
#pragma unroll
        for (int d0 = 0; d0 < 2; ++d0)
#pragma unroll
            for (int g4 = 0; g4 < 4; ++g4) { const f32x4 gv = *(const f32x4*)(sg + 32 * d0 + 8 * g4 + 4 * hi);
#pragma unroll
                for (int i = 0; i < 4; ++i) s1.o[d0][4 * g4 + i] *= rn * gv[i]; }
    } else {
#pragma unroll
        for (int d0 = 0; d0 < 2; ++d0)
#pragma unroll
            for (int r = 0; r < 16; ++r) s1.o[d0][r] *= il1;
    }
    store_gated(s1.o, HB, OB, qrow, MODE * 256 + h * 64, hi);
}

__device__ __forceinline__ void attn_unit_sb(const Ctx& C, const Args& a, int b, int h, int qb) {
    const bf16_t* HB = (const bf16_t*)(a.ws + WS_HB); bf16_t* OB = (bf16_t*)(a.ws + WS_XB);
    int lane_op = C.lane; asm volatile("" : "+v"(lane_op));
    const int lane = lane_op, wid = C.wid, r32 = lane & 31, hi = lane >> 5;
    const size_t rb = (size_t)b * SEQ;
    const int q0 = 256 * qb, tq = q0 + 32 * wid + r32;
    const size_t qrow = rb + tq;
    LAS unsigned char* lds = C.lds;
    volatile LAS unsigned* flags = (volatile LAS unsigned*)(lds + AL_FLAG);
    AttnSrc src; src.Kp = HB + rb * NV + V_AK + h * 64; src.kpitch = NV; src.Kr = nullptr; src.Vp = HB + rb * NV + V_AV + h * 64; src.vpitch = NV;
    bf16x8 qf[4];
#pragma unroll
    for (int d0 = 0; d0 < 4; ++d0) qf[d0] = *(const bf16x8*)(HB + qrow * NV + V_AQ + h * 64 + 16 * d0 + 8 * hi);
    f32x16 o[2]; o[0] = f32x16{}; o[1] = f32x16{};
    float carry = 0.f;
    const int my_first = 4 * qb + (wid >> 1);
    bool done = false;
    if (C.tid < 3) flags[C.tid] = 0u;
    TileRegs tr;
    int tt = 4 * qb + 3;
    tile_load<8>(tr, src, 64 * tt, wid, lane);
    tile_write<8>(tr, lds + AL_K, lds + AL_V, wid, lane);
    __syncthreads();
    int it = 0;
#pragma unroll 1
    for (;; ++it) {
        const int cur = it & 1, fi = it % 3;
        if (tt > 0) tile_load<8>(tr, src, 64 * (tt - 1), wid, lane);
        if (C.tid == 0) flags[(it + 1) % 3] = 0u;
        if (tt <= my_first && !done) {
            LAS const unsigned char* kb = lds + AL_K + cur * AL_KB; LAS const unsigned char* vb = lds + AL_V + cur * AL_VB;
            f32x16 p0 = f32x16{}, p1 = f32x16{};
            qk_tile<4>(p0, p1, kb, 0, qf, r32, hi);
            const int key0 = 64 * tt;
#pragma unroll
            for (int sub = 1; sub >= 0; --sub) {
                f32x16& p = sub ? p1 : p0;
                float x[16], ls[16];
#pragma unroll
                for (int r = 0; r < 16; ++r) {
                    const float z = p[r] * 0.125f;
                    const float e = __builtin_amdgcn_exp2f(-fabsf(z) * LOG2E);
                    const float sp = fmaxf(z, 0.f) + __builtin_amdgcn_logf(1.0f + e) * LN2;
                    x[r] = -sp;
                    ls[r] = z - sp;
                }
                if (tt == my_first) {
#pragma unroll
                    for (int r = 0; r < 16; ++r) { const bool valid = (key0 + 32 * sub + crow(r, hi)) < tq; x[r] = valid ? x[r] : 0.f; ls[r] = valid ? ls[r] : -INFINITY; __builtin_amdgcn_sched_barrier(0); }
                }
                float ex[16], gs[4];
#pragma unroll
                for (int g = 0; g < 4; ++g) { ex[4 * g + 3] = 0.f; ex[4 * g + 2] = x[4 * g + 3]; ex[4 * g + 1] = ex[4 * g + 2] + x[4 * g + 2]; ex[4 * g + 0] = ex[4 * g + 1] + x[4 * g + 1]; gs[g] = ex[4 * g] + x[4 * g]; }
                float oth[4], pr[4];
#pragma unroll
                for (int g = 0; g < 4; ++g) { oth[g] = xhalf_other(gs[g], hi); pr[g] = gs[g] + oth[g]; }
                float tail[4]; tail[3] = 0.f; tail[2] = pr[3]; tail[1] = pr[3] + pr[2]; tail[0] = tail[1] + pr[1];
                const float total = tail[0] + pr[0];
#pragma unroll
                for (int g = 0; g < 4; ++g) { const float off = carry + tail[g] + (hi == 0 ? oth[g] : 0.f);
#pragma unroll
                    for (int i = 0; i < 4; ++i) p[4 * g + i] = __builtin_amdgcn_exp2f((ls[4 * g + i] + (off + ex[4 * g + i])) * LOG2E); }
                carry += total;
                pv_half(o, vb, lane, hi, 2 * sub, pack8(p, 0), pack8(p, 8));
            }
            done = __all(carry < -104.0f);
        }
        const bool want = (tt > 0) && !((tt <= my_first) && done);
        if (want && lane == 0) flags[fi] = 1u;
        if (tt > 0) tile_write<8>(tr, lds + AL_K + (cur ^ 1) * AL_KB, lds + AL_V + (cur ^ 1) * AL_VB, wid, lane);
        __syncthreads();
        if (flags[fi] == 0u) break;
        --tt;
    }
    store_gated(o, HB, OB, qrow, 0 * 256 + h * 64, hi);
    __syncthreads();
}

__device__ __forceinline__ void p4_attention(const Ctx& C, const Args& a, int layer) {
    const int npair = 3 * NB * 16;
    for (int u = C.vcu; u < npair; u += C.G) {
        const int g = u / (NB * 16), rem = u % (NB * 16), b = rem >> 4, h = (rem >> 2) & 3, p = rem & 3;
#pragma unroll 1
        for (int k = 0; k < 2; ++k) {
            const int qb = k ? 7 - p : p;
            if (g == 0) { if (HAS(9)) attn_unit_sm<1>(C, a, layer, b, h, qb); }
            else if (g == 1) { if (HAS(10)) attn_unit_sm<2>(C, a, layer, b, h, qb); }
            else { if (HAS(11)) attn_unit_sm<3>(C, a, layer, b, h, qb); }
        }
    }
    for (int u = C.vcu; u < NB * 32; u += C.G) { const int b = u >> 5, h = (u >> 3) & 3, qb = u & 7; if (HAS(8)) attn_unit_sb(C, a, b, h, qb); }
}

__device__ __forceinline__ void p6_layernorm(const Ctx& C, const Args& a, int layer) {
    const float* Z = (const float*)(a.ws + WS_HB); bf16_t* XB = (bf16_t*)(a.ws + WS_XB);
    const float* g = a.ln_g + layer * DM; const float* bb = a.ln_b + layer * DM;
    const int gw = C.vcu * NWAVES + C.wid, NGW = C.G * NWAVES, lane = C.lane;
    f32x4 gv[4], bv[4];
#pragma unroll
    for (int j = 0; j < 4; ++j) { gv[j] = *(const f32x4*)(g + 256 * j + 4 * lane); bv[j] = *(const f32x4*)(bb + 256 * j + 4 * lane); }
    for (int m = gw; m < M_TOK; m += NGW) {
        f32x4 v[4]; float s = 0.f;
#pragma unroll
        for (int j = 0; j < 4; ++j) { v[j] = *(const f32x4*)(Z + (size_t)m * DM + 256 * j + 4 * lane); s += (v[j][0] + v[j][1]) + (v[j][2] + v[j][3]); }
        const float mean = wave_sum(s) * (1.0f / DM); float s2 = 0.f;
#pragma unroll
        for (int j = 0; j < 4; ++j) { v[j] = v[j] - mean; s2 += (v[j][0] * v[j][0] + v[j][1] * v[j][1]) + (v[j][2] * v[j][2] + v[j][3] * v[j][3]); }
        const float rstd = 1.0f / sqrtf(wave_sum(s2) * (1.0f / DM) + 1e-5f);
#pragma unroll
        for (int j = 0; j < 4; ++j) { const f32x4 o = v[j] * rstd * gv[j] + bv[j];
            *(f32x4*)(a.out + (size_t)m * DM + 256 * j + 4 * lane) = o;
            if (layer + 1 < DEPTH) { u32x2 w; w.x = cvtpk(o[0], o[1]); w.y = cvtpk(o[2], o[3]); *(u32x2*)(XB + (size_t)m * DM + 256 * j + 4 * lane) = w; } }
    }
}

#define RLX_AGENT __ATOMIC_RELAXED, __HIP_MEMORY_SCOPE_AGENT
#define XB_TMO      128
#define XB_XCNT(j)  (256  + 64 * (j))
#define XB_XSUB(j)  (1280 + 64 * (j))
#define XB_XGEN(j)  (2304 + 64 * (j))
#define XB_TOP      3328
#define XB_TOPGEN   3392
#define XCD_BAR_WORDS 3456
#define XB_SPIN_CAP (1u << 18)

__device__ __forceinline__ unsigned xb_ld(unsigned* p)              { return __hip_atomic_load(p, __ATOMIC_RELAXED, __HIP_MEMORY_SCOPE_AGENT); }
__device__ __forceinline__ unsigned xb_add(unsigned* p, unsigned v) { return __hip_atomic_fetch_add(p, v, __ATOMIC_RELAXED, __HIP_MEMORY_SCOPE_AGENT); }
__device__ __forceinline__ unsigned xb_xcc_id() { return (unsigned)__builtin_amdgcn_s_getreg((3 << 11) | 20) & 0xFu; }
#define XB_SPIN(cond, bar) do { unsigned _sp = 0; while (cond) { __builtin_amdgcn_s_sleep(1); \
    if ((++_sp & 255u) == 0u) { if (xb_ld(&(bar)[XB_TMO])) break; if (_sp > XB_SPIN_CAP) { atomicAdd(&(bar)[XB_TMO], 1u); break; } } } } while (0)

struct XcdBarrier {
    unsigned* bar; unsigned x;
    volatile LAS unsigned* st;
};

__device__ __forceinline__ XcdBarrier xcd_barrier_post(unsigned* bar, volatile LAS unsigned* st, bool leader) {
    XcdBarrier b; b.bar = bar; b.x = xb_xcc_id(); b.st = st;
    if (leader) (void)xb_add(&bar[XB_XCNT(b.x)], 1u);
    return b;
}
__device__ __forceinline__ void xcd_barrier_complete(unsigned* bar, unsigned x, unsigned& nloc, unsigned& nx) {
    const unsigned G = gridDim.x * gridDim.y * gridDim.z;
    unsigned sum, cnt, mine, sp = 0u;
    for (;;) {
        sum = 0u; cnt = 0u; mine = 0u;
#pragma unroll
        for (unsigned j = 0; j < 16; ++j) { const unsigned c = xb_ld(&bar[XB_XCNT(j)]); sum += c; cnt += (c > 0u) ? 1u : 0u; mine = (j == x) ? c : mine; }
        if (sum == G) break;
        __builtin_amdgcn_s_sleep(1);
        if ((++sp & 255u) == 0u) { if (xb_ld(&bar[XB_TMO])) break; if (sp > XB_SPIN_CAP) { atomicAdd(&bar[XB_TMO], 1u); break; } }
    }
    nloc = mine > 0u ? mine : 1u; nx = cnt > 0u ? cnt : 1u;
}

__device__ __forceinline__ void xcd_barrier(const XcdBarrier& b, bool leader) {
    asm volatile("s_waitcnt vmcnt(0)" ::: "memory");
    __syncthreads();
    if (leader) {
        unsigned* bar = b.bar;
        __builtin_amdgcn_s_waitcnt(0);
        unsigned nloc = b.st[0], nx = b.st[1];
        if (nloc == 0u) { xcd_barrier_complete(bar, b.x, nloc, nx); b.st[0] = nloc; b.st[1] = nx; }
        const unsigned old = xb_add(&bar[XB_XSUB(b.x)], 1u);
        const unsigned gen = old / nloc;
        if (old + 1u == (gen + 1u) * nloc) {
            __builtin_amdgcn_fence(__ATOMIC_RELEASE, "agent");
            asm volatile("s_waitcnt vmcnt(0)" ::: "memory");
            const unsigned og = xb_add(&bar[XB_TOP], 1u);
            const unsigned tg = og / nx;
            if (og + 1u == (tg + 1u) * nx) xb_add(&bar[XB_TOPGEN], 1u);
            else XB_SPIN(xb_ld(&bar[XB_TOPGEN]) == tg, bar);
            __builtin_amdgcn_fence(__ATOMIC_ACQUIRE, "agent");
            xb_add(&bar[XB_XGEN(b.x)], 1u);
            asm volatile("s_waitcnt vmcnt(0)" ::: "memory");
        } else {
            XB_SPIN(xb_ld(&bar[XB_XGEN(b.x)]) == gen, bar);
            __builtin_amdgcn_fence(__ATOMIC_ACQUIRE, "agent");
            asm volatile("s_waitcnt vmcnt(0)" ::: "memory");
        }
    }
    __syncthreads();
}

constexpr int N_PHASES = 1 + 6 * DEPTH;
#define IN(k) (lo <= (k) && (k) < hi)
#if DIAG
#define SEAM(k) do { } while (0)
#else
#define SEAM(k) do { if (IN(k) && IN((k) + 1)) { if ((k) == 0) grid.sync(); else { xcd_barrier(bar, C.wid == 0 && C.lane == 0); if (REP_PH == 8) xcd_barrier(bar, C.wid == 0 && C.lane == 0); } } } while (0)
#endif
#define REFRESH() do { int l_op; asm volatile("v_mbcnt_lo_u32_b32 %0, -1, 0\n\tv_mbcnt_hi_u32_b32 %0, -1, %0" : "=v"(l_op)); C.lane = l_op; C.tid = C.wid * 64 + l_op; \
        size_t z_op = 0; asm volatile("" : "+s"(z_op)); al.ws = a.ws + z_op; } while (0)
template <int layer>
__device__ __forceinline__ void layer_body(Ctx& C, const Args& a, Args& al, const int lo, const int hi, cg::grid_group& grid, const XcdBarrier& bar) {
        const int pb = 1 + 6 * layer;
        for (int rep = 0; rep < NREP(1); ++rep) if (HAS(1) && IN(pb)) {
            REFRESH();
            pg8::Gemm g{(const pg8::bf16_t*)(al.ws + WS_XB), (const pg8::bf16_t*)(al.ws + WS_WIN) + (size_t)layer * NV * DM, M_TOK, NV, DM};
            pg8::StaticOrder S; S.init(M_TOK, NV, C.G, (int)blockIdx.x);
            pg8::EpiMain E{(pg8::bf16_t*)(al.ws + WS_HB), NV, 12};
            pg8::gemm_phase<pg8::EpiMain, pg8::StaticOrder, true, true>(C.lds, g, S, E, C.wid);
        }
        SEAM(pb);
        if (IN(pb + 1)) { for (int rep = 0; rep < NREP(2); ++rep) if (HAS(2)) { REFRESH(); p2_mla_prep(C, al, layer); } for (int rep = 0; rep < NREP(7); ++rep) if (HAS(7)) { REFRESH(); p2_select(C, al); } }
        SEAM(pb + 1);
        for (int rep = 0; rep < NREP(3); ++rep) if (HAS(3) && IN(pb + 2)) {
            REFRESH();
            pg8::Gemm g{(const pg8::bf16_t*)(al.ws + WS_CN), (const pg8::bf16_t*)(al.ws + WS_WMLA) + (size_t)layer * 1024 * 384, M_TOK, 1024, 384};
            pg8::StaticOrder S; S.init(M_TOK, 1024, C.G, (int)blockIdx.x);
            pg8::EpiMain E{(pg8::bf16_t*)(al.ws + WS_MD), DM, 1 << 30};
            pg8::gemm_phase<pg8::EpiMain, pg8::StaticOrder, true, true>(C.lds, g, S, E, C.wid);
        }
        SEAM(pb + 2);
        for (int rep = 0; rep < NREP(4); ++rep) if (HAS(4) && IN(pb + 3)) { REFRESH(); p4_attention(C, al, layer); }
        SEAM(pb + 3);
        for (int rep = 0; rep < NREP(5); ++rep) if (HAS(5) && IN(pb + 4)) {
            REFRESH();
            pg8::Gemm g{(const pg8::bf16_t*)(al.ws + WS_XB), (const pg8::bf16_t*)(al.ws + WS_WOUT) + (size_t)layer * DM * DM, M_TOK, DM, DM};
            pg8::StaticOrder S; S.init(M_TOK, DM, C.G, (int)blockIdx.x);
            pg8::EpiOut E{layer == 0 ? al.x : al.out, (float*)(al.ws + WS_HB), ALPHA_RES};
            pg8::gemm_phase<pg8::EpiOut, pg8::StaticOrder, true, true>(C.lds, g, S, E, C.wid);
        }
        SEAM(pb + 4);
        for (int rep = 0; rep < NREP(6); ++rep) if (HAS(6) && IN(pb + 5)) { REFRESH(); p6_layernorm(C, al, layer); }
        SEAM(pb + 5);
}
__global__ void __launch_bounds__(NTHREADS, 2) mega_fwd(Args a) {
    extern __shared__ __attribute__((aligned(16))) unsigned char lds_raw[];
    cg::grid_group grid = cg::this_grid();
    Ctx C; C.lds = (LAS unsigned char*)lds_raw; C.tid = threadIdx.x; C.lane = C.tid & 63; C.wid = __builtin_amdgcn_readfirstlane(C.tid >> 6);
    C.G = gridDim.x; { const int bx = blockIdx.x; C.vcu = (C.G % 8 == 0) ? (bx % 8) * (C.G / 8) + bx / 8 : bx; }
    const int lo = a.ph_lo, hi = a.ph_hi;
    Args al = a;
    volatile LAS unsigned* MISC = (volatile LAS unsigned*)(C.lds + LDS_CTL);
    if (C.tid < 16) MISC[C.tid] = 0u;
    __syncthreads();
    XcdBarrier bar = xcd_barrier_post((unsigned*)(a.ws + WS_CTL), MISC, C.tid == 0);
    for (int rep = 0; rep < NREP(0); ++rep) if (HAS(0) && IN(0)) { REFRESH(); p0_prologue(C, al); } SEAM(0);
    layer_body<0>(C, a, al, lo, hi, grid, bar);
    layer_body<1>(C, a, al, lo, hi, grid, bar);
}
#undef IN
#undef SEAM

#if !DIAG
extern "C" void kernel_launch(void* const* d_in, const int* in_sizes, int n_in, void* d_out, int out_size, void* d_ws, size_t ws_size, hipStream_t stream) {
    static int grid = 0;
    if (grid == 0) {
        if (n_in != 12 || in_sizes[0] != M_TOK * DM || out_size != M_TOK * DM || ws_size < WS_END) {
            fprintf(stderr, "kernel_launch: unexpected shapes (n_in %d, x %d, out %d, ws %zu, need %zu); nothing launched\n", n_in, n_in > 0 ? in_sizes[0] : -1, out_size, ws_size, (size_t)WS_END); grid = -1; return; }
        int dev = 0, cus = 0, per_cu = 0;
        (void)hipGetDevice(&dev); (void)hipDeviceGetAttribute(&cus, hipDeviceAttributeMultiprocessorCount, dev);
        if (hipFuncSetAttribute((const void*)mega_fwd, hipFuncAttributeMaxDynamicSharedMemorySize, LDS_BYTES) != hipSuccess) { fprintf(stderr, "kernel_launch: hipFuncSetAttribute failed\n"); grid = -1; return; }
        if (hipOccupancyMaxActiveBlocksPerMultiprocessor(&per_cu, (const void*)mega_fwd, NTHREADS, LDS_BYTES) != hipSuccess || per_cu < 1) { fprintf(stderr, "kernel_launch: occupancy query says %d blocks per CU\n", per_cu); per_cu = 1; }
        (void)hipGetLastError();
        grid = cus;
    }
    if (grid < 0) return;
    Args a{};
    a.x = (const float*)d_in[0]; a.w_in = (const float*)d_in[1]; a.w_out = (const float*)d_in[2]; a.ln_g = (const float*)d_in[3]; a.ln_b = (const float*)d_in[4];
    a.rel_bias = (const float*)d_in[5]; a.diff_lambda = (const float*)d_in[6]; a.diff_subln = (const float*)d_in[7]; a.mla_q_norm = (const float*)d_in[8];
    a.mla_kv_norm = (const float*)d_in[9]; a.mla_w_uq = (const float*)d_in[10]; a.mla_w_ukv = (const float*)d_in[11];
    a.out = (float*)d_out; a.ws = (unsigned char*)d_ws; a.ph_lo = 0; a.ph_hi = N_PHASES;
    if (hipMemsetAsync(d_ws, 0, 16384, stream) != hipSuccess) { fprintf(stderr, "kernel_launch: hipMemsetAsync of the barrier words failed\n"); return; }
    void* args[] = {&a};
    const hipError_t e = hipLaunchCooperativeKernel((const void*)mega_fwd, dim3(grid), dim3(NTHREADS), args, LDS_BYTES, stream);
    if (e != hipSuccess) fprintf(stderr, "kernel_launch: cooperative launch failed: %s (grid %d)\n", hipGetErrorString(e), grid);
}
#endif
#if DIAG
namespace nv {
constexpr int D_MODEL = 1024, BATCH = 16, SEQ = 2048, DEPTH = 2, H = 4, HD = 64;
constexpr int D_IN = 4040;
constexpr int O_AQ = 0, O_AK = 256, O_AV = 512, O_BQ = 768, O_BK = 1024, O_BV = 1280, O_CQ = 1536, O_CK = 1792, O_CV = 2048,
              O_CIQ = 2304, O_CIK = 2560, O_CIW = 2592, O_DCQ = 2600, O_DCKV = 2856, O_DKR = 2984, O_GATE = 3016;
constexpr int CB = 1;
constexpr int MC = CB * SEQ;
constexpr float ALPHA = 1.4142135623730951f;

__global__ void __launch_bounds__(256) gemm_f32(const float* __restrict__ A, int lda, const float* __restrict__ B, int ldb,
                                                float* __restrict__ C, int ldc, int M, int N, int K) {
    __shared__ float As[16][65];
    __shared__ float Bs[16][65];
    const int tx = threadIdx.x & 15, ty = threadIdx.x >> 4;
    const int m0 = blockIdx.y * 64, n0 = blockIdx.x * 64;
    float acc[4][4];
#pragma unroll
    for (int i = 0; i < 4; ++i)
#pragma unroll
        for (int j = 0; j < 4; ++j) acc[i][j] = 0.f;
    for (int k0 = 0; k0 < K; k0 += 16) {
#pragma unroll
        for (int i = 0; i < 4; ++i) {
            const int e = threadIdx.x + i * 256, r = e >> 4, kk = e & 15;
            As[kk][r] = A[(size_t)(m0 + r) * lda + k0 + kk];
        }
#pragma unroll
        for (int i = 0; i < 4; ++i) {
            const int e = threadIdx.x + i * 256, kk = e >> 6, c = e & 63;
            Bs[kk][c] = (n0 + c < N) ? B[(size_t)(k0 + kk) * ldb + n0 + c] : 0.f;
        }
        __syncthreads();
#pragma unroll
        for (int kk = 0; kk < 16; ++kk) {
            float a[4], b[4];
#pragma unroll
            for (int i = 0; i < 4; ++i) a[i] = As[kk][ty * 4 + i];
#pragma unroll
            for (int j = 0; j < 4; ++j) b[j] = Bs[kk][tx * 4 + j];
#pragma unroll
            for (int i = 0; i < 4; ++i)
#pragma unroll
                for (int j = 0; j < 4; ++j) acc[i][j] = fmaf(a[i], b[j], acc[i][j]);
        }
        __syncthreads();
    }
#pragma unroll
    for (int i = 0; i < 4; ++i)
#pragma unroll
        for (int j = 0; j < 4; ++j) {
            const int c = n0 + tx * 4 + j;
            if (c < N) C[(size_t)(m0 + ty * 4 + i) * ldc + c] = acc[i][j];
        }
}

__device__ __forceinline__ float wave_sum(float v) {
#pragma unroll
    for (int o = 1; o < 64; o <<= 1) v += __shfl_xor(v, o);
    return v;
}

__global__ void __launch_bounds__(256) rms_rows(const float* __restrict__ src, int ld, int off, int W, const float* __restrict__ g, float* __restrict__ dst, int M) {
    const int row = blockIdx.x * 4 + (threadIdx.x >> 6), lane = threadIdx.x & 63;
    if (row >= M) return;
    const float* p = src + (size_t)row * ld + off;
    float s = 0.f;
    for (int c = lane; c < W; c += 64) { const float v = p[c]; s += v * v; }
    s = wave_sum(s);
    const float r = 1.0f / sqrtf(s / (float)W + 1e-6f);
    for (int c = lane; c < W; c += 64) dst[(size_t)row * W + c] = p[c] * r * g[c];
}

__device__ __forceinline__ float inv_freq(int i) { return powf(10000.0f, -(float)i / 16.0f); }

__global__ void __launch_bounds__(256) rope_k(float* __restrict__ dq, const float* __restrict__ hbuf, float* __restrict__ kr, int M) {
    const int idx = blockIdx.x * 256 + threadIdx.x;
    if (idx >= M * 16 * 5) return;
    const int i = idx & 15, which = (idx >> 4) % 5, m = idx / 80;
    const int t = m % SEQ;
    const float ang = (float)t * inv_freq(i);
    const float c = cosf(ang), s = sinf(ang);
    if (which < 4) {
        float* p = dq + (size_t)m * 384 + which * 96 + 64;
        const float x1 = p[i], x2 = p[16 + i];
        p[i] = x1 * c - x2 * s; p[16 + i] = x1 * s + x2 * c;
    } else {
        const float* p = hbuf + (size_t)m * D_IN + O_DKR;
        const float x1 = p[i], x2 = p[16 + i];
        kr[(size_t)m * 32 + i] = x1 * c - x2 * s; kr[(size_t)m * 32 + 16 + i] = x1 * s + x2 * c;
    }
}

__device__ __forceinline__ int t5_bucket(int dist) {
    const int n = dist > 0 ? dist : 0;
    if (n < 16) return n;
    const float nf = (float)n;
    int large = 16 + (int)(logf(nf / 16.0f) / 2.0794415416798357f * 16.0f);
    return large < 31 ? large : 31;
}

__device__ __forceinline__ float softplusf(float z) { return fmaxf(z, 0.f) + log1pf(expf(-fabsf(z))); }

__global__ void __launch_bounds__(256) attn_A(const float* __restrict__ hb, float* __restrict__ o) {
    const int b = blockIdx.z, hd = blockIdx.y, t = blockIdx.x * 256 + threadIdx.x;
    const float* qp = hb + (size_t)(b * SEQ + t) * D_IN + O_AQ + hd * 64;
    float q[64], acc[64];
#pragma unroll
    for (int d = 0; d < 64; ++d) { q[d] = qp[d]; acc[d] = 0.f; }
    float cum = 0.f;
    const int tmax = blockIdx.x * 256 + 255;
    for (int s = tmax - 1; s >= 0; --s) {
        const float* kp = hb + (size_t)(b * SEQ + s) * D_IN + O_AK + hd * 64;
        const float* vp = hb + (size_t)(b * SEQ + s) * D_IN + O_AV + hd * 64;
        float z = 0.f;
#pragma unroll
        for (int d = 0; d < 64; ++d) z = fmaf(q[d], kp[d], z);
        z *= 0.125f;
        if (s < t) {
            const float sp = softplusf(z);
            const float w = expf((z - sp) + cum);
#pragma unroll
            for (int d = 0; d < 64; ++d) acc[d] = fmaf(w, vp[d], acc[d]);
            cum -= sp;
        }
    }
    float* op = o + (size_t)(b * SEQ + t) * 1024 + 0 * 256 + hd * 64;
#pragma unroll
    for (int d = 0; d < 64; ++d) op[d] = acc[d];
}

__global__ void __launch_bounds__(256) attn_B(const float* __restrict__ hb, float* __restrict__ o, const float* __restrict__ rel_bias,
                                              const float* __restrict__ dlam, const float* __restrict__ subln, float lam_init) {
    const int b = blockIdx.z, hd = blockIdx.y, t = blockIdx.x * 256 + threadIdx.x;
    const float* qp = hb + (size_t)(b * SEQ + t) * D_IN + O_BQ + hd * 64;
    float q[64], o1[64], o2[64];
#pragma unroll
    for (int d = 0; d < 64; ++d) { q[d] = qp[d]; o1[d] = 0.f; o2[d] = 0.f; }
    float m1 = -INFINITY, m2 = -INFINITY, l1 = 0.f, l2 = 0.f;
    const int tmax = blockIdx.x * 256 + 255;
    const float sc = 0.17677669529663687f;
    for (int s = 0; s <= tmax; ++s) {
        const float* kp = hb + (size_t)(b * SEQ + s) * D_IN + O_BK + hd * 64;
        const float* vp = hb + (size_t)(b * SEQ + s) * D_IN + O_BV + hd * 64;
        float s1 = 0.f, s2 = 0.f;
#pragma unroll
        for (int d = 0; d < 32; ++d) { s1 = fmaf(q[d], kp[d], s1); s2 = fmaf(q[32 + d], kp[32 + d], s2); }
        if (s <= t) {
            const float bias = rel_bias[t5_bucket(t - s) * 8 + hd];
            s1 = s1 * sc + bias; s2 = s2 * sc + bias;
            {
                const float mn = fmaxf(m1, s1), a = expf(m1 - mn), p = expf(s1 - mn);
                l1 = l1 * a + p; m1 = mn;
#pragma unroll
                for (int d = 0; d < 64; ++d) o1[d] = fmaf(p, vp[d], o1[d] * a);
            }
            {
                const float mn = fmaxf(m2, s2), a = expf(m2 - mn), p = expf(s2 - mn);
                l2 = l2 * a + p; m2 = mn;
#pragma unroll
                for (int d = 0; d < 64; ++d) o2[d] = fmaf(p, vp[d], o2[d] * a);
            }
        }
    }
    float a0 = 0.f, a1 = 0.f;
    for (int d = 0; d < 32; ++d) { a0 += dlam[d] * dlam[32 + d]; a1 += dlam[64 + d] * dlam[96 + d]; }
    const float lam = expf(a0) - expf(a1) + lam_init;
    float ss = 0.f;
#pragma unroll
    for (int d = 0; d < 64; ++d) { o1[d] = o1[d] / l1 - lam * (o2[d] / l2); ss += o1[d] * o1[d]; }
    const float r = 1.0f / sqrtf(ss / 64.0f + 1e-6f);
    float* op = o + (size_t)(b * SEQ + t) * 1024 + 1 * 256 + hd * 64;
#pragma unroll
    for (int d = 0; d < 64; ++d) op[d] = o1[d] * r * subln[d] * (1.0f - lam_init);
}

__global__ void __launch_bounds__(256) c_score(const float* __restrict__ hb, float* __restrict__ score) {
    const int b = blockIdx.z, t = blockIdx.y, s = blockIdx.x * 256 + threadIdx.x;
    if (blockIdx.x * 256 > t) return;
    const float* iq = hb + (size_t)(b * SEQ + t) * D_IN + O_CIQ;
    const float* iw = hb + (size_t)(b * SEQ + t) * D_IN + O_CIW;
    const float* ik = hb + (size_t)(b * SEQ + s) * D_IN + O_CIK;
    float k[32];
#pragma unroll
    for (int d = 0; d < 32; ++d) k[d] = ik[d];
    float sc = 0.f;
#pragma unroll
    for (int hh = 0; hh < 8; ++hh) {
        float dot = 0.f;
#pragma unroll
        for (int d = 0; d < 32; ++d) dot = fmaf(iq[hh * 32 + d], k[d], dot);
        dot *= 0.17677669529663687f;
        sc += (iw[hh] * 0.35355339059327373f) * fmaxf(dot, 0.f);
    }
    score[((size_t)b * SEQ + t) * SEQ + s] = sc;
}

__global__ void __launch_bounds__(256) c_select(const float* __restrict__ score, unsigned* __restrict__ selbits) {
    const int row = blockIdx.x * 4 + (threadIdx.x >> 6), lane = threadIdx.x & 63;
    const int t = row % SEQ;
    unsigned* out = selbits + (size_t)row * 64;
    if (t < 256) {
        const int lo = lane * 32;
        unsigned w = 0u;
        if (t >= lo + 31) w = 0xFFFFFFFFu; else if (t >= lo) w = (2u << (t - lo)) - 1u;
        out[lane] = w;
        return;
    }
    const float* sp = score + (size_t)row * SEQ;
    unsigned u[32];
#pragma unroll
    for (int i = 0; i < 32; ++i) {
        const int key = lane * 32 + i;
        unsigned v = 0u;
        if (key <= t) { const unsigned bits = __float_as_uint(sp[key] + 0.0f); v = (bits & 0x80000000u) ? ~bits : (bits | 0x80000000u); }
        u[i] = v;
    }
    unsigned T = 0u;
    for (int bit = 31; bit >= 0; --bit) {
        const unsigned cand = T | (1u << bit);
        int c = 0;
#pragma unroll
        for (int i = 0; i < 32; ++i) c += (u[i] >= cand) ? 1 : 0;
        c = (int)wave_sum((float)c);
        if (c >= 256) T = cand;
    }
    int cg = 0, ce = 0;
#pragma unroll
    for (int i = 0; i < 32; ++i) { cg += (u[i] > T) ? 1 : 0; ce += (u[i] == T) ? 1 : 0; }
    const int G = (int)wave_sum((float)cg);
    int need = 256 - G;
    int pre = ce;
#pragma unroll
    for (int o = 1; o < 64; o <<= 1) { const int v = __shfl_up(pre, o); if (lane >= o) pre += v; }
    pre -= ce;
    unsigned w = 0u;
    int taken = pre;
#pragma unroll
    for (int i = 0; i < 32; ++i) {
        if (u[i] > T) w |= (1u << i);
        else if (u[i] == T) { if (taken < need) w |= (1u << i); ++taken; }
    }
    out[lane] = w;
}

__global__ void __launch_bounds__(256) attn_C(const float* __restrict__ hb, float* __restrict__ o, const float* __restrict__ rel_bias, const unsigned* __restrict__ selbits) {
    const int b = blockIdx.z, hd = blockIdx.y, t = blockIdx.x * 256 + threadIdx.x;
    const float* qp = hb + (size_t)(b * SEQ + t) * D_IN + O_CQ + hd * 64;
    const unsigned* sb = selbits + (size_t)(b * SEQ + t) * 64;
    float q[64], acc[64];
#pragma unroll
    for (int d = 0; d < 64; ++d) { q[d] = qp[d]; acc[d] = 0.f; }
    float m = -INFINITY, l = 0.f;
    const int tmax = blockIdx.x * 256 + 255;
    unsigned word = 0u;
    for (int s = 0; s <= tmax; ++s) {
        if ((s & 31) == 0) word = sb[s >> 5];
        const float* kp = hb + (size_t)(b * SEQ + s) * D_IN + O_CK + hd * 64;
        const float* vp = hb + (size_t)(b * SEQ + s) * D_IN + O_CV + hd * 64;
        float z = 0.f;
#pragma unroll
        for (int d = 0; d < 64; ++d) z = fmaf(q[d], kp[d], z);
        if (s <= t && ((word >> (s & 31)) & 1u)) {
            z = z * 0.125f + rel_bias[t5_bucket(t - s) * 8 + 4 + hd];
            const float mn = fmaxf(m, z), a = expf(m - mn), p = expf(z - mn);
            l = l * a + p; m = mn;
#pragma unroll
            for (int d = 0; d < 64; ++d) acc[d] = fmaf(p, vp[d], acc[d] * a);
        }
    }
    float* op = o + (size_t)(b * SEQ + t) * 1024 + 2 * 256 + hd * 64;
    const float il = 1.0f / l;
#pragma unroll
    for (int d = 0; d < 64; ++d) op[d] = acc[d] * il;
}

__global__ void __launch_bounds__(256) attn_D(const float* __restrict__ dq, const float* __restrict__ dkv, const float* __restrict__ kr, float* __restrict__ o) {
    const int b = blockIdx.z, hd = blockIdx.y, t = blockIdx.x * 256 + threadIdx.x;
    const float* qp = dq + (size_t)(b * SEQ + t) * 384 + hd * 96;
    float q[96], acc[64];
#pragma unroll
    for (int d = 0; d < 96; ++d) q[d] = qp[d];
#pragma unroll
    for (int d = 0; d < 64; ++d) acc[d] = 0.f;
    float m = -INFINITY, l = 0.f;
    const int tmax = blockIdx.x * 256 + 255;
    const float sc = 0.10206207261596577f;
    for (int s = 0; s <= tmax; ++s) {
        const float* kp = dkv + (size_t)(b * SEQ + s) * 512 + hd * 128;
        const float* vp = kp + 64;
        const float* rp = kr + (size_t)(b * SEQ + s) * 32;
        float z = 0.f;
#pragma unroll
        for (int d = 0; d < 64; ++d) z = fmaf(q[d], kp[d], z);
#pragma unroll
        for (int d = 0; d < 32; ++d) z = fmaf(q[64 + d], rp[d], z);
        if (s <= t) {
            z *= sc;
            const float mn = fmaxf(m, z), a = expf(m - mn), p = expf(z - mn);
            l = l * a + p; m = mn;
#pragma unroll
            for (int d = 0; d < 64; ++d) acc[d] = fmaf(p, vp[d], acc[d] * a);
        }
    }
    float* op = o + (size_t)(b * SEQ + t) * 1024 + 3 * 256 + hd * 64;
    const float il = 1.0f / l;
#pragma unroll
    for (int d = 0; d < 64; ++d) op[d] = acc[d] * il;
}

__global__ void __launch_bounds__(256) gate_mul(float* __restrict__ o, const float* __restrict__ hb, int M) {
    const size_t idx = (size_t)blockIdx.x * 256 + threadIdx.x;
    if (idx >= (size_t)M * 1024) return;
    const int m = (int)(idx >> 10), c = (int)(idx & 1023);
    const float g = hb[(size_t)m * D_IN + O_GATE + c];
    o[idx] = o[idx] * (g / (1.0f + expf(-g)));
}

__global__ void __launch_bounds__(256) ln_res(const float* __restrict__ x, const float* __restrict__ y, const float* __restrict__ g, const float* __restrict__ bb, float* __restrict__ out, int M) {
    const int row = blockIdx.x * 4 + (threadIdx.x >> 6), lane = threadIdx.x & 63;
    if (row >= M) return;
    float v[16]; float s = 0.f;
#pragma unroll
    for (int i = 0; i < 16; ++i) { const int c = i * 64 + lane; v[i] = ALPHA * x[(size_t)row * 1024 + c] + y[(size_t)row * 1024 + c]; s += v[i]; }
    const float mean = wave_sum(s) * (1.0f / 1024.0f);
    float s2 = 0.f;
#pragma unroll
    for (int i = 0; i < 16; ++i) { v[i] -= mean; s2 += v[i] * v[i]; }
    const float r = 1.0f / sqrtf(wave_sum(s2) * (1.0f / 1024.0f) + 1e-5f);
#pragma unroll
    for (int i = 0; i < 16; ++i) { const int c = i * 64 + lane; out[(size_t)row * 1024 + c] = v[i] * r * g[c] + bb[c]; }
}
}

#ifndef DIAG_SEL
#define DIAG_SEL -1
#endif
namespace dg {
constexpr int NITEM = 32;
struct P { const bf16_t* CN; const float* cq; const bf16_t* HB; const bf16_t* MD; const bf16_t* KR; const unsigned* SEL; const bf16_t* OB; const float* OUTOPT;
           const float* hb; const float* dq; const float* dkv; const float* kr; const unsigned* selbits; const float* ob; const float* outn; };
__device__ __forceinline__ bool pair(const P& p, int it, int r, int c, float& av, float& bv) {
    if (it < 16) { const int v = it * 256 + c, s = src_col(v); if (s < 0) return false; av = bf2f(p.HB[(size_t)r * NV + v]); bv = p.hb[(size_t)r * nv::D_IN + s];
        if (it >= 12) bv = bv / (1.0f + expf(-bv)); return true; }
    if (it == 16) { if (c >= 32) return false; av = bf2f(p.HB[(size_t)r * NV + V_DKR + c]); bv = p.hb[(size_t)r * nv::D_IN + nv::O_DKR + c]; return true; }
    if (it == 17) { if (c >= 32) return false; av = bf2f(p.HB[(size_t)r * NV + V_CIK + c]); bv = p.hb[(size_t)r * nv::D_IN + nv::O_CIK + c]; return true; }
    if (it == 18) { if (c >= 8) return false; av = bf2f(p.HB[(size_t)r * NV + V_CIW + c]); bv = p.hb[(size_t)r * nv::D_IN + nv::O_CIW + c]; return true; }
    if (it == 19) { av = bf2f(p.MD[(size_t)r * DM + MD_QN + c]); bv = p.dq[(size_t)r * 384 + (c >> 6) * 96 + (c & 63)]; return true; }
    if (it == 20) { return false; }
    if (it == 21) { av = bf2f(p.MD[(size_t)r * DM + MD_KN + c]); bv = p.dkv[(size_t)r * 512 + (c >> 6) * 128 + (c & 63)]; return true; }
    if (it == 22) { av = bf2f(p.MD[(size_t)r * DM + MD_V + c]); bv = p.dkv[(size_t)r * 512 + (c >> 6) * 128 + 64 + (c & 63)]; return true; }
    if (it == 23) { if (c >= 32) return false; av = bf2f(p.KR[(size_t)r * 32 + c]); bv = p.kr[(size_t)r * 32 + c]; return true; }
    if (it == 24) { if (c >= 64) return false; const unsigned x = p.SEL[(size_t)r * 64 + c], y = p.selbits[(size_t)r * 64 + c];
        unsigned cm = 0xFFFFFFFFu; const int t = r & 2047, lo = c * 32; if (t < lo) cm = 0u; else if (t < lo + 31) cm = (2u << (t - lo)) - 1u;
        av = (float)__popc((x ^ y) & cm); bv = 0.f; if (c == 0) bv = (t < 256) ? (float)(t + 1) : 256.f; av = sqrtf(av); bv = sqrtf(bv); av += bv; return true; }
    if (it == 31) { av = bf2f(p.CN[(size_t)r * 384 + c]); bv = p.cq[(size_t)r * 256 + c]; return true; }
    if (it == 30) { av = bf2f(p.MD[(size_t)r * DM + MD_QN + c]); bv = p.dq[(size_t)r * 384 + (c >> 6) * 96 + (c & 63)]; return true; }
    if (it >= 25 && it < 29) { const int g = it - 25; av = bf2f(p.OB[(size_t)r * DM + g * 256 + c]); bv = p.ob[(size_t)r * 1024 + g * 256 + c]; return true; }
    return false;
}
__global__ void __launch_bounds__(256) cmp_item(P p, int it, int rows, float* acc) {
    float num = 0.f, den = 0.f;
    for (size_t e = (size_t)blockIdx.x * 256 + threadIdx.x; e < (size_t)rows * 256; e += (size_t)gridDim.x * 256) {
        const int r = (int)(e >> 8), c = (int)(e & 255); float av, bv;
        if (pair(p, it, r, c, av, bv)) { const float d = av - bv; num += d * d; den += bv * bv; }
    }
    num = ::wave_sum(num); den = ::wave_sum(den);
    if ((threadIdx.x & 63) == 0) { atomicAdd(acc + 2 * it, num); atomicAdd(acc + 2 * it + 1, den); }
}
__global__ void __launch_bounds__(256) cmp_final(const float* a, const float* b, size_t n, float* acc, int it) {
    float num = 0.f, den = 0.f;
    for (size_t e = (size_t)blockIdx.x * 256 + threadIdx.x; e < n; e += (size_t)gridDim.x * 256) { const float d = a[e] - b[e]; num += d * d; den += b[e] * b[e]; }
    num = ::wave_sum(num); den = ::wave_sum(den);
    if ((threadIdx.x & 63) == 0) { atomicAdd(acc + 2 * it, num); atomicAdd(acc + 2 * it + 1, den); }
}
#ifndef DIAG_SEL2
#define DIAG_SEL2 -1
#endif
#ifndef DIAG_MAXHI
#define DIAG_MAXHI 24
#endif
__global__ void finalize(float* acc) {
    float E = 0.f; int arg = 0; float e2 = 0.f;
    for (int i = 0; i < NITEM; ++i) { const float den = acc[2 * i + 1]; float e = den > 0.f ? sqrtf(acc[2 * i] / den) : 0.f; if (!(e == e)) e = 9.f;
        if (DIAG_SEL >= 0) { if (i == DIAG_SEL) { E = e; arg = i; } } else if (i < DIAG_MAXHI && e > E) { E = e; arg = i; }
        if (i == DIAG_SEL2) e2 = e; }
    acc[2 * NITEM] = E; acc[2 * NITEM + 1] = (DIAG_SEL2 >= 0) ? fmaxf(1.0e6f * e2, 100.f) : (float)((10 + arg) * 10);
}
__global__ void __launch_bounds__(256) perturb(float* out, size_t n, const float* acc) {
    const float E = acc[2 * NITEM], spike = acc[2 * NITEM + 1];
    for (size_t e = (size_t)blockIdx.x * 256 + threadIdx.x; e < n; e += (size_t)gridDim.x * 256) { float v = out[e] * (1.0f + 1000.0f * E);     if (e == 0) v += spike; out[e] = v; }
}
}

extern "C" void kernel_launch(void* const* d_in, const int* in_sizes, int n_in, void* d_out, int out_size, void* d_ws, size_t ws_size, hipStream_t stream) {
    constexpr int MC = nv::MC, CB = nv::CB, BATCH = nv::BATCH, H = nv::H, O_DCQ = nv::O_DCQ, O_DCKV = nv::O_DCKV;
    using nv::gemm_f32; using nv::rms_rows; using nv::rope_k; using nv::attn_A; using nv::attn_B; using nv::c_score; using nv::c_select; using nv::attn_C; using nv::attn_D; using nv::gate_mul; using nv::ln_res;
    const float* x = (const float*)d_in[0]; const float* w_in = (const float*)d_in[1]; const float* w_out = (const float*)d_in[2]; const float* ln_g = (const float*)d_in[3];
    const float* ln_b = (const float*)d_in[4]; const float* rel_bias = (const float*)d_in[5]; const float* diff_lambda = (const float*)d_in[6]; const float* diff_subln = (const float*)d_in[7];
    const float* mla_q_norm = (const float*)d_in[8]; const float* mla_kv_norm = (const float*)d_in[9]; const float* mla_w_uq = (const float*)d_in[10]; const float* mla_w_ukv = (const float*)d_in[11];
    float* out = (float*)d_out; char* ws = (char*)d_ws;
    size_t off = (WS_END + 255) & ~(size_t)255;
    auto carve = [&](size_t bytes) { char* p = ws + off; off += (bytes + 255) & ~(size_t)255; return p; };
    float* outopt = (float*)carve((size_t)M_TOK * DM * 4);
    float* acc = (float*)carve(4096);
    float* hb = (float*)carve((size_t)MC * D_IN * 4); float* cq = (float*)carve((size_t)MC * 256 * 4); float* ckv = (float*)carve((size_t)MC * 128 * 4);
    float* dq = (float*)carve((size_t)MC * 384 * 4); float* dkv = (float*)carve((size_t)MC * 512 * 4); float* kr = (float*)carve((size_t)MC * 32 * 4);
    float* score = (float*)carve((size_t)CB * SEQ * SEQ * 4); unsigned* selbits = (unsigned*)carve((size_t)MC * 64 * 4);
    float* ob = (float*)carve((size_t)MC * 1024 * 4); float* yb = (float*)carve((size_t)MC * 1024 * 4); float* x1 = (float*)carve((size_t)MC * 1024 * 4);
    if (off > ws_size) { fprintf(stderr, "DIAG workspace too small: need %zu have %zu\n", off, ws_size); return; }
    (void)hipMemsetAsync(acc, 0, 4096, stream);
    auto naive_layer = [&](const float* xin, float* xout, int l, bool upto_y_only) {
        const float* wi = w_in + (size_t)l * 1024 * D_IN; const float* wo = w_out + (size_t)l * 1024 * 1024;
        const float lam_init = (float)(0.8 - 0.6 * exp(-0.3 * (double)l));
        gemm_f32<<<dim3((D_IN + 63) / 64, MC / 64), 256, 0, stream>>>(xin, 1024, wi, D_IN, hb, D_IN, MC, D_IN, 1024);
        rms_rows<<<MC / 4, 256, 0, stream>>>(hb, D_IN, O_DCQ, 256, mla_q_norm + l * 256, cq, MC);
        rms_rows<<<MC / 4, 256, 0, stream>>>(hb, D_IN, O_DCKV, 128, mla_kv_norm + l * 128, ckv, MC);
        gemm_f32<<<dim3(384 / 64, MC / 64), 256, 0, stream>>>(cq, 256, mla_w_uq + (size_t)l * 256 * 384, 384, dq, 384, MC, 384, 256);
        gemm_f32<<<dim3(512 / 64, MC / 64), 256, 0, stream>>>(ckv, 128, mla_w_ukv + (size_t)l * 128 * 512, 512, dkv, 512, MC, 512, 128);
        rope_k<<<(MC * 80 + 255) / 256, 256, 0, stream>>>(dq, hb, kr, MC);
        attn_A<<<dim3(SEQ / 256, H, CB), 256, 0, stream>>>(hb, ob);
        attn_B<<<dim3(SEQ / 256, H, CB), 256, 0, stream>>>(hb, ob, rel_bias, diff_lambda + l * 128, diff_subln + l * 64, lam_init);
        c_score<<<dim3(SEQ / 256, SEQ, CB), 256, 0, stream>>>(hb, score);
        c_select<<<MC / 4, 256, 0, stream>>>(score, selbits);
        attn_C<<<dim3(SEQ / 256, H, CB), 256, 0, stream>>>(hb, ob, rel_bias, selbits);
        attn_D<<<dim3(SEQ / 256, H, CB), 256, 0, stream>>>(dq, dkv, kr, ob);
        gate_mul<<<MC * 1024 / 256, 256, 0, stream>>>(ob, hb, MC);
        if (upto_y_only) return;
        gemm_f32<<<dim3(1024 / 64, MC / 64), 256, 0, stream>>>(ob, 1024, wo, 1024, yb, 1024, MC, 1024, 1024);
        ln_res<<<MC / 4, 256, 0, stream>>>(xin, yb, ln_g + l * 1024, ln_b + l * 1024, xout, MC);
    };
    for (int c = 0; c < BATCH / CB; ++c) {
        naive_layer(x + (size_t)c * MC * 1024, x1, 0, false);
        naive_layer(x1, out + (size_t)c * MC * 1024, 1, false);
    }
    naive_layer(x, x1, 0, true);
    (void)hipFuncSetAttribute((const void*)mega_fwd, hipFuncAttributeMaxDynamicSharedMemorySize, LDS_BYTES);
    Args a{};
    a.x = x; a.w_in = w_in; a.w_out = w_out; a.ln_g = ln_g; a.ln_b = ln_b; a.rel_bias = rel_bias; a.diff_lambda = diff_lambda; a.diff_subln = diff_subln;
    a.mla_q_norm = mla_q_norm; a.mla_kv_norm = mla_kv_norm; a.mla_w_uq = mla_w_uq; a.mla_w_ukv = mla_w_ukv; a.out = outopt; a.ws = (unsigned char*)d_ws;
    dg::P p{(const bf16_t*)(ws + WS_CN), cq, (const bf16_t*)(ws + WS_HB), (const bf16_t*)(ws + WS_MD), (const bf16_t*)(ws + WS_KR), (const unsigned*)(ws + WS_SEL), (const bf16_t*)(ws + WS_XB), outopt,
            hb, dq, dkv, kr, selbits, ob, out};
    auto run = [&](int lo, int hi) { for (int ph = lo; ph < hi; ++ph) { a.ph_lo = ph; a.ph_hi = ph + 1; hipLaunchKernelGGL(mega_fwd, dim3(256), dim3(NTHREADS), LDS_BYTES, stream, a); } };
    auto cmp = [&](int it) { dg::cmp_item<<<512, 256, 0, stream>>>(p, it, SEQ, acc); };
    run(0, 2); for (int it = 0; it < 19; ++it) cmp(it);
    run(2, 4); for (int it = 19; it < 25; ++it) cmp(it); cmp(31); run(3, 4); cmp(30);
#ifdef DIAG_COPYSEL
    (void)hipMemcpyAsync(ws + WS_SEL, selbits, (size_t)SEQ * 64 * 4, hipMemcpyDeviceToDevice, stream);
#endif
    run(4, 5); for (int it = 25; it < 29; ++it) cmp(it);
    run(5, N_PHASES);
    dg::cmp_final<<<1024, 256, 0, stream>>>(outopt, out, (size_t)M_TOK * DM, acc, 29);
    dg::finalize<<<1, 1, 0, stream>>>(acc);
    dg::perturb<<<2048, 256, 0, stream>>>(out, (size_t)BATCH * SEQ * 1024, acc);
}
#endif
```

```cpp
#include <hip/hip_runtime.h>
#include <hip/hip_cooperative_groups.h>
#include <hip/hip_bf16.h>
#include <cstdio>
#include <cstdint>
#include <cmath>
namespace cg = cooperative_groups;

#ifndef NBATCH
#define NBATCH 16
#endif
#ifndef DIAG
#define DIAG 0
#endif

#ifndef PH_MASK
#define PH_MASK 0xFFFF
#endif
#define HAS(k) (((PH_MASK) >> (k)) & 1)

constexpr int NB = NBATCH, SEQ = 2048, DM = 1024, M_TOK = NB * SEQ, DEPTH = 2;
constexpr int D_IN = 4040, NV = 4096;
constexpr int V_AQ = 0, V_AK = 256, V_AV = 512, V_BQ = 768, V_BK = 1024, V_BV = 1280, V_CQ = 1536, V_CK = 1792, V_CV = 2048,
              V_CIQ = 2304, V_DCQ = 2560, V_DCKV = 2816, V_DKR = 2944, V_CIK = 2976, V_CIW = 3008, V_GATE = 3072;
constexpr int MD_QN = 0, MD_QR = 256, MD_KN = 512, MD_V = 768;
constexpr float ALPHA_RES = 1.4142135623730951f;
constexpr float LOG2E = 1.4426950408889634f, LN2 = 0.6931471805599453f;

__host__ __device__ __forceinline__ int src_col(int v) {
    if (v < 2560) return v;
    if (v < 2816) return 2600 + (v - 2560);
    if (v < 2944) return 2856 + (v - 2816);
    if (v < 2976) return 2984 + (v - 2944);
    if (v < 3008) return 2560 + (v - 2976);
    if (v < 3016) return 2592 + (v - 3008);
    if (v < 3072) return -1;
    return 3016 + (v - 3072);
}

constexpr size_t MiB = 1u << 20;
constexpr size_t WS_CTL = 0;
constexpr size_t WS_ROPE = 512 * 1024;
constexpr size_t WS_WIN = 1 * MiB;
constexpr size_t WS_WOUT = WS_WIN + 2 * (size_t)NV * DM * 2;
constexpr size_t WS_WMLA = WS_WOUT + 2 * (size_t)DM * DM * 2;
constexpr size_t WS_XB = WS_WMLA + 2 * MiB;
constexpr size_t WS_HB = WS_XB + (size_t)M_TOK * DM * 2;
constexpr size_t WS_CN = WS_HB + (size_t)M_TOK * NV * 2;
constexpr size_t WS_KR = WS_CN + (size_t)M_TOK * 384 * 2;
constexpr size_t WS_MD = WS_KR + (size_t)M_TOK * 32 * 2;
constexpr size_t WS_SEL = WS_MD + (size_t)M_TOK * DM * 2;
constexpr size_t WS_END = WS_SEL + (size_t)M_TOK * 64 * 4;

#define LAS __attribute__((address_space(3)))
typedef unsigned short bf16_t;
typedef short bf16x8 __attribute__((ext_vector_type(8)));
typedef float f32x4 __attribute__((ext_vector_type(4)));
typedef float f32x16 __attribute__((ext_vector_type(16)));
typedef unsigned u32x4 __attribute__((ext_vector_type(4)));
typedef unsigned u32x2 __attribute__((ext_vector_type(2)));
typedef float f32x2_t __attribute__((ext_vector_type(2)));
typedef __bf16 bf16x2_t __attribute__((ext_vector_type(2)));
__device__ __forceinline__ unsigned cvtpk(float lo, float hi) { f32x2_t v = {lo, hi}; bf16x2_t b = __builtin_convertvector(v, bf16x2_t); return __builtin_bit_cast(unsigned, b); }
__device__ __forceinline__ float bf2f(unsigned short h) { return __uint_as_float((unsigned)h << 16); }
__device__ __forceinline__ float bflo(unsigned w) { return __uint_as_float(w << 16); }
__device__ __forceinline__ float bfhi(unsigned w) { return __uint_as_float(w & 0xffff0000u); }
__device__ __forceinline__ float wave_sum(float v) {
#pragma unroll
    for (int o = 1; o < 64; o <<= 1) v += __shfl_xor(v, o);
    return v;
}
namespace pg8 {
#define PG8_LAS __attribute__((address_space(3)))
typedef unsigned short bf16_t;
typedef short bf16x8 __attribute__((ext_vector_type(8)));
typedef float f32x4 __attribute__((ext_vector_type(4)));
typedef unsigned u32x4 __attribute__((ext_vector_type(4)));
constexpr int BM = 256, BK = 64, HALF = 128, HTB = HALF * BK * 2  , STAGE_BYTES = 8 * HTB, NXCD = 8, WGM = 8;

__host__ __device__ __forceinline__ int lds_byte(int r, int c) { const int st = (r >> 4) * 2 + (c >> 5), rr = r & 15, cc = c & 31, ob = rr * 64 + cc * 2; return st * 1024 + (ob ^ (((ob >> 9) & 1) << 5)); }
__host__ __device__ __forceinline__ void stage_rc(int b, int& R, int& C) { const int st = b / 1024, sb = b % 1024, swz = sb ^ (((sb >> 9) & 1) << 5); R = (st >> 1) * 16 + swz / 64; C = (st & 1) * 32 + (swz % 64) / 2; }
__host__ __device__ __forceinline__ int perm32(int rho) { const int n = rho >> 4, i = rho & 15; return 8 * (i >> 2) + 4 * n + (i & 3); }

struct Unit { int pm, pn; };
struct Gemm { const bf16_t* A; const bf16_t* Bt; int M, N, K; };

struct StaticOrder {
    int nM, nN, nwg, G, c;
    __host__ __device__ void init(int M, int N, int G_, int c_) { nM = M / BM; nN = N / BM; nwg = nM * nN; G = G_; c = c_; }
    __host__ __device__ bool next(int i, Unit& u) const {
        const long L = (long)i * G + c; if (L >= nwg) return false;
        int wgid = (int)L; { const int q = nwg / NXCD, r = nwg % NXCD, xcd = wgid % NXCD, off = wgid / NXCD; wgid = (xcd < r ? xcd * (q + 1) : r * (q + 1) + (xcd - r) * q) + off; }
        const int nig = WGM * nN, gid = wgid / nig, fm = gid * WGM, gsz = (nM - fm) < WGM ? (nM - fm) : WGM;
        u.pm = fm + ((wgid % nig) % gsz); u.pn = (wgid % nig) / gsz; return true;
    }
    __device__ __forceinline__ void a_ready(const Unit&) const {}
    __device__ __forceinline__ void done(const Unit&) const {}
};


__device__ __forceinline__ float silu_f(float v) { return v * __builtin_amdgcn_rcpf(1.0f + __builtin_amdgcn_exp2f(-v * 1.4426950408889634f)); }

struct EpiMain {
    static constexpr bool PERM = true, AFTER_DRAIN = false;
    bf16_t* O; int ldc; int gate_from;
    __device__ __forceinline__ void operator()(const f32x4 (&acc)[2][2][4][2], const Unit& u, int wr, int wc, int fr, int fq) const {
        const int row0 = u.pm * BM + wr * 64 + fr, col0 = u.pn * BM + wc * 32 + 8 * fq;
        const bool gate = u.pn >= gate_from;
#pragma unroll
        for (int ai = 0; ai < 2; ++ai)
#pragma unroll
            for (int m = 0; m < 4; ++m) { bf16_t* rowp = O + (size_t)(row0 + ai * HALF + m * 16) * ldc + col0;
#pragma unroll
                for (int bj = 0; bj < 2; ++bj) { f32x4 v0 = acc[ai][bj][m][0], v1 = acc[ai][bj][m][1];
                    if (gate) {
#pragma unroll
                        for (int j = 0; j < 4; ++j) { v0[j] = silu_f(v0[j]); v1[j] = silu_f(v1[j]); } }
                    u32x4 w; w.x = ::cvtpk(v0[0], v0[1]); w.y = ::cvtpk(v0[2], v0[3]); w.z = ::cvtpk(v1[0], v1[1]); w.w = ::cvtpk(v1[2], v1[3]);
                    *(u32x4*)(rowp + bj * HALF) = w; } }
    }
};
struct EpiOut {
    static constexpr bool PERM = false, AFTER_DRAIN = false;
    const float* xres; float* Z; float alpha;
    __device__ __forceinline__ void operator()(const f32x4 (&acc)[2][2][4][2], const Unit& u, int wr, int wc, int fr, int fq) const {
        const int row0 = u.pm * BM + wr * 64 + fr, col0 = u.pn * BM + wc * 32 + 4 * fq;
#pragma unroll
        for (int ai = 0; ai < 2; ++ai)
#pragma unroll
            for (int m = 0; m < 4; ++m) { const size_t off = (size_t)(row0 + ai * HALF + m * 16) * 1024 + col0;
#pragma unroll
                for (int bj = 0; bj < 2; ++bj)
#pragma unroll
                    for (int n = 0; n < 2; ++n) { const f32x4 xr = *(const f32x4*)(xres + off + bj * HALF + n * 16);
                        *(f32x4*)(Z + off + bj * HALF + n * 16) = xr * alpha + acc[ai][bj][m][n]; } }
    }
};
template <class Epi, class Sched, bool ALIGN_EPI = false, bool SP2 = false>
__device__ __forceinline__ void gemm_phase(PG8_LAS unsigned char* lds, const Gemm g, const Sched& S, const Epi& E, int wid_in) {
    int tid_op = wid_in * 64 + (int)__builtin_amdgcn_mbcnt_hi(~0u, __builtin_amdgcn_mbcnt_lo(~0u, 0u)); asm volatile("" : "+v"(tid_op));
    const int tid = tid_op, wid = __builtin_amdgcn_readfirstlane(tid >> 6), lane = tid & 63, wr = wid >> 2, wc = wid & 3, fr = lane & 15, fq = lane >> 4;
    const int K = g.K, nt = K / BK;
    unsigned voffA[2], voffB[2];
#pragma unroll
    for (int i = 0; i < 2; ++i) { int R, C; stage_rc(tid * 16 + i * 8192, R, C); const int Rb = Epi::PERM ? ((R & ~31) + perm32(R & 31)) : R;
        voffA[i] = (unsigned)(R * K + C) * 2u; voffB[i] = (unsigned)(Rb * K + C) * 2u; }
    const size_t kstep = (size_t)(BK * 2);
    const size_t hstep = (size_t)HALF * K * 2;
    const size_t tstep = 2 * hstep;
    const unsigned ldsw = (unsigned)wid * 1024u;
    const int aoff = lds_byte(wr * 64 + fr, fq * 8), boff = lds_byte(wc * 32 + fr, fq * 8);
#define PG8_SA(b, h) (((b) * 2 + (h)) * HTB)
#define PG8_SB(b, h) ((4 + (b) * 2 + (h)) * HTB)
#define PG8_STAGE(bufoff, gbase, voff) do { _Pragma("unroll") for (int _i = 0; _i < 2; ++_i) \
        __builtin_amdgcn_global_load_lds((const unsigned*)((const char*)(gbase) + (voff)[_i]), (PG8_LAS unsigned*)(lds + (bufoff) + ldsw + _i * 8192), 16, 0, 0); } while (0)
#define PG8_LDA(dst, b, h) do { _Pragma("unroll") for (int m = 0; m < 4; ++m) _Pragma("unroll") for (int k = 0; k < 2; ++k) dst[m][k] = *(const PG8_LAS bf16x8*)(lds + PG8_SA(b, h) + aoff + m * 2048 + k * 1024); } while (0)
#define PG8_LDB(dst, b, h) do { _Pragma("unroll") for (int n = 0; n < 2; ++n) _Pragma("unroll") for (int k = 0; k < 2; ++k) dst[n][k] = *(const PG8_LAS bf16x8*)(lds + PG8_SB(b, h) + boff + n * 2048 + k * 1024); } while (0)
#define PG8_MMA(ai, bj, At, Bt) do { __builtin_amdgcn_s_setprio(1); _Pragma("unroll") for (int m = 0; m < 4; ++m) _Pragma("unroll") for (int n = 0; n < 2; ++n) _Pragma("unroll") for (int k = 0; k < 2; ++k) \
        acc[ai][bj][m][n] = __builtin_amdgcn_mfma_f32_16x16x32_bf16(Bt[n][k], At[m][k], acc[ai][bj][m][n], 0, 0, 0); __builtin_amdgcn_s_setprio(0); } while (0)
#define PG8_WAIT_V(n) asm volatile("s_waitcnt vmcnt(" #n ")" ::: "memory")
#define PG8_WAIT_L(n) asm volatile("s_waitcnt lgkmcnt(" #n ")" ::: "memory")
#define PG8_BAR __builtin_amdgcn_s_barrier()
#define PG8_SCHED __builtin_amdgcn_sched_barrier(0)
    Unit cur, nxt; int ui = 0;
    if (!S.next(0, cur)) return;
    f32x4 acc[2][2][4][2];
#pragma unroll
    for (int a = 0; a < 2; ++a)
#pragma unroll
        for (int b = 0; b < 2; ++b)
#pragma unroll
            for (int m = 0; m < 4; ++m)
#pragma unroll
                for (int n = 0; n < 2; ++n) acc[a][b][m][n] = (f32x4){0.f, 0.f, 0.f, 0.f};
    bf16x8 At[4][2], B0[2][2], B1[2][2];
    const char* cA = (const char*)g.A + (size_t)cur.pm * tstep; const char* cB = (const char*)g.Bt + (size_t)cur.pn * tstep;
    S.a_ready(cur);
    if constexpr (SP2) {
        PG8_STAGE(PG8_SB(0, 0), cB, voffB); PG8_STAGE(PG8_SB(0, 1), cB + hstep, voffB); PG8_STAGE(PG8_SA(0, 0), cA, voffA); PG8_STAGE(PG8_SA(0, 1), cA + hstep, voffA);
        if (wr == 1) PG8_BAR;
        PG8_WAIT_V(2); PG8_BAR;
        PG8_STAGE(PG8_SB(1, 0), cB + kstep, voffB); PG8_STAGE(PG8_SA(1, 0), cA + kstep, voffA); PG8_STAGE(PG8_SB(1, 1), cB + hstep + kstep, voffB);
        PG8_WAIT_V(6); PG8_BAR;
    } else {
        PG8_STAGE(PG8_SB(0, 0), cB, voffB); PG8_STAGE(PG8_SA(0, 0), cA, voffA); PG8_STAGE(PG8_SB(0, 1), cB + hstep, voffB); PG8_STAGE(PG8_SA(0, 1), cA + hstep, voffA);
        if (wr == 1) PG8_BAR;
        PG8_WAIT_V(4); PG8_BAR;
        PG8_STAGE(PG8_SB(1, 0), cB + kstep, voffB); PG8_STAGE(PG8_SA(1, 0), cA + kstep, voffA); PG8_STAGE(PG8_SB(1, 1), cB + hstep + kstep, voffB);
        PG8_WAIT_V(6); PG8_BAR;
    }
    for (;;) {
        const bool has_next = S.next(ui + 1, nxt);
        const char* nA = has_next ? (const char*)g.A + (size_t)nxt.pm * tstep : cA; const char* nB = has_next ? (const char*)g.Bt + (size_t)nxt.pn * tstep : cB;
#pragma unroll 1
        for (int t = 0; t < nt; t += 2) {
            const bool last = (t == nt - 2);
            const char* a1 = cA + (size_t)(t + 1) * kstep;
            const char* a2 = last ? nA : cA + (size_t)(t + 2) * kstep; const char* b2 = last ? nB : cB + (size_t)(t + 2) * kstep;
            const char* a3 = a2 + kstep; const char* b3 = b2 + kstep;
            if (last && has_next) S.a_ready(nxt);
            if constexpr (SP2) {
            PG8_LDB(B0, 0, 0); PG8_LDB(B1, 0, 1); PG8_SCHED; PG8_LDA(At, 0, 0); PG8_STAGE(PG8_SA(1, 1), a1 + hstep, voffA);
            PG8_WAIT_V(8); PG8_WAIT_L(0); PG8_BAR; PG8_MMA(0, 0, At, B0); PG8_MMA(0, 1, At, B1); PG8_BAR; PG8_SCHED;
            PG8_LDA(At, 0, 1); PG8_STAGE(PG8_SB(0, 0), b2, voffB); PG8_STAGE(PG8_SB(0, 1), b2 + hstep, voffB); PG8_STAGE(PG8_SA(0, 0), a2, voffA);
            PG8_WAIT_V(8); PG8_WAIT_L(0); PG8_BAR; PG8_MMA(1, 0, At, B0); PG8_MMA(1, 1, At, B1); PG8_BAR; PG8_SCHED;
            PG8_LDB(B0, 1, 0); PG8_LDB(B1, 1, 1); PG8_SCHED; PG8_LDA(At, 1, 0); PG8_STAGE(PG8_SA(0, 1), a2 + hstep, voffA);
            PG8_WAIT_V(8); PG8_WAIT_L(0); PG8_BAR; PG8_MMA(0, 0, At, B0); PG8_MMA(0, 1, At, B1); PG8_BAR; PG8_SCHED;
            PG8_LDA(At, 1, 1); PG8_STAGE(PG8_SB(1, 0), b3, voffB); PG8_STAGE(PG8_SB(1, 1), b3 + hstep, voffB); PG8_STAGE(PG8_SA(1, 0), a3, voffA);
            PG8_WAIT_V(8); PG8_WAIT_L(0); PG8_BAR; PG8_MMA(1, 0, At, B0); PG8_MMA(1, 1, At, B1); PG8_BAR; PG8_SCHED;
            } else {
            PG8_LDB(B0, 0, 0); PG8_SCHED; PG8_LDA(At, 0, 0); PG8_STAGE(PG8_SA(1, 1), a1 + hstep, voffA);
            PG8_WAIT_L(8); PG8_BAR; PG8_WAIT_L(0); PG8_MMA(0, 0, At, B0); PG8_BAR; PG8_SCHED;
            PG8_LDB(B1, 0, 1); PG8_STAGE(PG8_SB(0, 0), b2, voffB);
            PG8_BAR; PG8_WAIT_L(0); PG8_MMA(0, 1, At, B1); PG8_BAR;
            PG8_LDA(At, 0, 1); PG8_STAGE(PG8_SA(0, 0), a2, voffA);
            PG8_BAR; PG8_WAIT_L(0); PG8_MMA(1, 0, At, B0); PG8_BAR; PG8_SCHED;
            PG8_STAGE(PG8_SB(0, 1), b2 + hstep, voffB);
            PG8_WAIT_V(6); PG8_BAR; PG8_MMA(1, 1, At, B1); PG8_BAR;
            PG8_LDB(B0, 1, 0); PG8_SCHED; PG8_LDA(At, 1, 0); PG8_STAGE(PG8_SA(0, 1), a2 + hstep, voffA);
            PG8_WAIT_L(8); PG8_BAR; PG8_WAIT_L(0); PG8_MMA(0, 0, At, B0); PG8_BAR; PG8_SCHED;
            PG8_LDB(B1, 1, 1); PG8_STAGE(PG8_SB(1, 0), b3, voffB);
            PG8_BAR; PG8_WAIT_L(0); PG8_MMA(0, 1, At, B1); PG8_BAR;
            PG8_LDA(At, 1, 1); PG8_STAGE(PG8_SA(1, 0), a3, voffA);
            PG8_BAR; PG8_WAIT_L(0); PG8_MMA(1, 0, At, B0); PG8_BAR; PG8_SCHED;
            PG8_STAGE(PG8_SB(1, 1), b3 + hstep, voffB);
            PG8_WAIT_V(6); PG8_BAR; PG8_MMA(1, 1, At, B1); PG8_BAR;
            }
        }
        if constexpr (ALIGN_EPI) { if (wr == 0) PG8_BAR; }
        if constexpr (!Epi::AFTER_DRAIN) { E(acc, cur, wr, wc, fr, fq); S.done(cur); }
        if (!has_next) break;
#pragma unroll
        for (int a = 0; a < 2; ++a)
#pragma unroll
            for (int b = 0; b < 2; ++b)
#pragma unroll
                for (int m = 0; m < 4; ++m)
#pragma unroll
                    for (int n = 0; n < 2; ++n) acc[a][b][m][n] = (f32x4){0.f, 0.f, 0.f, 0.f};
        cur = nxt; cA = nA; cB = nB; ++ui;
        if constexpr (ALIGN_EPI) { if (wr == 1) PG8_BAR; }
    }
    PG8_WAIT_V(0);
    if constexpr (!ALIGN_EPI) { if (wr == 0) PG8_BAR; }
    PG8_BAR;
    if constexpr (Epi::AFTER_DRAIN) { E.fused(acc, cur, wr, wc, fr, fq, lds, wid, lane); S.done(cur); }
#undef PG8_SA
#undef PG8_SB
#undef PG8_STAGE
#undef PG8_LDA
#undef PG8_LDB
#undef PG8_MMA
#undef PG8_WAIT_V
#undef PG8_WAIT_L
#undef PG8_BAR
#undef PG8_SCHED
}
}

#ifndef REP_PH
#define REP_PH -1
#endif
#define NREP(k) ((REP_PH) == (k) ? 2 : 1)
constexpr int NWAVES = 8, NTHREADS = 512;
constexpr int LDS_BYTES = 163840;
constexpr int SEL_RS = 2052;
constexpr int LDS_CTL = 16 * SEL_RS * 4;
constexpr int LDS_HIST = LDS_CTL + 256, HIST_WAVE = 3072;
static_assert(LDS_HIST + 8 * HIST_WAVE <= 163840, "LDS map");
constexpr int AL_K = 0, AL_KB = 12288, AL_V = 2 * AL_KB, AL_VB = 8192, AL_BIAS = AL_V + 2 * AL_VB, AL_FLAG = AL_BIAS + 1024, AL_Q = AL_FLAG + 1024;

struct Args {
    const float* x; const float* w_in; const float* w_out; const float* ln_g; const float* ln_b; const float* rel_bias; const float* diff_lambda;
    const float* diff_subln; const float* mla_q_norm; const float* mla_kv_norm; const float* mla_w_uq; const float* mla_w_ukv;
    float* out; unsigned char* ws; int ph_lo, ph_hi;
};

struct Ctx {
    LAS unsigned char* lds; int tid, lane, wid, vcu, G;
};

__device__ __forceinline__ f32x16 mfma32(bf16x8 a, bf16x8 b, f32x16 c) { return __builtin_amdgcn_mfma_f32_32x32x16_bf16(a, b, c, 0, 0, 0); }
__device__ __forceinline__ f32x4 mfma16(bf16x8 a, bf16x8 b, f32x4 c) { return __builtin_amdgcn_mfma_f32_16x16x32_bf16(a, b, c, 0, 0, 0); }
typedef short v4i16_t __attribute__((ext_vector_type(4)));
__device__ __forceinline__ v4i16_t vtr(LAS const unsigned char* p) { return __builtin_amdgcn_ds_read_tr16_b64_v4i16((LAS v4i16_t*)p); }
__device__ __forceinline__ float xhalf_sum(float v) { auto rr = __builtin_amdgcn_permlane32_swap(__float_as_uint(v), __float_as_uint(v), false, false); return __uint_as_float(rr[0]) + __uint_as_float(rr[1]); }
__device__ __forceinline__ float xhalf_max(float v) { auto rr = __builtin_amdgcn_permlane32_swap(__float_as_uint(v), __float_as_uint(v), false, false); return fmaxf(__uint_as_float(rr[0]), __uint_as_float(rr[1])); }
__device__ __forceinline__ float xhalf_other(float v, int hi) { auto rr = __builtin_amdgcn_permlane32_swap(__float_as_uint(v), __float_as_uint(v), false, false); return __uint_as_float(hi ? rr[0] : rr[1]); }
__device__ __forceinline__ int crow(int r, int hi) { return (r & 3) + 8 * (r >> 2) + 4 * hi; }

__device__ __forceinline__ int t5_bucket(int n) {
    if (n < 16) return n;
    int large = 16 + (int)(logf((float)n / 16.0f) / 2.0794415416798357f * 16.0f);
    return large < 31 ? large : 31;
}

template <int MAP>
__device__ __forceinline__ void p0_transpose_item(const float* W, int K, int N, bf16_t* WT, LAS float* scr, int item, int nblk, int lane) {
    const int kb = item / nblk, nb = item % nblk, k0 = 64 * kb, n0 = 32 * nb;
    const int v = n0 + (lane & 31);
    const int sc = MAP ? src_col(v) : v;
#pragma unroll 8
    for (int i = 0; i < 32; ++i) { const int kk = 2 * i + (lane >> 5); scr[kk * 33 + (lane & 31)] = (sc >= 0) ? W[(size_t)(k0 + kk) * N + sc] : 0.f; }
    asm volatile("s_waitcnt lgkmcnt(0)" ::: "memory");
    const int c = lane & 7;
#pragma unroll
    for (int j = 0; j < 4; ++j) { const int n = (lane >> 3) + 8 * j; const LAS float* s = scr + (8 * c) * 33 + n;
        u32x4 o; o.x = cvtpk(s[0 * 33], s[1 * 33]); o.y = cvtpk(s[2 * 33], s[3 * 33]); o.z = cvtpk(s[4 * 33], s[5 * 33]); o.w = cvtpk(s[6 * 33], s[7 * 33]);
        *(u32x4*)(WT + (size_t)(n0 + n) * K + k0 + 8 * c) = o; }
    asm volatile("s_waitcnt lgkmcnt(0)" ::: "memory");
}
__device__ __forceinline__ void p0_prologue(const Ctx& C, const Args& a) {
    unsigned char* ws = a.ws;
    LAS float* scr = (LAS float*)(C.lds + C.wid * 16384);
    const int gw = C.vcu * NWAVES + C.wid, NGW = C.G * NWAVES;
    constexpr int I_IN = (DM / 64) * (NV / 32), I_OUT = (DM / 64) * (DM / 32);
    for (int it = gw; it < 2 * I_IN + 2 * I_OUT; it += NGW) {
        int r = it;
        if (r < 2 * I_IN) { const int l = r / I_IN; r -= l * I_IN;
            p0_transpose_item<1>(a.w_in + (size_t)l * DM * D_IN, DM, D_IN, (bf16_t*)(ws + WS_WIN) + (size_t)l * NV * DM, scr, r, NV / 32, C.lane); continue; }
        r -= 2 * I_IN; { const int l = r / I_OUT; r -= l * I_OUT;
            p0_transpose_item<0>(a.w_out + (size_t)l * DM * DM, DM, DM, (bf16_t*)(ws + WS_WOUT) + (size_t)l * DM * DM, scr, r, DM / 32, C.lane); }
    }
    const int gt = C.vcu * NTHREADS + C.tid, NGT = C.G * NTHREADS;
    for (int e = gt; e < 2 * 1024 * 384; e += NGT) {
        const int l = e / (1024 * 384), rem = e % (1024 * 384), r = rem / 384, k = rem % 384;
        float v = 0.f;
        if (r < 256) { if (k < 256) v = a.mla_w_uq[(size_t)l * 256 * 384 + (size_t)k * 384 + (r >> 6) * 96 + (r & 63)]; }
        else if (r < 384) { if (k < 256) v = a.mla_w_uq[(size_t)l * 256 * 384 + (size_t)k * 384 + ((r - 256) >> 5) * 96 + 64 + ((r - 256) & 31)]; }
        else if (r < 512) { }
        else if (r < 768) { if (k >= 256) v = a.mla_w_ukv[(size_t)l * 128 * 512 + (size_t)(k - 256) * 512 + ((r - 512) >> 6) * 128 + ((r - 512) & 63)]; }
        else { if (k >= 256) v = a.mla_w_ukv[(size_t)l * 128 * 512 + (size_t)(k - 256) * 512 + ((r - 768) >> 6) * 128 + 64 + ((r - 768) & 63)]; }
        ((bf16_t*)(ws + WS_WMLA))[e] = (bf16_t)(cvtpk(v, 0.f) & 0xffffu);
    }
    for (int e = gt; e < SEQ * 16; e += NGT) {
        const int t = e >> 4, i = e & 15;
        const float ang = (float)t * powf(10000.0f, -(float)i / 16.0f);
        ((float*)(ws + WS_ROPE))[2 * e] = cosf(ang); ((float*)(ws + WS_ROPE))[2 * e + 1] = sinf(ang);
    }
    for (size_t e = gt; e < (size_t)M_TOK * DM / 8; e += NGT) {
        const f32x4 v0 = *(const f32x4*)(a.x + e * 8), v1 = *(const f32x4*)(a.x + e * 8 + 4);
        u32x4 o; o.x = cvtpk(v0[0], v0[1]); o.y = cvtpk(v0[2], v0[3]); o.z = cvtpk(v1[0], v1[1]); o.w = cvtpk(v1[2], v1[3]);
        *(u32x4*)((bf16_t*)(ws + WS_XB) + e * 8) = o;
    }
}

__device__ __forceinline__ void p2_mla_prep(const Ctx& C, const Args& a, int layer) {
    const bf16_t* HB = (const bf16_t*)(a.ws + WS_HB); bf16_t* CN = (bf16_t*)(a.ws + WS_CN); bf16_t* KR = (bf16_t*)(a.ws + WS_KR);
    const float* rope = (const float*)(a.ws + WS_ROPE);
    const float* gq = a.mla_q_norm + layer * 256; const float* gkv = a.mla_kv_norm + layer * 128;
    const int gw = C.vcu * NWAVES + C.wid, NGW = C.G * NWAVES, lane = C.lane;
    const f32x4 g4 = *(const f32x4*)(gq + 4 * lane); const float g20 = gkv[2 * lane], g21 = gkv[2 * lane + 1];
    for (int m = gw; m < M_TOK; m += NGW) {
        const bf16_t* hr = HB + (size_t)m * NV;
        const u32x2 q = *(const u32x2*)(hr + V_DCQ + 4 * lane);
        const unsigned kv = *(const unsigned*)(hr + V_DCKV + 2 * lane);
        const float q0 = bflo(q.x), q1 = bfhi(q.x), q2 = bflo(q.y), q3 = bfhi(q.y), k0 = bflo(kv), k1 = bfhi(kv);
        const float sq = wave_sum((q0 * q0 + q1 * q1) + (q2 * q2 + q3 * q3)), sk = wave_sum(k0 * k0 + k1 * k1);
        const float rq = 1.0f / sqrtf(sq * (1.0f / 256.0f) + 1e-6f), rk = 1.0f / sqrtf(sk * (1.0f / 128.0f) + 1e-6f);
        u32x2 oq; oq.x = cvtpk(q0 * rq * g4[0], q1 * rq * g4[1]); oq.y = cvtpk(q2 * rq * g4[2], q3 * rq * g4[3]);
        *(u32x2*)(CN + (size_t)m * 384 + 4 * lane) = oq;
        *(unsigned*)(CN + (size_t)m * 384 + 256 + 2 * lane) = cvtpk(k0 * rk * g20, k1 * rk * g21);
        if (lane < 16) {
            const float x1 = bf2f(hr[V_DKR + lane]), x2 = bf2f(hr[V_DKR + 16 + lane]);
            const float c = rope[((m & (SEQ - 1)) * 16 + lane) * 2], s = rope[((m & (SEQ - 1)) * 16 + lane) * 2 + 1];
            KR[(size_t)m * 32 + lane] = (bf16_t)(cvtpk(x1 * c - x2 * s, 0.f) & 0xffffu);
            KR[(size_t)m * 32 + 16 + lane] = (bf16_t)(cvtpk(x1 * s + x2 * c, 0.f) & 0xffffu);
        }
    }
}

__device__ __forceinline__ int wave_sum_dpp(int v) {
    v += __builtin_amdgcn_update_dpp(0, v, 0xB1, 0xf, 0xf, false);
    v += __builtin_amdgcn_update_dpp(0, v, 0x4E, 0xf, 0xf, false);
    v += __builtin_amdgcn_update_dpp(0, v, 0x141, 0xf, 0xf, false);
    v += __builtin_amdgcn_update_dpp(0, v, 0x140, 0xf, 0xf, false);
    return __builtin_amdgcn_readlane(v, 0) + __builtin_amdgcn_readlane(v, 16) + __builtin_amdgcn_readlane(v, 32) + __builtin_amdgcn_readlane(v, 48);
}
__device__ __forceinline__ unsigned wave_max_dpp(unsigned v) {
    unsigned o;
    o = (unsigned)__builtin_amdgcn_update_dpp(0, (int)v, 0xB1, 0xf, 0xf, false); v = v > o ? v : o;
    o = (unsigned)__builtin_amdgcn_update_dpp(0, (int)v, 0x4E, 0xf, 0xf, false); v = v > o ? v : o;
    o = (unsigned)__builtin_amdgcn_update_dpp(0, (int)v, 0x141, 0xf, 0xf, false); v = v > o ? v : o;
    o = (unsigned)__builtin_amdgcn_update_dpp(0, (int)v, 0x140, 0xf, 0xf, false); v = v > o ? v : o;
    const unsigned a = __builtin_amdgcn_readlane((int)v, 0), b = __builtin_amdgcn_readlane((int)v, 16), c = __builtin_amdgcn_readlane((int)v, 32), d = __builtin_amdgcn_readlane((int)v, 48);
    const unsigned ab = a > b ? a : b, cd = c > d ? c : d; return ab > cd ? ab : cd;
}
__device__ __forceinline__ unsigned wave_min_dpp(unsigned v) { return ~wave_max_dpp(~v); }
__device__ __forceinline__ unsigned sel_key(float v) { const unsigned bits = __float_as_uint(v + 0.0f); return (bits & 0x80000000u) ? ~bits : (bits | 0x80000000u); }
__device__ __forceinline__ unsigned sel_words(const unsigned (&u)[32], unsigned T, bool exact, int lane) {
    unsigned myword = 0u;
    if (exact) {
#pragma unroll
        for (int g = 0; g < 4; ++g) {
            asm("v_cmp_le_u32 s[84:85], %1, %2\n\tv_cmp_le_u32 s[86:87], %1, %3\n\tv_cmp_le_u32 s[88:89], %1, %4\n\tv_cmp_le_u32 s[90:91], %1, %5\n\t"
                "v_cmp_le_u32 s[92:93], %1, %6\n\tv_cmp_le_u32 s[94:95], %1, %7\n\tv_cmp_le_u32 s[96:97], %1, %8\n\tv_cmp_le_u32 s[98:99], %1, %9\n\ts_nop 3\n\t"
                "v_writelane_b32 %0, s84, %10\n\tv_writelane_b32 %0, s85, %10+1\n\tv_writelane_b32 %0, s86, %10+2\n\tv_writelane_b32 %0, s87, %10+3\n\t"
                "v_writelane_b32 %0, s88, %10+4\n\tv_writelane_b32 %0, s89, %10+5\n\tv_writelane_b32 %0, s90, %10+6\n\tv_writelane_b32 %0, s91, %10+7\n\t"
                "v_writelane_b32 %0, s92, %10+8\n\tv_writelane_b32 %0, s93, %10+9\n\tv_writelane_b32 %0, s94, %10+10\n\tv_writelane_b32 %0, s95, %10+11\n\t"
                "v_writelane_b32 %0, s96, %10+12\n\tv_writelane_b32 %0, s97, %10+13\n\tv_writelane_b32 %0, s98, %10+14\n\tv_writelane_b32 %0, s99, %10+15"
                : "+v"(myword) : "v"(T), "v"(u[8 * g]), "v"(u[8 * g + 1]), "v"(u[8 * g + 2]), "v"(u[8 * g + 3]), "v"(u[8 * g + 4]), "v"(u[8 * g + 5]), "v"(u[8 * g + 6]), "v"(u[8 * g + 7]), "i"(16 * g)
                : "s84", "s85", "s86", "s87", "s88", "s89", "s90", "s91", "s92", "s93", "s94", "s95", "s96", "s97", "s98", "s99");
        }
    } else {
        int cgt = 0;
#pragma unroll
        for (int i = 0; i < 32; ++i) cgt += __popcll(__ballot(u[i] > T));
        const int need = 256 - cgt;
        int running = 0;
        const unsigned long long ltmask = (1ull << lane) - 1ull;
#pragma unroll
        for (int i = 0; i < 32; ++i) {
            const unsigned long long eq = __ballot(u[i] == T);
            const int pre = running + __popcll(eq & ltmask);
            const bool selb = (u[i] > T) || ((u[i] == T) && (pre < need));
            const unsigned long long bal = __ballot(selb);
            running += __popcll(eq);
            if ((lane >> 1) == i) myword = (lane & 1) ? (unsigned)(bal >> 32) : (unsigned)bal;
            __builtin_amdgcn_sched_barrier(0);
        }
    }
    return myword;
}
__device__ __forceinline__ void sel_step(const Ctx& C, const Args& a, int b, int j) {
    const bf16_t* HB = (const bf16_t*)(a.ws + WS_HB); unsigned* SEL = (unsigned*)(a.ws + WS_SEL);
    LAS float* sc_lds = (LAS float*)C.lds;
    int lane_op = C.lane; asm volatile("" : "+v"(lane_op));
    const int lane = lane_op, wid = C.wid, t0 = 16 * j;
    const size_t rb = (size_t)b * SEQ;
    if (t0 + 15 < 256) {
#pragma unroll
        for (int rr = 0; rr < 2; ++rr) SEL[(rb + t0 + 2 * wid + rr) * 64 + lane] = 0xFFFFFFFFu;
        return;
    }
    const int nkt = j + 1;
    {
        const int q = lane & 15, kq = lane >> 4;
        const bf16_t* qrow = HB + (rb + t0 + q) * NV;
        bf16x8 ak[16];
#pragma unroll
        for (int i = 0; i < 16; ++i) { const int kt = wid + 8 * i; if (kt < nkt) ak[i] = *(const bf16x8*)(HB + (rb + 16 * kt + q) * NV + V_CIK + 8 * kq); }
        bf16x8 bq[8];
#pragma unroll
        for (int h = 0; h < 8; ++h) bq[h] = *(const bf16x8*)(qrow + V_CIQ + h * 32 + 8 * kq);
        const u32x4 wv = *(const u32x4*)(qrow + V_CIW);
        float w[8]; const float wsc = 0.35355339059327373f * 0.17677669529663687f;
        w[0] = bflo(wv.x) * wsc; w[1] = bfhi(wv.x) * wsc; w[2] = bflo(wv.y) * wsc; w[3] = bfhi(wv.y) * wsc;
        w[4] = bflo(wv.z) * wsc; w[5] = bfhi(wv.z) * wsc; w[6] = bflo(wv.w) * wsc; w[7] = bfhi(wv.w) * wsc;
        for (int rep = 0; rep < NREP(9); ++rep)
#pragma unroll
        for (int i = 0; i < 16; ++i) { const int kt = wid + 8 * i;
            if (kt < nkt) {
                f32x4 s = {0.f, 0.f, 0.f, 0.f};
#pragma unroll
                for (int h = 0; h < 8; ++h) { const f32x4 d = mfma16(ak[i], bq[h], (f32x4){0.f, 0.f, 0.f, 0.f});
#pragma unroll
                    for (int e = 0; e < 4; ++e) s[e] = fmaf(w[h], fmaxf(d[e], 0.f), s[e]); }
                *(LAS f32x4*)(sc_lds + q * SEL_RS + 16 * kt + 4 * kq) = s;
            } }
    }
    __syncthreads();
    for (int rep = 0; rep < NREP(15); ++rep)
#pragma unroll 1
    for (int rr = 0; rr < 2; ++rr) {
        const int q = 2 * wid + rr, t = t0 + q;
        LAS unsigned* hist = (LAS unsigned*)(C.lds + LDS_HIST + wid * HIST_WAVE);
        LAS unsigned* cand = hist + 512; LAS unsigned* ccnt = hist + 640;
        float v[32]; unsigned u[32];
        float vmin = 3.0e38f, vmax = -3.0e38f;
#pragma unroll
        for (int i = 0; i < 32; ++i) { const int key = lane + 64 * i; const int kc = key <= t ? key : t;
            const float x = sc_lds[q * SEL_RS + kc] + 0.0f;
            v[i] = x; u[i] = (key <= t) ? sel_key(x) : 0u; vmin = fminf(vmin, x); vmax = fmaxf(vmax, x); }
        *(LAS u32x4*)(hist + 8 * lane) = (u32x4){0u, 0u, 0u, 0u}; *(LAS u32x4*)(hist + 8 * lane + 4) = (u32x4){0u, 0u, 0u, 0u};
        if (lane == 0) ccnt[0] = 0u;
        const unsigned kmin = wave_min_dpp(sel_key(vmin)), kmax = wave_max_dpp(sel_key(vmax));
        const float fmin_ = (kmin & 0x80000000u) ? __uint_as_float(kmin & 0x7FFFFFFFu) : __uint_as_float(~kmin);
        const float fmax_ = (kmax & 0x80000000u) ? __uint_as_float(kmax & 0x7FFFFFFFu) : __uint_as_float(~kmax);
        const float range = fmax_ - fmin_;
        const float scale = range > 0.f ? 511.0f / range : 0.f;
        int bin[32];
#pragma unroll
        for (int i = 0; i < 32; ++i) { const float bf = (v[i] - fmin_) * scale; int bi = (int)bf; bi = bi < 0 ? 0 : (bi > 511 ? 511 : bi); bin[i] = bi; }
#pragma unroll
        for (int i = 0; i < 32; ++i) { if (lane + 64 * i <= t) atomicAdd((unsigned*)(hist + bin[i]), 1u); }
        asm volatile("s_waitcnt lgkmcnt(0)" ::: "memory");
        const u32x4 h0 = *(LAS const u32x4*)(hist + 8 * lane), h1 = *(LAS const u32x4*)(hist + 8 * lane + 4);
        const int hb[8] = {(int)h0[0], (int)h0[1], (int)h0[2], (int)h0[3], (int)h1[0], (int)h1[1], (int)h1[2], (int)h1[3]};
        const int own = (hb[0] + hb[1]) + (hb[2] + hb[3]) + (hb[4] + hb[5]) + (hb[6] + hb[7]);
        int incl = own;
#pragma unroll
        for (int o = 1; o < 64; o <<= 1) { const int x = __shfl_down(incl, o); if (lane + o < 64) incl += x; }
        const int above_lane = incl - own;
        const bool mine = (above_lane < 256) && (incl >= 256);
        int bstar = 0, above = 0;
        {
            int acc = above_lane, bs = 0, ab = 0; bool found = false;
#pragma unroll
            for (int k = 7; k >= 0; --k) { if (!found && acc + hb[k] >= 256) { found = true; bs = 8 * lane + k; ab = acc; } acc += hb[k]; }
            const unsigned long long mb = __ballot(mine);
            const int src = mb ? (int)__builtin_ctzll(mb) : 0;
            bstar = __shfl(bs, src); above = __shfl(ab, src);
        }
        const int need = 256 - above;
#pragma unroll
        for (int i = 0; i < 32; ++i) { if ((lane + 64 * i <= t) && bin[i] == bstar) { const unsigned slot = atomicAdd((unsigned*)ccnt, 1u); if (slot < 64u) cand[slot] = u[i]; } }
        asm volatile("s_waitcnt lgkmcnt(0)" ::: "memory");
        const int m = (int)ccnt[0];
        unsigned T = 0u; bool exact = false;
        if (m <= 64) {
            const unsigned mykey = (lane < m) ? cand[lane] : 0u;
            int cge = 0;
            for (int i = 0; i < m; ++i) { const unsigned ki = (unsigned)__builtin_amdgcn_readlane((int)mykey, i); cge += (ki >= mykey) ? 1 : 0; }
            T = wave_max_dpp((lane < m && cge >= need) ? mykey : 0u);
            exact = (int)wave_max_dpp((lane < m && mykey == T) ? (unsigned)cge : 0u) == need;
        } else {
#pragma unroll 1
            for (int bit = 31; bit >= 0; --bit) {
                const unsigned x = T | (1u << bit);
                int c = 0;
#pragma unroll
                for (int i = 0; i < 32; ++i) c += (u[i] >= x) ? 1 : 0;
                c = wave_sum_dpp(c);
                if (c >= 256) { T = x; if (c == 256) { exact = true; break; } }
            }
        }
        for (int rep2 = 0; rep2 < NREP(16); ++rep2) { asm volatile("" : "+v"(u[0])); SEL[(rb + t) * 64 + lane] = sel_words(u, T, exact, lane); }
    }
    __syncthreads();
}
__device__ __forceinline__ void p2_select(const Ctx& C, const Args& a) {
    for (int v = C.vcu; v < NB * 16; v += C.G) {
        const int b = v >> 4, p = v & 15;
#pragma unroll 1
        for (int i = 0; i < 8; ++i) { const int j = (i & 1) ? (32 * (i >> 1) + 31 - p) : (32 * (i >> 1) + p); sel_step(C, a, b, j); }
    }
}

struct TileRegs { u32x4 k0, k1, v; };
struct AttnSrc { const bf16_t* Kp; int kpitch; const bf16_t* Kr; const bf16_t* Vp; int vpitch; };
template <int NCH>
__device__ __forceinline__ void tile_load(TileRegs& r, const AttnSrc& s, int key0, int wid, int lane) {
    r.k0 = *(const u32x4*)(s.Kp + (size_t)(key0 + lane) * s.kpitch + wid * 8);
    if (NCH == 12) { if (wid < 4) r.k1 = *(const u32x4*)(s.Kr + (size_t)(key0 + lane) * 32 + wid * 8); }
    r.v = *(const u32x4*)(s.Vp + (size_t)(key0 + 16 * (wid & 3) + (lane >> 2)) * s.vpitch + (wid >> 2) * 32 + (lane & 3) * 8);
}
template <int NCH>
__device__ __forceinline__ void tile_write(const TileRegs& r, LAS unsigned char* kb, LAS unsigned char* vb, int wid, int lane) {
    *(LAS u32x4*)(kb + wid * 1024 + lane * 16) = r.k0;
    if (NCH == 12) { if (wid < 4) *(LAS u32x4*)(kb + (8 + wid) * 1024 + lane * 16) = r.k1; }
    *(LAS u32x4*)(vb + wid * 1024 + lane * 16) = r.v;
}
template <int ND>
__device__ __forceinline__ void qk_tile(f32x16& p0, f32x16& p1, LAS const unsigned char* kb, int cb, const bf16x8* qf, int r32, int hi) {
#pragma unroll
    for (int d0 = 0; d0 < ND; ++d0) {
        const bf16x8 a0 = *(LAS const bf16x8*)(kb + (cb + 2 * d0 + hi) * 1024 + r32 * 16);
        const bf16x8 a1 = *(LAS const bf16x8*)(kb + (cb + 2 * d0 + hi) * 1024 + 512 + r32 * 16);
        p0 = mfma32(a0, qf[d0], p0); p1 = mfma32(a1, qf[d0], p1);
    }
}
__device__ __forceinline__ bf16x8 pack8(const f32x16& p, int base) {
    u32x4 w; w.x = cvtpk(p[base + 0], p[base + 1]); w.y = cvtpk(p[base + 2], p[base + 3]); w.z = cvtpk(p[base + 4], p[base + 5]); w.w = cvtpk(p[base + 6], p[base + 7]);
    return __builtin_bit_cast(bf16x8, w);
}
__device__ __forceinline__ void pv_half(f32x16 (&o)[2], LAS const unsigned char* vb, int lane, int hi, int ks0, bf16x8 pa, bf16x8 pb) {
    LAS const unsigned char* vp = vb + ((lane >> 4) & 1) * 32 + (lane & 3) * 8 + (4 * hi + ((lane & 15) >> 2)) * 64;
#pragma unroll
    for (int d0 = 0; d0 < 2; ++d0) {
#pragma unroll
        for (int k = 0; k < 2; ++k) {
            const v4i16_t lo = vtr(vp + d0 * 4096 + (ks0 + k) * 1024), hh = vtr(vp + d0 * 4096 + (ks0 + k) * 1024 + 512);
            const bf16x8 vf = {lo[0], lo[1], lo[2], lo[3], hh[0], hh[1], hh[2], hh[3]};
            o[d0] = mfma32(vf, k == 0 ? pa : pb, o[d0]);
        }
    }
}
__device__ __forceinline__ void store_gated(const f32x16 (&o)[2], const bf16_t* HB, bf16_t* OB, size_t row, int colg, int hi) {
#pragma unroll
    for (int d0 = 0; d0 < 2; ++d0)
#pragma unroll
        for (int g4 = 0; g4 < 4; ++g4) {
            const int d = 32 * d0 + 8 * g4 + 4 * hi;
            const u32x2 g = *(const u32x2*)(HB + row * NV + V_GATE + colg + d);
            u32x2 w; w.x = cvtpk(o[d0][4 * g4 + 0] * bflo(g.x), o[d0][4 * g4 + 1] * bfhi(g.x)); w.y = cvtpk(o[d0][4 * g4 + 2] * bflo(g.y), o[d0][4 * g4 + 3] * bfhi(g.y));
            *(u32x2*)(OB + row * DM + colg + d) = w;
        }
}

struct SmState { float m, l; f32x16 o[2]; };
__device__ __forceinline__ void sm_stats(SmState& st, f32x16& x0, f32x16& x1) {
    float mx = x0[0];
#pragma unroll
    for (int r = 1; r < 16; ++r) mx = fmaxf(mx, x0[r]);
#pragma unroll
    for (int r = 0; r < 16; ++r) mx = fmaxf(mx, x1[r]);
    mx = xhalf_max(mx);
    const float mn = fmaxf(st.m, mx);
    const float ms = (mn == -INFINITY) ? 0.f : mn;
    float ls = 0.f;
#pragma unroll
    for (int r = 0; r < 16; ++r) { x0[r] = __builtin_amdgcn_exp2f(x0[r] - ms); x1[r] = __builtin_amdgcn_exp2f(x1[r] - ms); ls += x0[r] + x1[r]; }
    if (__any(mn != st.m)) {
        const float alpha = __builtin_amdgcn_exp2f(st.m - ms);
        st.l *= alpha;
#pragma unroll
        for (int r = 0; r < 16; ++r) { st.o[0][r] *= alpha; st.o[1][r] *= alpha; }
    }
    st.l += ls; st.m = mn;
}
__device__ __forceinline__ void v_frags(bf16x8 (&vf)[2][4], LAS const unsigned char* vb, int lane, int hi) {
    LAS const unsigned char* vp = vb + ((lane >> 4) & 1) * 32 + (lane & 3) * 8 + (4 * hi + ((lane & 15) >> 2)) * 64;
#pragma unroll
    for (int d0 = 0; d0 < 2; ++d0)
#pragma unroll
        for (int ks = 0; ks < 4; ++ks) {
            const v4i16_t lo = vtr(vp + d0 * 4096 + ks * 1024), hh = vtr(vp + d0 * 4096 + ks * 1024 + 512);
            vf[d0][ks] = (bf16x8){lo[0], lo[1], lo[2], lo[3], hh[0], hh[1], hh[2], hh[3]};
        }
}
__device__ __forceinline__ void pv_tile(f32x16 (&o)[2], const bf16x8 (&vf)[2][4], const f32x16& x0, const f32x16& x1) {
    const bf16x8 p0 = pack8(x0, 0), p1 = pack8(x0, 8), p2 = pack8(x1, 0), p3 = pack8(x1, 8);
#pragma unroll
    for (int d0 = 0; d0 < 2; ++d0) { o[d0] = mfma32(vf[d0][0], p0, o[d0]); o[d0] = mfma32(vf[d0][1], p1, o[d0]); o[d0] = mfma32(vf[d0][2], p2, o[d0]); o[d0] = mfma32(vf[d0][3], p3, o[d0]); }
}

template <int MODE>
__device__ __forceinline__ void attn_unit_sm(const Ctx& C, const Args& a, int layer, int b, int h, int qb) {
    constexpr int NCH = (MODE == 3) ? 12 : 8;
    const bf16_t* HB = (const bf16_t*)(a.ws + WS_HB); const bf16_t* MD = (const bf16_t*)(a.ws + WS_MD); const bf16_t* KR = (const bf16_t*)(a.ws + WS_KR);
    bf16_t* OB = (bf16_t*)(a.ws + WS_XB); const unsigned* SEL = (const unsigned*)(a.ws + WS_SEL);
    int lane_op = C.lane; asm volatile("" : "+v"(lane_op));
    const int lane = lane_op, wid = C.wid, r32 = lane & 31, hi = lane >> 5;
    const size_t rb = (size_t)b * SEQ;
    const int q0 = 256 * qb, tq = q0 + 32 * wid + r32;
    const size_t qrow = rb + tq;
    LAS unsigned char* lds = C.lds;
    LAS float* btab = (LAS float*)(lds + AL_BIAS);
    AttnSrc src;
    if (MODE == 1) { src.Kp = HB + rb * NV + V_BK + h * 64; src.kpitch = NV; src.Kr = nullptr; src.Vp = HB + rb * NV + V_BV + h * 64; src.vpitch = NV; }
    if (MODE == 2) { src.Kp = HB + rb * NV + V_CK + h * 64; src.kpitch = NV; src.Kr = nullptr; src.Vp = HB + rb * NV + V_CV + h * 64; src.vpitch = NV; }
    if (MODE == 3) { src.Kp = MD + rb * DM + MD_KN + h * 64; src.kpitch = DM; src.Kr = KR + rb * 32; src.Vp = MD + rb * DM + MD_V + h * 64; src.vpitch = DM; }
    if (MODE != 3) { if (C.tid <= 128) btab[C.tid] = a.rel_bias[t5_bucket(C.tid) * 8 + (MODE == 2 ? 4 : 0) + h] * LOG2E; }
    const float c1 = (MODE == 1 ? 0.17677669529663687f : (MODE == 2 ? 0.125f : 0.10206207261596577f)) * LOG2E;
    auto qscale = [&](bf16x8 q) { u32x4 w = __builtin_bit_cast(u32x4, q);
#pragma unroll
        for (int i = 0; i < 4; ++i) w[i] = cvtpk(bflo(w[i]) * c1, bfhi(w[i]) * c1);
        return __builtin_bit_cast(bf16x8, w); };
    constexpr int NQ = (MODE == 3) ? 6 : (MODE == 1 ? 1 : 4);
    bf16x8 qf[NQ];
    LAS bf16x8* qlds = (LAS bf16x8*)(lds + AL_Q) + wid * 256 + lane;
    if (MODE == 1) {
#pragma unroll
        for (int d0 = 0; d0 < 4; ++d0) qlds[64 * d0] = qscale(*(const bf16x8*)(HB + qrow * NV + V_BQ + h * 64 + 16 * d0 + 8 * hi)); }
    if (MODE == 2) {
#pragma unroll
        for (int d0 = 0; d0 < 4; ++d0) qf[d0] = qscale(*(const bf16x8*)(HB + qrow * NV + V_CQ + h * 64 + 16 * d0 + 8 * hi)); }
    if (MODE == 3) {
#pragma unroll
        for (int d0 = 0; d0 < 4; ++d0) qf[d0] = qscale(*(const bf16x8*)(MD + qrow * DM + MD_QN + h * 64 + 16 * d0 + 8 * hi));
#pragma unroll
        for (int d0 = 0; d0 < 2; ++d0) qf[4 + d0] = *(const bf16x8*)(MD + qrow * DM + MD_QR + h * 32 + 16 * d0 + 8 * hi);
        const f32x2_t* rp = (const f32x2_t*)(a.ws + WS_ROPE) + (size_t)tq * 16 + 8 * hi;
        u32x4 w4 = __builtin_bit_cast(u32x4, qf[4]), w5 = __builtin_bit_cast(u32x4, qf[5]);
#pragma unroll
        for (int jj = 0; jj < 4; ++jj) {
            const f32x2_t cs0 = rp[2 * jj], cs1 = rp[2 * jj + 1];
            const float a0 = bflo(w4[jj]), a1 = bfhi(w4[jj]), b0 = bflo(w5[jj]), b1 = bfhi(w5[jj]);
            w4[jj] = cvtpk((a0 * cs0.x - b0 * cs0.y) * c1, (a1 * cs1.x - b1 * cs1.y) * c1);
            w5[jj] = cvtpk((a0 * cs0.y + b0 * cs0.x) * c1, (a1 * cs1.y + b1 * cs1.x) * c1);
        }
        qf[4] = __builtin_bit_cast(bf16x8, w4); qf[5] = __builtin_bit_cast(bf16x8, w5); }
    SmState s1, s2;
    s1.m = -INFINITY; s1.l = 0.f; s1.o[0] = f32x16{}; s1.o[1] = f32x16{};
    if (MODE == 1) { s2.m = -INFINITY; s2.l = 0.f; s2.o[0] = f32x16{}; s2.o[1] = f32x16{}; }
    const int NT = 4 * (qb + 1), my_last = 4 * qb + (wid >> 1);
    const int tmin = q0 + 32 * wid;
    TileRegs tr;
    tile_load<NCH>(tr, src, 0, wid, lane);
    tile_write<NCH>(tr, lds + AL_K, lds + AL_V, wid, lane);
    __syncthreads();
#pragma unroll 1
    for (int tt = 0; tt < NT; ++tt) {
        const int cur = tt & 1;
        if (tt + 1 < NT) tile_load<NCH>(tr, src, 64 * (tt + 1), wid, lane);
        if (tt <= my_last) {
            LAS const unsigned char* kb = lds + AL_K + cur * AL_KB; LAS const unsigned char* vb = lds + AL_V + cur * AL_VB;
            const int key0 = 64 * tt;
            const bool diag = (tt == my_last);
            const bool farb = (MODE != 3) && (key0 + 63 + 128 <= tmin);
            const float pinit = farb ? btab[128] : 0.f;
            u32x2 wsel = {0u, 0u};
            if (MODE == 2) wsel = *(const u32x2*)(SEL + qrow * 64 + 2 * tt);
            auto finish_scores = [&](f32x16& p0, f32x16& p1) {
                if (MODE != 3 && !farb) {
#pragma unroll
                    for (int r = 0; r < 16; ++r) { int d0i = tq - (key0 + crow(r, hi)); int d1i = d0i - 32;
                        d0i = d0i < 0 ? 0 : (d0i > 128 ? 128 : d0i); d1i = d1i < 0 ? 0 : (d1i > 128 ? 128 : d1i);
                        p0[r] += btab[d0i]; p1[r] += btab[d1i]; }
                }
                if (diag) {
#pragma unroll
                    for (int r = 0; r < 16; ++r) { const int k0i = key0 + crow(r, hi); if (k0i > tq) p0[r] = -INFINITY; if (k0i + 32 > tq) p1[r] = -INFINITY; }
                }
                if (MODE == 2) {
                    const unsigned w0 = wsel.x >> (4 * hi), w1 = wsel.y >> (4 * hi);
#pragma unroll
                    for (int r = 0; r < 16; ++r) { const int bp = (r & 3) + 8 * (r >> 2); if (!((w0 >> bp) & 1u)) p0[r] = -INFINITY; if (!((w1 >> bp) & 1u)) p1[r] = -INFINITY; }
                }
            };
            f32x16 pz;
#pragma unroll
            for (int r = 0; r < 16; ++r) pz[r] = pinit;
            bf16x8 vf[2][4];
            if (MODE == 1) {
                f32x16 a0 = pz, a1 = pz, b0 = pz, b1 = pz;
                { bf16x8 q2[2] = {qlds[0], qlds[64]}; qk_tile<2>(a0, a1, kb, 0, q2, r32, hi); }
                { bf16x8 q2[2] = {qlds[128], qlds[192]}; qk_tile<2>(b0, b1, kb, 4, q2, r32, hi); }
                finish_scores(a0, a1); sm_stats(s1, a0, a1);
                finish_scores(b0, b1); sm_stats(s2, b0, b1);
                v_frags(vf, vb, lane, hi);
                pv_tile(s1.o, vf, a0, a1); pv_tile(s2.o, vf, b0, b1);
            } else {
                f32x16 p0 = pz, p1 = pz;
                qk_tile<(MODE == 3 ? 6 : 4)>(p0, p1, kb, 0, qf, r32, hi);
                finish_scores(p0, p1); sm_stats(s1, p0, p1);
                v_frags(vf, vb, lane, hi);
                pv_tile(s1.o, vf, p0, p1);
            }
        }
        if (tt + 1 < NT) tile_write<NCH>(tr, lds + AL_K + (cur ^ 1) * AL_KB, lds + AL_V + (cur ^ 1) * AL_VB, wid, lane);
        __syncthreads();
    }
    const float l1 = xhalf_sum(s1.l), il1 = 1.0f / l1;
    if (MODE == 1) {
        const float* dl = a.diff_lambda + layer * 128;
        float a0 = 0.f, a1 = 0.f;
        if (lane < 32) { a0 = dl[lane] * dl[32 + lane]; a1 = dl[64 + lane] * dl[96 + lane]; }
        const float lam_init = (layer == 0) ? 0.2f : 0.35550906779f;
        const float lam = expf(wave_sum(a0)) - expf(wave_sum(a1)) + lam_init;
        const float l2 = xhalf_sum(s2.l), f2 = lam / l2;
        float ss = 0.f;
#pragma unroll
        for (int d0 = 0; d0 < 2; ++d0)
#pragma unroll
            for (int r = 0; r < 16; ++r) { const float v = s1.o[d0][r] * il1 - s2.o[d0][r] * f2; s1.o[d0][r] = v; ss += v * v; }
        ss = xhalf_sum(ss);
        const float rn = (1.0f / sqrtf(ss * (1.0f / 64.0f) + 1e-6f)) * (1.0f - lam_init);
        const float* sg = a.diff_subln + layer * 64;
#pragma unroll
        for (int d0 = 0; d0 < 2; ++d0)
#pragma unroll
            for (int g4 = 0; g4 < 4; ++g4) { const f32x4 gv = *(const f32x4*)(sg + 32 * d0 + 8 * g4 + 4 * hi);
#pragma unroll
                for (int i = 0; i < 4; ++i) s1.o[d0][4 * g4 + i] *= rn * gv[i]; }
    } else {
#pragma unroll
        for (int d0 = 0; d0 < 2; ++d0)
#pragma unroll
            for (int r = 0; r < 16; ++r) s1.o[d0][r] *= il1;
    }
    store_gated(s1.o, HB, OB, qrow, MODE * 256 + h * 64, hi);
}

__device__ __forceinline__ void sb_tile_load(u32x4 (&kr)[8], u32x4 (&vr)[8], const bf16_t* Kp, const bf16_t* Vp, int key0, int lane) {
#pragma unroll
    for (int c = 0; c < 8; ++c) kr[c] = *(const u32x4*)(Kp + (size_t)(key0 + lane) * NV + c * 8);
#pragma unroll
    for (int w = 0; w < 8; ++w) vr[w] = *(const u32x4*)(Vp + (size_t)(key0 + 16 * (w & 3) + (lane >> 2)) * NV + (w >> 2) * 32 + (lane & 3) * 8);
}
__device__ __forceinline__ void sb_tile_write(const u32x4 (&kr)[8], const u32x4 (&vr)[8], LAS unsigned char* kb, LAS unsigned char* vb, int lane) {
#pragma unroll
    for (int c = 0; c < 8; ++c) *(LAS u32x4*)(kb + c * 1024 + lane * 16) = kr[c];
#pragma unroll
    for (int w = 0; w < 8; ++w) *(LAS u32x4*)(vb + w * 1024 + lane * 16) = vr[w];
}
__device__ __forceinline__ void attn_item_sb(const Ctx& C, const Args& a, int b, int h, int qw) {
    const bf16_t* HB = (const bf16_t*)(a.ws + WS_HB); bf16_t* OB = (bf16_t*)(a.ws + WS_XB);
    int lane_op = C.lane; asm volatile("" : "+v"(lane_op));
    const int lane = lane_op, wid = C.wid, r32 = lane & 31, hi = lane >> 5;
    const size_t rb = (size_t)b * SEQ;
    const int tq = 32 * qw + r32;
    const size_t qrow = rb + tq;
    LAS unsigned char* kb = C.lds + wid * 16384; LAS unsigned char* vb = kb + 8192;
    const bf16_t* Kp = HB + rb * NV + V_AK + h * 64; const bf16_t* Vp = HB + rb * NV + V_AV + h * 64;
    bf16x8 qf[4];
#pragma unroll
    for (int d0 = 0; d0 < 4; ++d0) qf[d0] = *(const bf16x8*)(HB + qrow * NV + V_AQ + h * 64 + 16 * d0 + 8 * hi);
    f32x16 o[2]; o[0] = f32x16{}; o[1] = f32x16{};
    float carry = 0.f;
    const int t_first = qw >> 1;
    u32x4 kr[8], vr[8];
    sb_tile_load(kr, vr, Kp, Vp, 64 * t_first, lane);
#pragma unroll 1
    for (int tt = t_first; tt >= 0; --tt) {
        sb_tile_write(kr, vr, kb, vb, lane);
        if (tt > 0) sb_tile_load(kr, vr, Kp, Vp, 64 * (tt - 1), lane);
        f32x16 p0 = f32x16{}, p1 = f32x16{};
        qk_tile<4>(p0, p1, kb, 0, qf, r32, hi);
        const int key0 = 64 * tt;
#pragma unroll
        for (int sub = 1; sub >= 0; --sub) {
            f32x16& p = sub ? p1 : p0;
            float x[16], ls[16];
#pragma unroll
            for (int r = 0; r < 16; ++r) {
                const float z = p[r] * 0.125f;
                const float e = __builtin_amdgcn_exp2f(-fabsf(z) * LOG2E);
                const float sp = fmaxf(z, 0.f) + __builtin_amdgcn_logf(1.0f + e) * LN2;
                x[r] = -sp;
                ls[r] = z - sp;
            }
            if (tt == t_first) {
#pragma unroll
                for (int r = 0; r < 16; ++r) { const bool valid = (key0 + 32 * sub + crow(r, hi)) < tq; x[r] = valid ? x[r] : 0.f; ls[r] = valid ? ls[r] : -INFINITY; __builtin_amdgcn_sched_barrier(0); }
            }
            float ex[16], gs[4];
#pragma unroll
            for (int g = 0; g < 4; ++g) { ex[4 * g + 3] = 0.f; ex[4 * g + 2] = x[4 * g + 3]; ex[4 * g + 1] = ex[4 * g + 2] + x[4 * g + 2]; ex[4 * g + 0] = ex[4 * g + 1] + x[4 * g + 1]; gs[g] = ex[4 * g] + x[4 * g]; }
            float oth[4], pr[4];
#pragma unroll
            for (int g = 0; g < 4; ++g) { oth[g] = xhalf_other(gs[g], hi); pr[g] = gs[g] + oth[g]; }
            float tail[4]; tail[3] = 0.f; tail[2] = pr[3]; tail[1] = pr[3] + pr[2]; tail[0] = tail[1] + pr[1];
            const float total = tail[0] + pr[0];
#pragma unroll
            for (int g = 0; g < 4; ++g) { const float off = carry + tail[g] + (hi == 0 ? oth[g] : 0.f);
#pragma unroll
                for (int i = 0; i < 4; ++i) p[4 * g + i] = __builtin_amdgcn_exp2f((ls[4 * g + i] + (off + ex[4 * g + i])) * LOG2E); }
            carry += total;
            pv_half(o, vb, lane, hi, 2 * sub, pack8(p, 0), pack8(p, 8));
        }
        if (__all(carry < -104.0f)) break;
    }
    store_gated(o, HB, OB, qrow, 0 * 256 + h * 64, hi);
}

__device__ __forceinline__ void p4_attention(const Ctx& C, const Args& a, int layer) {
    const int npair = 3 * NB * 16;
    for (int u = C.vcu; u < npair; u += C.G) {
        const int g = u / (NB * 16), rem = u % (NB * 16), b = rem >> 4, h = (rem >> 2) & 3, p = rem & 3;
#pragma unroll 1
        for (int k = 0; k < 2; ++k) {
            const int qb = k ? 7 - p : p;
            if (g == 0) { for (int rep = 0; rep < NREP(11); ++rep) if (HAS(9)) attn_unit_sm<1>(C, a, layer, b, h, qb); }
            else if (g == 1) { for (int rep = 0; rep < NREP(12); ++rep) if (HAS(10)) attn_unit_sm<2>(C, a, layer, b, h, qb); }
            else { for (int rep = 0; rep < NREP(13); ++rep) if (HAS(11)) attn_unit_sm<3>(C, a, layer, b, h, qb); }
        }
    }
    __syncthreads();
    for (int it = C.vcu * NWAVES + C.wid; it < NB * 256; it += C.G * NWAVES) { const int b = it >> 8, h = (it >> 6) & 3, qw = it & 63; for (int rep = 0; rep < NREP(14); ++rep) if (HAS(8)) attn_item_sb(C, a, b, h, qw); }
    __syncthreads();
}

__device__ __forceinline__ void p6_layernorm(const Ctx& C, const Args& a, int layer) {
    const float* Z = (const float*)(a.ws + WS_HB); bf16_t* XB = (bf16_t*)(a.ws + WS_XB);
    const float* g = a.ln_g + layer * DM; const float* bb = a.ln_b + layer * DM;
    const int gw = C.vcu * NWAVES + C.wid, NGW = C.G * NWAVES, lane = C.lane;
    f32x4 gv[4], bv[4];
#pragma unroll
    for (int j = 0; j < 4; ++j) { gv[j] = *(const f32x4*)(g + 256 * j + 4 * lane); bv[j] = *(const f32x4*)(bb + 256 * j + 4 * lane); }
    for (int m = gw; m < M_TOK; m += NGW) {
        f32x4 v[4]; float s = 0.f;
#pragma unroll
        for (int j = 0; j < 4; ++j) { v[j] = *(const f32x4*)(Z + (size_t)m * DM + 256 * j + 4 * lane); s += (v[j][0] + v[j][1]) + (v[j][2] + v[j][3]); }
        const float mean = wave_sum(s) * (1.0f / DM); float s2 = 0.f;
#pragma unroll
        for (int j = 0; j < 4; ++j) { v[j] = v[j] - mean; s2 += (v[j][0] * v[j][0] + v[j][1] * v[j][1]) + (v[j][2] * v[j][2] + v[j][3] * v[j][3]); }
        const float rstd = 1.0f / sqrtf(wave_sum(s2) * (1.0f / DM) + 1e-5f);
#pragma unroll
        for (int j = 0; j < 4; ++j) { const f32x4 o = v[j] * rstd * gv[j] + bv[j];
            *(f32x4*)(a.out + (size_t)m * DM + 256 * j + 4 * lane) = o;
            if (layer + 1 < DEPTH) { u32x2 w; w.x = cvtpk(o[0], o[1]); w.y = cvtpk(o[2], o[3]); *(u32x2*)(XB + (size_t)m * DM + 256 * j + 4 * lane) = w; } }
    }
}

#define RLX_AGENT __ATOMIC_RELAXED, __HIP_MEMORY_SCOPE_AGENT
#define XB_TMO      128
#define XB_XCNT(j)  (256  + 64 * (j))
#define XB_XSUB(j)  (1280 + 64 * (j))
#define XB_XGEN(j)  (2304 + 64 * (j))
#define XB_TOP      3328
#define XB_TOPGEN   3392
#define XCD_BAR_WORDS 3456
#define XB_SPIN_CAP (1u << 18)

__device__ __forceinline__ unsigned xb_ld(unsigned* p)              { return __hip_atomic_load(p, __ATOMIC_RELAXED, __HIP_MEMORY_SCOPE_AGENT); }
__device__ __forceinline__ unsigned xb_add(unsigned* p, unsigned v) { return __hip_atomic_fetch_add(p, v, __ATOMIC_RELAXED, __HIP_MEMORY_SCOPE_AGENT); }
__device__ __forceinline__ unsigned xb_xcc_id() { return (unsigned)__builtin_amdgcn_s_getreg((3 << 11) | 20) & 0xFu; }
#define XB_SPIN(cond, bar) do { unsigned _sp = 0; while (cond) { __builtin_amdgcn_s_sleep(1); \
    if ((++_sp & 255u) == 0u) { if (xb_ld(&(bar)[XB_TMO])) break; if (_sp > XB_SPIN_CAP) { atomicAdd(&(bar)[XB_TMO], 1u); break; } } } } while (0)

struct XcdBarrier {
    unsigned* bar; unsigned x;
    volatile LAS unsigned* st;
};

__device__ __forceinline__ XcdBarrier xcd_barrier_post(unsigned* bar, volatile LAS unsigned* st, bool leader) {
    XcdBarrier b; b.bar = bar; b.x = xb_xcc_id(); b.st = st;
    if (leader) (void)xb_add(&bar[XB_XCNT(b.x)], 1u);
    return b;
}
__device__ __forceinline__ void xcd_barrier_complete(unsigned* bar, unsigned x, unsigned& nloc, unsigned& nx) {
    const unsigned G = gridDim.x * gridDim.y * gridDim.z;
    unsigned sum, cnt, mine, sp = 0u;
    for (;;) {
        sum = 0u; cnt = 0u; mine = 0u;
#pragma unroll
        for (unsigned j = 0; j < 16; ++j) { const unsigned c = xb_ld(&bar[XB_XCNT(j)]); sum += c; cnt += (c > 0u) ? 1u : 0u; mine = (j == x) ? c : mine; }
        if (sum == G) break;
        __builtin_amdgcn_s_sleep(1);
        if ((++sp & 255u) == 0u) { if (xb_ld(&bar[XB_TMO])) break; if (sp > XB_SPIN_CAP) { atomicAdd(&bar[XB_TMO], 1u); break; } }
    }
    nloc = mine > 0u ? mine : 1u; nx = cnt > 0u ? cnt : 1u;
}

__device__ __forceinline__ void xcd_barrier(const XcdBarrier& b, bool leader) {
    asm volatile("s_waitcnt vmcnt(0)" ::: "memory");
    __syncthreads();
    if (leader) {
        unsigned* bar = b.bar;
        __builtin_amdgcn_s_waitcnt(0);
        unsigned nloc = b.st[0], nx = b.st[1];
        if (nloc == 0u) { xcd_barrier_complete(bar, b.x, nloc, nx); b.st[0] = nloc; b.st[1] = nx; }
        const unsigned old = xb_add(&bar[XB_XSUB(b.x)], 1u);
        const unsigned gen = old / nloc;
        if (old + 1u == (gen + 1u) * nloc) {
            __builtin_amdgcn_fence(__ATOMIC_RELEASE, "agent");
            asm volatile("s_waitcnt vmcnt(0)" ::: "memory");
            const unsigned og = xb_add(&bar[XB_TOP], 1u);
            const unsigned tg = og / nx;
            if (og + 1u == (tg + 1u) * nx) xb_add(&bar[XB_TOPGEN], 1u);
            else XB_SPIN(xb_ld(&bar[XB_TOPGEN]) == tg, bar);
            __builtin_amdgcn_fence(__ATOMIC_ACQUIRE, "agent");
            xb_add(&bar[XB_XGEN(b.x)], 1u);
            asm volatile("s_waitcnt vmcnt(0)" ::: "memory");
        } else {
            XB_SPIN(xb_ld(&bar[XB_XGEN(b.x)]) == gen, bar);
            __builtin_amdgcn_fence(__ATOMIC_ACQUIRE, "agent");
            asm volatile("s_waitcnt vmcnt(0)" ::: "memory");
        }
    }
    __syncthreads();
}

constexpr int N_PHASES = 1 + 6 * DEPTH;
#define IN(k) (lo <= (k) && (k) < hi)
#if DIAG
#define SEAM(k) do { } while (0)
#else
#define SEAM(k) do { if (IN(k) && IN((k) + 1)) { { xcd_barrier(bar, C.wid == 0 && C.lane == 0); if (REP_PH == 8) xcd_barrier(bar, C.wid == 0 && C.lane == 0); } } } while (0)
#endif
#define REFRESH() do { int l_op; asm volatile("v_mbcnt_lo_u32_b32 %0, -1, 0\n\tv_mbcnt_hi_u32_b32 %0, -1, %0" : "=v"(l_op)); C.lane = l_op; C.tid = C.wid * 64 + l_op; \
        size_t z_op = 0; asm volatile("" : "+s"(z_op)); al.ws = a.ws + z_op; } while (0)
template <int layer>
__device__ __forceinline__ void layer_body(Ctx& C, const Args& a, Args& al, const int lo, const int hi, cg::grid_group& grid, const XcdBarrier& bar) {
        const int pb = 1 + 6 * layer;
        for (int rep = 0; rep < NREP(1); ++rep) if (HAS(1) && IN(pb)) {
            REFRESH();
            pg8::Gemm g{(const pg8::bf16_t*)(al.ws + WS_XB), (const pg8::bf16_t*)(al.ws + WS_WIN) + (size_t)layer * NV * DM, M_TOK, NV, DM};
            pg8::StaticOrder S; S.init(M_TOK, NV, C.G, (int)blockIdx.x);
            pg8::EpiMain E{(pg8::bf16_t*)(al.ws + WS_HB), NV, 12};
            pg8::gemm_phase<pg8::EpiMain, pg8::StaticOrder, true, true>(C.lds, g, S, E, C.wid);
        }
        SEAM(pb);
        if (IN(pb + 1)) { for (int rep = 0; rep < NREP(2); ++rep) if (HAS(2)) { REFRESH(); p2_mla_prep(C, al, layer); } for (int rep = 0; rep < NREP(7); ++rep) if (HAS(7)) { REFRESH(); p2_select(C, al); } }
        SEAM(pb + 1);
        for (int rep = 0; rep < NREP(3); ++rep) if (HAS(3) && IN(pb + 2)) {
            REFRESH();
            pg8::Gemm g{(const pg8::bf16_t*)(al.ws + WS_CN), (const pg8::bf16_t*)(al.ws + WS_WMLA) + (size_t)layer * 1024 * 384, M_TOK, 1024, 384};
            pg8::StaticOrder S; S.init(M_TOK, 1024, C.G, (int)blockIdx.x);
            pg8::EpiMain E{(pg8::bf16_t*)(al.ws + WS_MD), DM, 1 << 30};
            pg8::gemm_phase<pg8::EpiMain, pg8::StaticOrder, true, true>(C.lds, g, S, E, C.wid);
        }
        SEAM(pb + 2);
        for (int rep = 0; rep < NREP(4); ++rep) if (HAS(4) && IN(pb + 3)) { REFRESH(); p4_attention(C, al, layer); }
        SEAM(pb + 3);
        for (int rep = 0; rep < NREP(5); ++rep) if (HAS(5) && IN(pb + 4)) {
            REFRESH();
            pg8::Gemm g{(const pg8::bf16_t*)(al.ws + WS_XB), (const pg8::bf16_t*)(al.ws + WS_WOUT) + (size_t)layer * DM * DM, M_TOK, DM, DM};
            pg8::StaticOrder S; S.init(M_TOK, DM, C.G, (int)blockIdx.x);
            pg8::EpiOut E{layer == 0 ? al.x : al.out, (float*)(al.ws + WS_HB), ALPHA_RES};
            pg8::gemm_phase<pg8::EpiOut, pg8::StaticOrder, true, true>(C.lds, g, S, E, C.wid);
        }
        SEAM(pb + 4);
        for (int rep = 0; rep < NREP(6); ++rep) if (HAS(6) && IN(pb + 5)) { REFRESH(); p6_layernorm(C, al, layer); }
        SEAM(pb + 5);
}
__global__ void __launch_bounds__(NTHREADS, 2) mega_fwd(Args a) {
    extern __shared__ __attribute__((aligned(16))) unsigned char lds_raw[];
    cg::grid_group grid = cg::this_grid();
    Ctx C; C.lds = (LAS unsigned char*)lds_raw; C.tid = threadIdx.x; C.lane = C.tid & 63; C.wid = __builtin_amdgcn_readfirstlane(C.tid >> 6);
    C.G = gridDim.x; { const int bx = blockIdx.x; C.vcu = (C.G % 8 == 0) ? (bx % 8) * (C.G / 8) + bx / 8 : bx; }
    const int lo = a.ph_lo, hi = a.ph_hi;
    Args al = a;
    volatile LAS unsigned* MISC = (volatile LAS unsigned*)(C.lds + LDS_CTL);
    if (C.tid < 16) MISC[C.tid] = 0u;
    __syncthreads();
    XcdBarrier bar = xcd_barrier_post((unsigned*)(a.ws + WS_CTL), MISC, C.tid == 0);
    for (int rep = 0; rep < NREP(0); ++rep) if (HAS(0) && IN(0)) { REFRESH(); p0_prologue(C, al); } SEAM(0);
    layer_body<0>(C, a, al, lo, hi, grid, bar);
    layer_body<1>(C, a, al, lo, hi, grid, bar);
}
#undef IN
#undef SEAM

#if !DIAG
extern "C" void kernel_launch(void* const* d_in, const int* in_sizes, int n_in, void* d_out, int out_size, void* d_ws, size_t ws_size, hipStream_t stream) {
    static int grid = 0;
    if (grid == 0) {
        if (n_in != 12 || in_sizes[0] != M_TOK * DM || out_size != M_TOK * DM || ws_size < WS_END) {
            fprintf(stderr, "kernel_launch: unexpected shapes (n_in %d, x %d, out %d, ws %zu, need %zu); nothing launched\n", n_in, n_in > 0 ? in_sizes[0] : -1, out_size, ws_size, (size_t)WS_END); grid = -1; return; }
        int dev = 0, cus = 0, per_cu = 0;
        (void)hipGetDevice(&dev); (void)hipDeviceGetAttribute(&cus, hipDeviceAttributeMultiprocessorCount, dev);
        if (hipFuncSetAttribute((const void*)mega_fwd, hipFuncAttributeMaxDynamicSharedMemorySize, LDS_BYTES) != hipSuccess) { fprintf(stderr, "kernel_launch: hipFuncSetAttribute failed\n"); grid = -1; return; }
        if (hipOccupancyMaxActiveBlocksPerMultiprocessor(&per_cu, (const void*)mega_fwd, NTHREADS, LDS_BYTES) != hipSuccess || per_cu < 1) { fprintf(stderr, "kernel_launch: occupancy query says %d blocks per CU\n", per_cu); per_cu = 1; }
        (void)hipGetLastError();
        grid = cus;
    }
    if (grid < 0) return;
    Args a{};
    a.x = (const float*)d_in[0]; a.w_in = (const float*)d_in[1]; a.w_out = (const float*)d_in[2]; a.ln_g = (const float*)d_in[3]; a.ln_b = (const float*)d_in[4];
    a.rel_bias = (const float*)d_in[5]; a.diff_lambda = (const float*)d_in[6]; a.diff_subln = (const float*)d_in[7]; a.mla_q_norm = (const float*)d_in[8];
    a.mla_kv_norm = (const float*)d_in[9]; a.mla_w_uq = (const float*)d_in[10]; a.mla_w_ukv = (const float*)d_in[11];
    a.out = (float*)d_out; a.ws = (unsigned char*)d_ws; a.ph_lo = 0; a.ph_hi = N_PHASES;
    if (hipMemsetAsync(d_ws, 0, 16384, stream) != hipSuccess) { fprintf(stderr, "kernel_launch: hipMemsetAsync of the barrier words failed\n"); return; }
    void* args[] = {&a};
    const hipError_t e = hipLaunchCooperativeKernel((const void*)mega_fwd, dim3(grid), dim3(NTHREADS), args, LDS_BYTES, stream);
    if (e != hipSuccess) fprintf(stderr, "kernel_launch: cooperative launch failed: %s (grid %d)\n", hipGetErrorString(e), grid);
}
#endif
#if DIAG
namespace nv {
constexpr int D_MODEL = 1024, BATCH = 16, SEQ = 2048, DEPTH = 2, H = 4, HD = 64;
constexpr int D_IN = 4040;
constexpr int O_AQ = 0, O_AK = 256, O_AV = 512, O_BQ = 768, O_BK = 1024, O_BV = 1280, O_CQ = 1536, O_CK = 1792, O_CV = 2048,
              O_CIQ = 2304, O_CIK = 2560, O_CIW = 2592, O_DCQ = 2600, O_DCKV = 2856, O_DKR = 2984, O_GATE = 3016;
constexpr int CB = 1;
constexpr int MC = CB * SEQ;
constexpr float ALPHA = 1.4142135623730951f;

__global__ void __launch_bounds__(256) gemm_f32(const float* __restrict__ A, int lda, const float* __restrict__ B, int ldb,
                                                float* __restrict__ C, int ldc, int M, int N, int K) {
    __shared__ float As[16][65];
    __shared__ float Bs[16][65];
    const int tx = threadIdx.x & 15, ty = threadIdx.x >> 4;
    const int m0 = blockIdx.y * 64, n0 = blockIdx.x * 64;
    float acc[4][4];
#pragma unroll
    for (int i = 0; i < 4; ++i)
#pragma unroll
        for (int j = 0; j < 4; ++j) acc[i][j] = 0.f;
    for (int k0 = 0; k0 < K; k0 += 16) {
#pragma unroll
        for (int i = 0; i < 4; ++i) {
            const int e = threadIdx.x + i * 256, r = e >> 4, kk = e & 15;
            As[kk][r] = A[(size_t)(m0 + r) * lda + k0 + kk];
        }
#pragma unroll
        for (int i = 0; i < 4; ++i) {
            const int e = threadIdx.x + i * 256, kk = e >> 6, c = e & 63;
            Bs[kk][c] = (n0 + c < N) ? B[(size_t)(k0 + kk) * ldb + n0 + c] : 0.f;
        }
        __syncthreads();
#pragma unroll
        for (int kk = 0; kk < 16; ++kk) {
            float a[4], b[4];
#pragma unroll
            for (int i = 0; i < 4; ++i) a[i] = As[kk][ty * 4 + i];
#pragma unroll
            for (int j = 0; j < 4; ++j) b[j] = Bs[kk][tx * 4 + j];
#pragma unroll
            for (int i = 0; i < 4; ++i)
#pragma unroll
                for (int j = 0; j < 4; ++j) acc[i][j] = fmaf(a[i], b[j], acc[i][j]);
        }
        __syncthreads();
    }
#pragma unroll
    for (int i = 0; i < 4; ++i)
#pragma unroll
        for (int j = 0; j < 4; ++j) {
            const int c = n0 + tx * 4 + j;
            if (c < N) C[(size_t)(m0 + ty * 4 + i) * ldc + c] = acc[i][j];
        }
}

__device__ __forceinline__ float wave_sum(float v) {
#pragma unroll
    for (int o = 1; o < 64; o <<= 1) v += __shfl_xor(v, o);
    return v;
}

__global__ void __launch_bounds__(256) rms_rows(const float* __restrict__ src, int ld, int off, int W, const float* __restrict__ g, float* __restrict__ dst, int M) {
    const int row = blockIdx.x * 4 + (threadIdx.x >> 6), lane = threadIdx.x & 63;
    if (row >= M) return;
    const float* p = src + (size_t)row * ld + off;
    float s = 0.f;
    for (int c = lane; c < W; c += 64) { const float v = p[c]; s += v * v; }
    s = wave_sum(s);
    const float r = 1.0f / sqrtf(s / (float)W + 1e-6f);
    for (int c = lane; c < W; c += 64) dst[(size_t)row * W + c] = p[c] * r * g[c];
}

__device__ __forceinline__ float inv_freq(int i) { return powf(10000.0f, -(float)i / 16.0f); }

__global__ void __launch_bounds__(256) rope_k(float* __restrict__ dq, const float* __restrict__ hbuf, float* __restrict__ kr, int M) {
    const int idx = blockIdx.x * 256 + threadIdx.x;
    if (idx >= M * 16 * 5) return;
    const int i = idx & 15, which = (idx >> 4) % 5, m = idx / 80;
    const int t = m % SEQ;
    const float ang = (float)t * inv_freq(i);
    const float c = cosf(ang), s = sinf(ang);
    if (which < 4) {
        float* p = dq + (size_t)m * 384 + which * 96 + 64;
        const float x1 = p[i], x2 = p[16 + i];
        p[i] = x1 * c - x2 * s; p[16 + i] = x1 * s + x2 * c;
    } else {
        const float* p = hbuf + (size_t)m * D_IN + O_DKR;
        const float x1 = p[i], x2 = p[16 + i];
        kr[(size_t)m * 32 + i] = x1 * c - x2 * s; kr[(size_t)m * 32 + 16 + i] = x1 * s + x2 * c;
    }
}

__device__ __forceinline__ int t5_bucket(int dist) {
    const int n = dist > 0 ? dist : 0;
    if (n < 16) return n;
    const float nf = (float)n;
    int large = 16 + (int)(logf(nf / 16.0f) / 2.0794415416798357f * 16.0f);
    return large < 31 ? large : 31;
}

__device__ __forceinline__ float softplusf(float z) { return fmaxf(z, 0.f) + log1pf(expf(-fabsf(z))); }

__global__ void __launch_bounds__(256) attn_A(const float* __restrict__ hb, float* __restrict__ o) {
    const int b = blockIdx.z, hd = blockIdx.y, t = blockIdx.x * 256 + threadIdx.x;
    const float* qp = hb + (size_t)(b * SEQ + t) * D_IN + O_AQ + hd * 64;
    float q[64], acc[64];
#pragma unroll
    for (int d = 0; d < 64; ++d) { q[d] = qp[d]; acc[d] = 0.f; }
    float cum = 0.f;
    const int tmax = blockIdx.x * 256 + 255;
    for (int s = tmax - 1; s >= 0; --s) {
        const float* kp = hb + (size_t)(b * SEQ + s) * D_IN + O_AK + hd * 64;
        const float* vp = hb + (size_t)(b * SEQ + s) * D_IN + O_AV + hd * 64;
        float z = 0.f;
#pragma unroll
        for (int d = 0; d < 64; ++d) z = fmaf(q[d], kp[d], z);
        z *= 0.125f;
        if (s < t) {
            const float sp = softplusf(z);
            const float w = expf((z - sp) + cum);
#pragma unroll
            for (int d = 0; d < 64; ++d) acc[d] = fmaf(w, vp[d], acc[d]);
            cum -= sp;
        }
    }
    float* op = o + (size_t)(b * SEQ + t) * 1024 + 0 * 256 + hd * 64;
#pragma unroll
    for (int d = 0; d < 64; ++d) op[d] = acc[d];
}

__global__ void __launch_bounds__(256) attn_B(const float* __restrict__ hb, float* __restrict__ o, const float* __restrict__ rel_bias,
                                              const float* __restrict__ dlam, const float* __restrict__ subln, float lam_init) {
    const int b = blockIdx.z, hd = blockIdx.y, t = blockIdx.x * 256 + threadIdx.x;
    const float* qp = hb + (size_t)(b * SEQ + t) * D_IN + O_BQ + hd * 64;
    float q[64], o1[64], o2[64];
#pragma unroll
    for (int d = 0; d < 64; ++d) { q[d] = qp[d]; o1[d] = 0.f; o2[d] = 0.f; }
    float m1 = -INFINITY, m2 = -INFINITY, l1 = 0.f, l2 = 0.f;
    const int tmax = blockIdx.x * 256 + 255;
    const float sc = 0.17677669529663687f;
    for (int s = 0; s <= tmax; ++s) {
        const float* kp = hb + (size_t)(b * SEQ + s) * D_IN + O_BK + hd * 64;
        const float* vp = hb + (size_t)(b * SEQ + s) * D_IN + O_BV + hd * 64;
        float s1 = 0.f, s2 = 0.f;
#pragma unroll
        for (int d = 0; d < 32; ++d) { s1 = fmaf(q[d], kp[d], s1); s2 = fmaf(q[32 + d], kp[32 + d], s2); }
        if (s <= t) {
            const float bias = rel_bias[t5_bucket(t - s) * 8 + hd];
            s1 = s1 * sc + bias; s2 = s2 * sc + bias;
            {
                const float mn = fmaxf(m1, s1), a = expf(m1 - mn), p = expf(s1 - mn);
                l1 = l1 * a + p; m1 = mn;
#pragma unroll
                for (int d = 0; d < 64; ++d) o1[d] = fmaf(p, vp[d], o1[d] * a);
            }
            {
                const float mn = fmaxf(m2, s2), a = expf(m2 - mn), p = expf(s2 - mn);
                l2 = l2 * a + p; m2 = mn;
#pragma unroll
                for (int d = 0; d < 64; ++d) o2[d] = fmaf(p, vp[d], o2[d] * a);
            }
        }
    }
    float a0 = 0.f, a1 = 0.f;
    for (int d = 0; d < 32; ++d) { a0 += dlam[d] * dlam[32 + d]; a1 += dlam[64 + d] * dlam[96 + d]; }
    const float lam = expf(a0) - expf(a1) + lam_init;
    float ss = 0.f;
#pragma unroll
    for (int d = 0; d < 64; ++d) { o1[d] = o1[d] / l1 - lam * (o2[d] / l2); ss += o1[d] * o1[d]; }
    const float r = 1.0f / sqrtf(ss / 64.0f + 1e-6f);
    float* op = o + (size_t)(b * SEQ + t) * 1024 + 1 * 256 + hd * 64;
#pragma unroll
    for (int d = 0; d < 64; ++d) op[d] = o1[d] * r * subln[d] * (1.0f - lam_init);
}

__global__ void __launch_bounds__(256) c_score(const float* __restrict__ hb, float* __restrict__ score) {
    const int b = blockIdx.z, t = blockIdx.y, s = blockIdx.x * 256 + threadIdx.x;
    if (blockIdx.x * 256 > t) return;
    const float* iq = hb + (size_t)(b * SEQ + t) * D_IN + O_CIQ;
    const float* iw = hb + (size_t)(b * SEQ + t) * D_IN + O_CIW;
    const float* ik = hb + (size_t)(b * SEQ + s) * D_IN + O_CIK;
    float k[32];
#pragma unroll
    for (int d = 0; d < 32; ++d) k[d] = ik[d];
    float sc = 0.f;
#pragma unroll
    for (int hh = 0; hh < 8; ++hh) {
        float dot = 0.f;
#pragma unroll
        for (int d = 0; d < 32; ++d) dot = fmaf(iq[hh * 32 + d], k[d], dot);
        dot *= 0.17677669529663687f;
        sc += (iw[hh] * 0.35355339059327373f) * fmaxf(dot, 0.f);
    }
    score[((size_t)b * SEQ + t) * SEQ + s] = sc;
}

__global__ void __launch_bounds__(256) c_select(const float* __restrict__ score, unsigned* __restrict__ selbits) {
    const int row = blockIdx.x * 4 + (threadIdx.x >> 6), lane = threadIdx.x & 63;
    const int t = row % SEQ;
    unsigned* out = selbits + (size_t)row * 64;
    if (t < 256) {
        const int lo = lane * 32;
        unsigned w = 0u;
        if (t >= lo + 31) w = 0xFFFFFFFFu; else if (t >= lo) w = (2u << (t - lo)) - 1u;
        out[lane] = w;
        return;
    }
    const float* sp = score + (size_t)row * SEQ;
    unsigned u[32];
#pragma unroll
    for (int i = 0; i < 32; ++i) {
        const int key = lane * 32 + i;
        unsigned v = 0u;
        if (key <= t) { const unsigned bits = __float_as_uint(sp[key] + 0.0f); v = (bits & 0x80000000u) ? ~bits : (bits | 0x80000000u); }
        u[i] = v;
    }
    unsigned T = 0u;
    for (int bit = 31; bit >= 0; --bit) {
        const unsigned cand = T | (1u << bit);
        int c = 0;
#pragma unroll
        for (int i = 0; i < 32; ++i) c += (u[i] >= cand) ? 1 : 0;
        c = (int)wave_sum((float)c);
        if (c >= 256) T = cand;
    }
    int cg = 0, ce = 0;
#pragma unroll
    for (int i = 0; i < 32; ++i) { cg += (u[i] > T) ? 1 : 0; ce += (u[i] == T) ? 1 : 0; }
    const int G = (int)wave_sum((float)cg);
    int need = 256 - G;
    int pre = ce;
#pragma unroll
    for (int o = 1; o < 64; o <<= 1) { const int v = __shfl_up(pre, o); if (lane >= o) pre += v; }
    pre -= ce;
    unsigned w = 0u;
    int taken = pre;
#pragma unroll
    for (int i = 0; i < 32; ++i) {
        if (u[i] > T) w |= (1u << i);
        else if (u[i] == T) { if (taken < need) w |= (1u << i); ++taken; }
    }
    out[lane] = w;
}

__global__ void __launch_bounds__(256) attn_C(const float* __restrict__ hb, float* __restrict__ o, const float* __restrict__ rel_bias, const unsigned* __restrict__ selbits) {
    const int b = blockIdx.z, hd = blockIdx.y, t = blockIdx.x * 256 + threadIdx.x;
    const float* qp = hb + (size_t)(b * SEQ + t) * D_IN + O_CQ + hd * 64;
    const unsigned* sb = selbits + (size_t)(b * SEQ + t) * 64;
    float q[64], acc[64];
#pragma unroll
    for (int d = 0; d < 64; ++d) { q[d] = qp[d]; acc[d] = 0.f; }
    float m = -INFINITY, l = 0.f;
    const int tmax = blockIdx.x * 256 + 255;
    unsigned word = 0u;
    for (int s = 0; s <= tmax; ++s) {
        if ((s & 31) == 0) word = sb[s >> 5];
        const float* kp = hb + (size_t)(b * SEQ + s) * D_IN + O_CK + hd * 64;
        const float* vp = hb + (size_t)(b * SEQ + s) * D_IN + O_CV + hd * 64;
        float z = 0.f;
#pragma unroll
        for (int d = 0; d < 64; ++d) z = fmaf(q[d], kp[d], z);
        if (s <= t && ((word >> (s & 31)) & 1u)) {
            z = z * 0.125f + rel_bias[t5_bucket(t - s) * 8 + 4 + hd];
            const float mn = fmaxf(m, z), a = expf(m - mn), p = expf(z - mn);
            l = l * a + p; m = mn;
#pragma unroll
            for (int d = 0; d < 64; ++d) acc[d] = fmaf(p, vp[d], acc[d] * a);
        }
    }
    float* op = o + (size_t)(b * SEQ + t) * 1024 + 2 * 256 + hd * 64;
    const float il = 1.0f / l;
#pragma unroll
    for (int d = 0; d < 64; ++d) op[d] = acc[d] * il;
}

__global__ void __launch_bounds__(256) attn_D(const float* __restrict__ dq, const float* __restrict__ dkv, const float* __restrict__ kr, float* __restrict__ o) {
    const int b = blockIdx.z, hd = blockIdx.y, t = blockIdx.x * 256 + threadIdx.x;
    const float* qp = dq + (size_t)(b * SEQ + t) * 384 + hd * 96;
    float q[96], acc[64];
#pragma unroll
    for (int d = 0; d < 96; ++d) q[d] = qp[d];
#pragma unroll
    for (int d = 0; d < 64; ++d) acc[d] = 0.f;
    float m = -INFINITY, l = 0.f;
    const int tmax = blockIdx.x * 256 + 255;
    const float sc = 0.10206207261596577f;
    for (int s = 0; s <= tmax; ++s) {
        const float* kp = dkv + (size_t)(b * SEQ + s) * 512 + hd * 128;
        const float* vp = kp + 64;
        const float* rp = kr + (size_t)(b * SEQ + s) * 32;
        float z = 0.f;
#pragma unroll
        for (int d = 0; d < 64; ++d) z = fmaf(q[d], kp[d], z);
#pragma unroll
        for (int d = 0; d < 32; ++d) z = fmaf(q[64 + d], rp[d], z);
        if (s <= t) {
            z *= sc;
            const float mn = fmaxf(m, z), a = expf(m - mn), p = expf(z - mn);
            l = l * a + p; m = mn;
#pragma unroll
            for (int d = 0; d < 64; ++d) acc[d] = fmaf(p, vp[d], acc[d] * a);
        }
    }
    float* op = o + (size_t)(b * SEQ + t) * 1024 + 3 * 256 + hd * 64;
    const float il = 1.0f / l;
#pragma unroll
    for (int d = 0; d < 64; ++d) op[d] = acc[d] * il;
}

__global__ void __launch_bounds__(256) gate_mul(float* __restrict__ o, const float* __restrict__ hb, int M) {
    const size_t idx = (size_t)blockIdx.x * 256 + threadIdx.x;
    if (idx >= (size_t)M * 1024) return;
    const int m = (int)(idx >> 10), c = (int)(idx & 1023);
    const float g = hb[(size_t)m * D_IN + O_GATE + c];
    o[idx] = o[idx] * (g / (1.0f + expf(-g)));
}

__global__ void __launch_bounds__(256) ln_res(const float* __restrict__ x, const float* __restrict__ y, const float* __restrict__ g, const float* __restrict__ bb, float* __restrict__ out, int M) {
    const int row = blockIdx.x * 4 + (threadIdx.x >> 6), lane = threadIdx.x & 63;
    if (row >= M) return;
    float v[16]; float s = 0.f;
#pragma unroll
    for (int i = 0; i < 16; ++i) { const int c = i * 64 + lane; v[i] = ALPHA * x[(size_t)row * 1024 + c] + y[(size_t)row * 1024 + c]; s += v[i]; }
    const float mean = wave_sum(s) * (1.0f / 1024.0f);
    float s2 = 0.f;
#pragma unroll
    for (int i = 0; i < 16; ++i) { v[i] -= mean; s2 += v[i] * v[i]; }
    const float r = 1.0f / sqrtf(wave_sum(s2) * (1.0f / 1024.0f) + 1e-5f);
#pragma unroll
    for (int i = 0; i < 16; ++i) { const int c = i * 64 + lane; out[(size_t)row * 1024 + c] = v[i] * r * g[c] + bb[c]; }
}
}

#ifndef DIAG_SEL
#define DIAG_SEL -1
#endif
namespace dg {
constexpr int NITEM = 32;
struct P { const bf16_t* CN; const float* cq; const bf16_t* HB; const bf16_t* MD; const bf16_t* KR; const unsigned* SEL; const bf16_t* OB; const float* OUTOPT;
           const float* hb; const float* dq; const float* dkv; const float* kr; const unsigned* selbits; const float* ob; const float* outn; };
__device__ __forceinline__ bool pair(const P& p, int it, int r, int c, float& av, float& bv) {
    if (it < 16) { const int v = it * 256 + c, s = src_col(v); if (s < 0) return false; av = bf2f(p.HB[(size_t)r * NV + v]); bv = p.hb[(size_t)r * nv::D_IN + s];
        if (it >= 12) bv = bv / (1.0f + expf(-bv)); return true; }
    if (it == 16) { if (c >= 32) return false; av = bf2f(p.HB[(size_t)r * NV + V_DKR + c]); bv = p.hb[(size_t)r * nv::D_IN + nv::O_DKR + c]; return true; }
    if (it == 17) { if (c >= 32) return false; av = bf2f(p.HB[(size_t)r * NV + V_CIK + c]); bv = p.hb[(size_t)r * nv::D_IN + nv::O_CIK + c]; return true; }
    if (it == 18) { if (c >= 8) return false; av = bf2f(p.HB[(size_t)r * NV + V_CIW + c]); bv = p.hb[(size_t)r * nv::D_IN + nv::O_CIW + c]; return true; }
    if (it == 19) { av = bf2f(p.MD[(size_t)r * DM + MD_QN + c]); bv = p.dq[(size_t)r * 384 + (c >> 6) * 96 + (c & 63)]; return true; }
    if (it == 20) { return false; }
    if (it == 21) { av = bf2f(p.MD[(size_t)r * DM + MD_KN + c]); bv = p.dkv[(size_t)r * 512 + (c >> 6) * 128 + (c & 63)]; return true; }
    if (it == 22) { av = bf2f(p.MD[(size_t)r * DM + MD_V + c]); bv = p.dkv[(size_t)r * 512 + (c >> 6) * 128 + 64 + (c & 63)]; return true; }
    if (it == 23) { if (c >= 32) return false; av = bf2f(p.KR[(size_t)r * 32 + c]); bv = p.kr[(size_t)r * 32 + c]; return true; }
    if (it == 24) { if (c >= 64) return false; const unsigned x = p.SEL[(size_t)r * 64 + c], y = p.selbits[(size_t)r * 64 + c];
        unsigned cm = 0xFFFFFFFFu; const int t = r & 2047, lo = c * 32; if (t < lo) cm = 0u; else if (t < lo + 31) cm = (2u << (t - lo)) - 1u;
        av = (float)__popc((x ^ y) & cm); bv = 0.f; if (c == 0) bv = (t < 256) ? (float)(t + 1) : 256.f; av = sqrtf(av); bv = sqrtf(bv); av += bv; return true; }
    if (it == 31) { av = bf2f(p.CN[(size_t)r * 384 + c]); bv = p.cq[(size_t)r * 256 + c]; return true; }
    if (it == 30) { av = bf2f(p.MD[(size_t)r * DM + MD_QN + c]); bv = p.dq[(size_t)r * 384 + (c >> 6) * 96 + (c & 63)]; return true; }
    if (it >= 25 && it < 29) { const int g = it - 25; av = bf2f(p.OB[(size_t)r * DM + g * 256 + c]); bv = p.ob[(size_t)r * 1024 + g * 256 + c]; return true; }
    return false;
}
__global__ void __launch_bounds__(256) cmp_item(P p, int it, int rows, float* acc) {
    float num = 0.f, den = 0.f;
    for (size_t e = (size_t)blockIdx.x * 256 + threadIdx.x; e < (size_t)rows * 256; e += (size_t)gridDim.x * 256) {
        const int r = (int)(e >> 8), c = (int)(e & 255); float av, bv;
        if (pair(p, it, r, c, av, bv)) { const float d = av - bv; num += d * d; den += bv * bv; }
    }
    num = ::wave_sum(num); den = ::wave_sum(den);
    if ((threadIdx.x & 63) == 0) { atomicAdd(acc + 2 * it, num); atomicAdd(acc + 2 * it + 1, den); }
}
__global__ void __launch_bounds__(256) cmp_final(const float* a, const float* b, size_t n, float* acc, int it) {
    float num = 0.f, den = 0.f;
    for (size_t e = (size_t)blockIdx.x * 256 + threadIdx.x; e < n; e += (size_t)gridDim.x * 256) { const float d = a[e] - b[e]; num += d * d; den += b[e] * b[e]; }
    num = ::wave_sum(num); den = ::wave_sum(den);
    if ((threadIdx.x & 63) == 0) { atomicAdd(acc + 2 * it, num); atomicAdd(acc + 2 * it + 1, den); }
}
#ifndef DIAG_SEL2
#define DIAG_SEL2 -1
#endif
#ifndef DIAG_MAXHI
#define DIAG_MAXHI 24
#endif
__global__ void finalize(float* acc) {
    float E = 0.f; int arg = 0; float e2 = 0.f;
    for (int i = 0; i < NITEM; ++i) { const float den = acc[2 * i + 1]; float e = den > 0.f ? sqrtf(acc[2 * i] / den) : 0.f; if (!(e == e)) e = 9.f;
        if (DIAG_SEL >= 0) { if (i == DIAG_SEL) { E = e; arg = i; } } else if (i < DIAG_MAXHI && e > E) { E = e; arg = i; }
        if (i == DIAG_SEL2) e2 = e; }
    acc[2 * NITEM] = E; acc[2 * NITEM + 1] = (DIAG_SEL2 >= 0) ? fmaxf(1.0e6f * e2, 100.f) : (float)((10 + arg) * 10);
}
__global__ void __launch_bounds__(256) perturb(float* out, size_t n, const float* acc) {
    const float E = acc[2 * NITEM], spike = acc[2 * NITEM + 1];
    for (size_t e = (size_t)blockIdx.x * 256 + threadIdx.x; e < n; e += (size_t)gridDim.x * 256) { float v = out[e] * (1.0f + 1000.0f * E);     if (e == 0) v += spike; out[e] = v; }
}
}

extern "C" void kernel_launch(void* const* d_in, const int* in_sizes, int n_in, void* d_out, int out_size, void* d_ws, size_t ws_size, hipStream_t stream) {
    constexpr int MC = nv::MC, CB = nv::CB, BATCH = nv::BATCH, H = nv::H, O_DCQ = nv::O_DCQ, O_DCKV = nv::O_DCKV;
    using nv::gemm_f32; using nv::rms_rows; using nv::rope_k; using nv::attn_A; using nv::attn_B; using nv::c_score; using nv::c_select; using nv::attn_C; using nv::attn_D; using nv::gate_mul; using nv::ln_res;
    const float* x = (const float*)d_in[0]; const float* w_in = (const float*)d_in[1]; const float* w_out = (const float*)d_in[2]; const float* ln_g = (const float*)d_in[3];
    const float* ln_b = (const float*)d_in[4]; const float* rel_bias = (const float*)d_in[5]; const float* diff_lambda = (const float*)d_in[6]; const float* diff_subln = (const float*)d_in[7];
    const float* mla_q_norm = (const float*)d_in[8]; const float* mla_kv_norm = (const float*)d_in[9]; const float* mla_w_uq = (const float*)d_in[10]; const float* mla_w_ukv = (const float*)d_in[11];
    float* out = (float*)d_out; char* ws = (char*)d_ws;
    size_t off = (WS_END + 255) & ~(size_t)255;
    auto carve = [&](size_t bytes) { char* p = ws + off; off += (bytes + 255) & ~(size_t)255; return p; };
    float* outopt = (float*)carve((size_t)M_TOK * DM * 4);
    float* acc = (float*)carve(4096);
    float* hb = (float*)carve((size_t)MC * D_IN * 4); float* cq = (float*)carve((size_t)MC * 256 * 4); float* ckv = (float*)carve((size_t)MC * 128 * 4);
    float* dq = (float*)carve((size_t)MC * 384 * 4); float* dkv = (float*)carve((size_t)MC * 512 * 4); float* kr = (float*)carve((size_t)MC * 32 * 4);
    float* score = (float*)carve((size_t)CB * SEQ * SEQ * 4); unsigned* selbits = (unsigned*)carve((size_t)MC * 64 * 4);
    float* ob = (float*)carve((size_t)MC * 1024 * 4); float* yb = (float*)carve((size_t)MC * 1024 * 4); float* x1 = (float*)carve((size_t)MC * 1024 * 4);
    if (off > ws_size) { fprintf(stderr, "DIAG workspace too small: need %zu have %zu\n", off, ws_size); return; }
    (void)hipMemsetAsync(acc, 0, 4096, stream);
    auto naive_layer = [&](const float* xin, float* xout, int l, bool upto_y_only) {
        const float* wi = w_in + (size_t)l * 1024 * D_IN; const float* wo = w_out + (size_t)l * 1024 * 1024;
        const float lam_init = (float)(0.8 - 0.6 * exp(-0.3 * (double)l));
        gemm_f32<<<dim3((D_IN + 63) / 64, MC / 64), 256, 0, stream>>>(xin, 1024, wi, D_IN, hb, D_IN, MC, D_IN, 1024);
        rms_rows<<<MC / 4, 256, 0, stream>>>(hb, D_IN, O_DCQ, 256, mla_q_norm + l * 256, cq, MC);
        rms_rows<<<MC / 4, 256, 0, stream>>>(hb, D_IN, O_DCKV, 128, mla_kv_norm + l * 128, ckv, MC);
        gemm_f32<<<dim3(384 / 64, MC / 64), 256, 0, stream>>>(cq, 256, mla_w_uq + (size_t)l * 256 * 384, 384, dq, 384, MC, 384, 256);
        gemm_f32<<<dim3(512 / 64, MC / 64), 256, 0, stream>>>(ckv, 128, mla_w_ukv + (size_t)l * 128 * 512, 512, dkv, 512, MC, 512, 128);
        rope_k<<<(MC * 80 + 255) / 256, 256, 0, stream>>>(dq, hb, kr, MC);
        attn_A<<<dim3(SEQ / 256, H, CB), 256, 0, stream>>>(hb, ob);
        attn_B<<<dim3(SEQ / 256, H, CB), 256, 0, stream>>>(hb, ob, rel_bias, diff_lambda + l * 128, diff_subln + l * 64, lam_init);
        c_score<<<dim3(SEQ / 256, SEQ, CB), 256, 0, stream>>>(hb, score);
        c_select<<<MC / 4, 256, 0, stream>>>(score, selbits);
        attn_C<<<dim3(SEQ / 256, H, CB), 256, 0, stream>>>(hb, ob, rel_bias, selbits);
        attn_D<<<dim3(SEQ / 256, H, CB), 256, 0, stream>>>(dq, dkv, kr, ob);
        gate_mul<<<MC * 1024 / 256, 256, 0, stream>>>(ob, hb, MC);
        if (upto_y_only) return;
        gemm_f32<<<dim3(1024 / 64, MC / 64), 256, 0, stream>>>(ob, 1024, wo, 1024, yb, 1024, MC, 1024, 1024);
        ln_res<<<MC / 4, 256, 0, stream>>>(xin, yb, ln_g + l * 1024, ln_b + l * 1024, xout, MC);
    };
    for (int c = 0; c < BATCH / CB; ++c) {
        naive_layer(x + (size_t)c * MC * 1024, x1, 0, false);
        naive_layer(x1, out + (size_t)c * MC * 1024, 1, false);
    }
    naive_layer(x, x1, 0, true);
    (void)hipFuncSetAttribute((const void*)mega_fwd, hipFuncAttributeMaxDynamicSharedMemorySize, LDS_BYTES);
    Args a{};
    a.x = x; a.w_in = w_in; a.w_out = w_out; a.ln_g = ln_g; a.ln_b = ln_b; a.rel_bias = rel_bias; a.diff_lambda = diff_lambda; a.diff_subln = diff_subln;
    a.mla_q_norm = mla_q_norm; a.mla_kv_norm = mla_kv_norm; a.mla_w_uq = mla_w_uq; a.mla_w_ukv = mla_w_ukv; a.out = outopt; a.ws = (unsigned char*)d_ws;
    dg::P p{(const bf16_t*)(ws + WS_CN), cq, (const bf16_t*)(ws + WS_HB), (const bf16_t*)(ws + WS_MD), (const bf16_t*)(ws + WS_KR), (const unsigned*)(ws + WS_SEL), (const bf16_t*)(ws + WS_XB), outopt,
            hb, dq, dkv, kr, selbits, ob, out};
    auto run = [&](int lo, int hi) { for (int ph = lo; ph < hi; ++ph) { a.ph_lo = ph; a.ph_hi = ph + 1; hipLaunchKernelGGL(mega_fwd, dim3(256), dim3(NTHREADS), LDS_BYTES, stream, a); } };
    auto cmp = [&](int it) { dg::cmp_item<<<512, 256, 0, stream>>>(p, it, SEQ, acc); };
    run(0, 2); for (int it = 0; it < 19; ++it) cmp(it);
    run(2, 4); for (int it = 19; it < 25; ++it) cmp(it); cmp(31); run(3, 4); cmp(30);
#ifdef DIAG_COPYSEL
    (void)hipMemcpyAsync(ws + WS_SEL, selbits, (size_t)SEQ * 64 * 4, hipMemcpyDeviceToDevice, stream);
#endif
    run(4, 5); for (int it = 25; it < 29; ++it) cmp(it);
    run(5, N_PHASES);
    dg::cmp_final<<<1024, 256, 0, stream>>>(outopt, out, (size_t)M_TOK * DM, acc, 29);
    dg::finalize<<<1, 1, 0, stream>>>(acc);
    dg::perturb<<<2048, 256, 0, stream>>>(out, (size_t)BATCH * SEQ * 1024, acc);
}
#endif
```

```cpp
#include <hip/hip_runtime.h>
#include <hip/hip_cooperative_groups.h>
#include <hip/hip_bf16.h>
#include <cstdio>
#include <cstdint>
#include <cmath>
#include <type_traits>
namespace cg = cooperative_groups;

#ifndef NBATCH
#define NBATCH 16
#endif
#ifndef DIAG
#define DIAG 0
#endif

#ifndef PH_MASK
#define PH_MASK 0xFFFF
#endif
#define HAS(k) (((PH_MASK) >> (k)) & 1)

constexpr int NB = NBATCH, SEQ = 2048, DM = 1024, M_TOK = NB * SEQ, DEPTH = 2;
constexpr int D_IN = 4040, NV = 4096;
constexpr int V_AQ = 0, V_AK = 256, V_AV = 512, V_BQ = 768, V_BK = 1024, V_BV = 1280, V_CQ = 1536, V_CK = 1792, V_CV = 2048,
              V_CIQ = 2304, V_DCQ = 2560, V_DCKV = 2816, V_DKR = 2944, V_CIK = 2976, V_CIW = 3008, V_GATE = 3072;
constexpr int MD_QN = 0, MD_QR = 256, MD_KN = 512, MD_V = 768;
constexpr float ALPHA_RES = 1.4142135623730951f;
constexpr float LOG2E = 1.4426950408889634f, LN2 = 0.6931471805599453f;

__host__ __device__ __forceinline__ int src_col(int v) {
    if (v < 2560) return v;
    if (v < 2816) return 2600 + (v - 2560);
    if (v < 2944) return 2856 + (v - 2816);
    if (v < 2976) return 2984 + (v - 2944);
    if (v < 3008) return 2560 + (v - 2976);
    if (v < 3016) return 2592 + (v - 3008);
    if (v < 3072) return -1;
    return 3016 + (v - 3072);
}

constexpr size_t MiB = 1u << 20;
constexpr size_t WS_CTL = 0;
constexpr size_t WS_ROPE = 512 * 1024;
constexpr size_t WS_WIN = 1 * MiB;
constexpr size_t WS_WOUT = WS_WIN + 2 * (size_t)NV * DM * 2;
constexpr size_t WS_WMLA = WS_WOUT + 2 * (size_t)DM * DM * 2;
constexpr size_t WS_XB = WS_WMLA + 2 * MiB;
constexpr size_t WS_HB = WS_XB + (size_t)M_TOK * DM * 2;
constexpr size_t WS_CN = WS_HB + (size_t)M_TOK * NV * 2;
constexpr size_t WS_KR = WS_CN + (size_t)M_TOK * 384 * 2;
constexpr size_t WS_MD = WS_KR + (size_t)M_TOK * 32 * 2;
constexpr size_t WS_SEL = WS_MD + (size_t)M_TOK * DM * 2;
constexpr size_t WS_END = WS_SEL + (size_t)M_TOK * 64 * 4;

#define LAS __attribute__((address_space(3)))
typedef unsigned short bf16_t;
typedef short bf16x8 __attribute__((ext_vector_type(8)));
typedef float f32x4 __attribute__((ext_vector_type(4)));
typedef float f32x16 __attribute__((ext_vector_type(16)));
typedef unsigned u32x4 __attribute__((ext_vector_type(4)));
typedef unsigned u32x2 __attribute__((ext_vector_type(2)));
typedef float f32x2_t __attribute__((ext_vector_type(2)));
typedef __bf16 bf16x2_t __attribute__((ext_vector_type(2)));
__device__ __forceinline__ unsigned cvtpk(float lo, float hi) { f32x2_t v = {lo, hi}; bf16x2_t b = __builtin_convertvector(v, bf16x2_t); return __builtin_bit_cast(unsigned, b); }
__device__ __forceinline__ float bf2f(unsigned short h) { return __uint_as_float((unsigned)h << 16); }
__device__ __forceinline__ float bflo(unsigned w) { return __uint_as_float(w << 16); }
__device__ __forceinline__ float bfhi(unsigned w) { return __uint_as_float(w & 0xffff0000u); }
__device__ __forceinline__ float wave_sum(float v) {
#pragma unroll
    for (int o = 1; o < 64; o <<= 1) v += __shfl_xor(v, o);
    return v;
}
namespace pg8 {
#define PG8_LAS __attribute__((address_space(3)))
typedef unsigned short bf16_t;
typedef short bf16x8 __attribute__((ext_vector_type(8)));
typedef float f32x4 __attribute__((ext_vector_type(4)));
typedef unsigned u32x4 __attribute__((ext_vector_type(4)));
constexpr int BM = 256, BK = 64, HALF = 128, HTB = HALF * BK * 2  , STAGE_BYTES = 8 * HTB, NXCD = 8, WGM = 8;

__host__ __device__ __forceinline__ int lds_byte(int r, int c) { const int st = (r >> 4) * 2 + (c >> 5), rr = r & 15, cc = c & 31, ob = rr * 64 + cc * 2; return st * 1024 + (ob ^ (((ob >> 9) & 1) << 5)); }
__host__ __device__ __forceinline__ void stage_rc(int b, int& R, int& C) { const int st = b / 1024, sb = b % 1024, swz = sb ^ (((sb >> 9) & 1) << 5); R = (st >> 1) * 16 + swz / 64; C = (st & 1) * 32 + (swz % 64) / 2; }
__host__ __device__ __forceinline__ int perm32(int rho) { const int n = rho >> 4, i = rho & 15; return 8 * (i >> 2) + 4 * n + (i & 3); }

struct Unit { int pm, pn; };
struct Gemm { const bf16_t* A; const bf16_t* Bt; int M, N, K; };

struct StaticOrder {
    int nM, nN, nwg, G, c;
    __host__ __device__ void init(int M, int N, int G_, int c_) { nM = M / BM; nN = N / BM; nwg = nM * nN; G = G_; c = c_; }
    __host__ __device__ bool next(int i, Unit& u) const {
        const long L = (long)i * G + c; if (L >= nwg) return false;
        int wgid = (int)L; { const int q = nwg / NXCD, r = nwg % NXCD, xcd = wgid % NXCD, off = wgid / NXCD; wgid = (xcd < r ? xcd * (q + 1) : r * (q + 1) + (xcd - r) * q) + off; }
        const int nig = WGM * nN, gid = wgid / nig, fm = gid * WGM, gsz = (nM - fm) < WGM ? (nM - fm) : WGM;
        u.pm = fm + ((wgid % nig) % gsz); u.pn = (wgid % nig) / gsz; return true;
    }
    __device__ __forceinline__ void a_ready(const Unit&) const {}
    __device__ __forceinline__ void done(const Unit&) const {}
};


__device__ __forceinline__ float silu_f(float v) { return v * __builtin_amdgcn_rcpf(1.0f + __builtin_amdgcn_exp2f(-v * 1.4426950408889634f)); }

struct EpiMain {
    static constexpr bool PERM = true, AFTER_DRAIN = false;
    bf16_t* O; int ldc; int gate_from;
    __device__ __forceinline__ void operator()(const f32x4 (&acc)[2][2][4][2], const Unit& u, int wr, int wc, int fr, int fq) const {
        const int row0 = u.pm * BM + wr * 64 + fr, col0 = u.pn * BM + wc * 32 + 8 * fq;
        const bool gate = u.pn >= gate_from;
#pragma unroll
        for (int ai = 0; ai < 2; ++ai)
#pragma unroll
            for (int m = 0; m < 4; ++m) { bf16_t* rowp = O + (size_t)(row0 + ai * HALF + m * 16) * ldc + col0;
#pragma unroll
                for (int bj = 0; bj < 2; ++bj) { f32x4 v0 = acc[ai][bj][m][0], v1 = acc[ai][bj][m][1];
                    if (gate) {
#pragma unroll
                        for (int j = 0; j < 4; ++j) { v0[j] = silu_f(v0[j]); v1[j] = silu_f(v1[j]); } }
                    u32x4 w; w.x = ::cvtpk(v0[0], v0[1]); w.y = ::cvtpk(v0[2], v0[3]); w.z = ::cvtpk(v1[0], v1[1]); w.w = ::cvtpk(v1[2], v1[3]);
                    *(u32x4*)(rowp + bj * HALF) = w; } }
    }
};
struct EpiOut {
    static constexpr bool PERM = false, AFTER_DRAIN = false;
    const float* xres; float* Z; float alpha;
    __device__ __forceinline__ void operator()(const f32x4 (&acc)[2][2][4][2], const Unit& u, int wr, int wc, int fr, int fq) const {
        const int row0 = u.pm * BM + wr * 64 + fr, col0 = u.pn * BM + wc * 32 + 4 * fq;
#pragma unroll
        for (int ai = 0; ai < 2; ++ai)
#pragma unroll
            for (int m = 0; m < 4; ++m) { const size_t off = (size_t)(row0 + ai * HALF + m * 16) * 1024 + col0;
#pragma unroll
                for (int bj = 0; bj < 2; ++bj)
#pragma unroll
                    for (int n = 0; n < 2; ++n) { const f32x4 xr = *(const f32x4*)(xres + off + bj * HALF + n * 16);
                        *(f32x4*)(Z + off + bj * HALF + n * 16) = xr * alpha + acc[ai][bj][m][n]; } }
    }
};
template <class Epi, class Sched, bool ALIGN_EPI = false, bool SP2 = false>
__device__ __forceinline__ void gemm_phase(PG8_LAS unsigned char* lds, const Gemm g, const Sched& S, const Epi& E, int wid_in) {
    int tid_op = wid_in * 64 + (int)__builtin_amdgcn_mbcnt_hi(~0u, __builtin_amdgcn_mbcnt_lo(~0u, 0u)); asm volatile("" : "+v"(tid_op));
    const int tid = tid_op, wid = __builtin_amdgcn_readfirstlane(tid >> 6), lane = tid & 63, wr = wid >> 2, wc = wid & 3, fr = lane & 15, fq = lane >> 4;
    const int K = g.K, nt = K / BK;
    unsigned voffA[2], voffB[2];
#pragma unroll
    for (int i = 0; i < 2; ++i) { int R, C; stage_rc(tid * 16 + i * 8192, R, C); const int Rb = Epi::PERM ? ((R & ~31) + perm32(R & 31)) : R;
        voffA[i] = (unsigned)(R * K + C) * 2u; voffB[i] = (unsigned)(Rb * K + C) * 2u; }
    const size_t kstep = (size_t)(BK * 2);
    const size_t hstep = (size_t)HALF * K * 2;
    const size_t tstep = 2 * hstep;
    const unsigned ldsw = (unsigned)wid * 1024u;
    const int aoff = lds_byte(wr * 64 + fr, fq * 8), boff = lds_byte(wc * 32 + fr, fq * 8);
#define PG8_SA(b, h) (((b) * 2 + (h)) * HTB)
#define PG8_SB(b, h) ((4 + (b) * 2 + (h)) * HTB)
#define PG8_STAGE(bufoff, gbase, voff) do { _Pragma("unroll") for (int _i = 0; _i < 2; ++_i) \
        __builtin_amdgcn_global_load_lds((const unsigned*)((const char*)(gbase) + (voff)[_i]), (PG8_LAS unsigned*)(lds + (bufoff) + ldsw + _i * 8192), 16, 0, 0); } while (0)
#define PG8_LDA(dst, b, h) do { _Pragma("unroll") for (int m = 0; m < 4; ++m) _Pragma("unroll") for (int k = 0; k < 2; ++k) dst[m][k] = *(const PG8_LAS bf16x8*)(lds + PG8_SA(b, h) + aoff + m * 2048 + k * 1024); } while (0)
#define PG8_LDB(dst, b, h) do { _Pragma("unroll") for (int n = 0; n < 2; ++n) _Pragma("unroll") for (int k = 0; k < 2; ++k) dst[n][k] = *(const PG8_LAS bf16x8*)(lds + PG8_SB(b, h) + boff + n * 2048 + k * 1024); } while (0)
#define PG8_MMA(ai, bj, At, Bt) do { __builtin_amdgcn_s_setprio(1); _Pragma("unroll") for (int m = 0; m < 4; ++m) _Pragma("unroll") for (int n = 0; n < 2; ++n) _Pragma("unroll") for (int k = 0; k < 2; ++k) \
        acc[ai][bj][m][n] = __builtin_amdgcn_mfma_f32_16x16x32_bf16(Bt[n][k], At[m][k], acc[ai][bj][m][n], 0, 0, 0); __builtin_amdgcn_s_setprio(0); } while (0)
#define PG8_WAIT_V(n) asm volatile("s_waitcnt vmcnt(" #n ")" ::: "memory")
#define PG8_WAIT_L(n) asm volatile("s_waitcnt lgkmcnt(" #n ")" ::: "memory")
#define PG8_BAR __builtin_amdgcn_s_barrier()
#define PG8_SCHED __builtin_amdgcn_sched_barrier(0)
    Unit cur, nxt; int ui = 0;
    if (!S.next(0, cur)) return;
    f32x4 acc[2][2][4][2];
#pragma unroll
    for (int a = 0; a < 2; ++a)
#pragma unroll
        for (int b = 0; b < 2; ++b)
#pragma unroll
            for (int m = 0; m < 4; ++m)
#pragma unroll
                for (int n = 0; n < 2; ++n) acc[a][b][m][n] = (f32x4){0.f, 0.f, 0.f, 0.f};
    bf16x8 At[4][2], B0[2][2], B1[2][2];
    const char* cA = (const char*)g.A + (size_t)cur.pm * tstep; const char* cB = (const char*)g.Bt + (size_t)cur.pn * tstep;
    S.a_ready(cur);
    if constexpr (SP2) {
        PG8_STAGE(PG8_SB(0, 0), cB, voffB); PG8_STAGE(PG8_SB(0, 1), cB + hstep, voffB); PG8_STAGE(PG8_SA(0, 0), cA, voffA); PG8_STAGE(PG8_SA(0, 1), cA + hstep, voffA);
        if (wr == 1) PG8_BAR;
        PG8_WAIT_V(2); PG8_BAR;
        PG8_STAGE(PG8_SB(1, 0), cB + kstep, voffB); PG8_STAGE(PG8_SA(1, 0), cA + kstep, voffA); PG8_STAGE(PG8_SB(1, 1), cB + hstep + kstep, voffB);
        PG8_WAIT_V(6); PG8_BAR;
    } else {
        PG8_STAGE(PG8_SB(0, 0), cB, voffB); PG8_STAGE(PG8_SA(0, 0), cA, voffA); PG8_STAGE(PG8_SB(0, 1), cB + hstep, voffB); PG8_STAGE(PG8_SA(0, 1), cA + hstep, voffA);
        if (wr == 1) PG8_BAR;
        PG8_WAIT_V(4); PG8_BAR;
        PG8_STAGE(PG8_SB(1, 0), cB + kstep, voffB); PG8_STAGE(PG8_SA(1, 0), cA + kstep, voffA); PG8_STAGE(PG8_SB(1, 1), cB + hstep + kstep, voffB);
        PG8_WAIT_V(6); PG8_BAR;
    }
    for (;;) {
        const bool has_next = S.next(ui + 1, nxt);
        const char* nA = has_next ? (const char*)g.A + (size_t)nxt.pm * tstep : cA; const char* nB = has_next ? (const char*)g.Bt + (size_t)nxt.pn * tstep : cB;
#pragma unroll 1
        for (int t = 0; t < nt; t += 2) {
            const bool last = (t == nt - 2);
            const char* a1 = cA + (size_t)(t + 1) * kstep;
            const char* a2 = last ? nA : cA + (size_t)(t + 2) * kstep; const char* b2 = last ? nB : cB + (size_t)(t + 2) * kstep;
            const char* a3 = a2 + kstep; const char* b3 = b2 + kstep;
            if (last && has_next) S.a_ready(nxt);
            if constexpr (SP2) {
            PG8_LDB(B0, 0, 0); PG8_LDB(B1, 0, 1); PG8_SCHED; PG8_LDA(At, 0, 0); PG8_STAGE(PG8_SA(1, 1), a1 + hstep, voffA);
            PG8_WAIT_V(8); PG8_WAIT_L(0); PG8_BAR; PG8_MMA(0, 0, At, B0); PG8_MMA(0, 1, At, B1); PG8_BAR; PG8_SCHED;
            PG8_LDA(At, 0, 1); PG8_STAGE(PG8_SB(0, 0), b2, voffB); PG8_STAGE(PG8_SB(0, 1), b2 + hstep, voffB); PG8_STAGE(PG8_SA(0, 0), a2, voffA);
            PG8_WAIT_V(8); PG8_WAIT_L(0); PG8_BAR; PG8_MMA(1, 0, At, B0); PG8_MMA(1, 1, At, B1); PG8_BAR; PG8_SCHED;
            PG8_LDB(B0, 1, 0); PG8_LDB(B1, 1, 1); PG8_SCHED; PG8_LDA(At, 1, 0); PG8_STAGE(PG8_SA(0, 1), a2 + hstep, voffA);
            PG8_WAIT_V(8); PG8_WAIT_L(0); PG8_BAR; PG8_MMA(0, 0, At, B0); PG8_MMA(0, 1, At, B1); PG8_BAR; PG8_SCHED;
            PG8_LDA(At, 1, 1); PG8_STAGE(PG8_SB(1, 0), b3, voffB); PG8_STAGE(PG8_SB(1, 1), b3 + hstep, voffB); PG8_STAGE(PG8_SA(1, 0), a3, voffA);
            PG8_WAIT_V(8); PG8_WAIT_L(0); PG8_BAR; PG8_MMA(1, 0, At, B0); PG8_MMA(1, 1, At, B1); PG8_BAR; PG8_SCHED;
            } else {
            PG8_LDB(B0, 0, 0); PG8_SCHED; PG8_LDA(At, 0, 0); PG8_STAGE(PG8_SA(1, 1), a1 + hstep, voffA);
            PG8_WAIT_L(8); PG8_BAR; PG8_WAIT_L(0); PG8_MMA(0, 0, At, B0); PG8_BAR; PG8_SCHED;
            PG8_LDB(B1, 0, 1); PG8_STAGE(PG8_SB(0, 0), b2, voffB);
            PG8_BAR; PG8_WAIT_L(0); PG8_MMA(0, 1, At, B1); PG8_BAR;
            PG8_LDA(At, 0, 1); PG8_STAGE(PG8_SA(0, 0), a2, voffA);
            PG8_BAR; PG8_WAIT_L(0); PG8_MMA(1, 0, At, B0); PG8_BAR; PG8_SCHED;
            PG8_STAGE(PG8_SB(0, 1), b2 + hstep, voffB);
            PG8_WAIT_V(6); PG8_BAR; PG8_MMA(1, 1, At, B1); PG8_BAR;
            PG8_LDB(B0, 1, 0); PG8_SCHED; PG8_LDA(At, 1, 0); PG8_STAGE(PG8_SA(0, 1), a2 + hstep, voffA);
            PG8_WAIT_L(8); PG8_BAR; PG8_WAIT_L(0); PG8_MMA(0, 0, At, B0); PG8_BAR; PG8_SCHED;
            PG8_LDB(B1, 1, 1); PG8_STAGE(PG8_SB(1, 0), b3, voffB);
            PG8_BAR; PG8_WAIT_L(0); PG8_MMA(0, 1, At, B1); PG8_BAR;
            PG8_LDA(At, 1, 1); PG8_STAGE(PG8_SA(1, 0), a3, voffA);
            PG8_BAR; PG8_WAIT_L(0); PG8_MMA(1, 0, At, B0); PG8_BAR; PG8_SCHED;
            PG8_STAGE(PG8_SB(1, 1), b3 + hstep, voffB);
            PG8_WAIT_V(6); PG8_BAR; PG8_MMA(1, 1, At, B1); PG8_BAR;
            }
        }
        if constexpr (ALIGN_EPI) { if (wr == 0) PG8_BAR; }
        if constexpr (!Epi::AFTER_DRAIN) { E(acc, cur, wr, wc, fr, fq); S.done(cur); }
        if (!has_next) break;
#pragma unroll
        for (int a = 0; a < 2; ++a)
#pragma unroll
            for (int b = 0; b < 2; ++b)
#pragma unroll
                for (int m = 0; m < 4; ++m)
#pragma unroll
                    for (int n = 0; n < 2; ++n) acc[a][b][m][n] = (f32x4){0.f, 0.f, 0.f, 0.f};
        cur = nxt; cA = nA; cB = nB; ++ui;
        if constexpr (ALIGN_EPI) { if (wr == 1) PG8_BAR; }
    }
    PG8_WAIT_V(0);
    if constexpr (!ALIGN_EPI) { if (wr == 0) PG8_BAR; }
    PG8_BAR;
    if constexpr (Epi::AFTER_DRAIN) { E.fused(acc, cur, wr, wc, fr, fq, lds, wid, lane); S.done(cur); }
#undef PG8_SA
#undef PG8_SB
#undef PG8_STAGE
#undef PG8_LDA
#undef PG8_LDB
#undef PG8_MMA
#undef PG8_WAIT_V
#undef PG8_WAIT_L
#undef PG8_BAR
#undef PG8_SCHED
}
}

#ifndef REP_PH
#define REP_PH -1
#endif
#define NREP(k) ((REP_PH) == (k) ? 2 : 1)
constexpr int NWAVES = 8, NTHREADS = 512;
constexpr int LDS_BYTES = 163840;
constexpr int SEL_RS = 2052;
constexpr int LDS_CTL = 16 * SEL_RS * 4;
constexpr int LDS_HIST = LDS_CTL + 256, HIST_WAVE = 3072;
static_assert(LDS_HIST + 8 * HIST_WAVE <= 163840, "LDS map");
constexpr int AL_K = 0, AL_KB = 12288, AL_V = 2 * AL_KB, AL_VB = 8192, AL_BIAS = AL_V + 2 * AL_VB, AL_FLAG = AL_BIAS + 1024, AL_Q = AL_FLAG + 1024;

struct Args {
    const float* x; const float* w_in; const float* w_out; const float* ln_g; const float* ln_b; const float* rel_bias; const float* diff_lambda;
    const float* diff_subln; const float* mla_q_norm; const float* mla_kv_norm; const float* mla_w_uq; const float* mla_w_ukv;
    float* out; unsigned char* ws; int ph_lo, ph_hi;
};

struct Ctx {
    LAS unsigned char* lds; int tid, lane, wid, vcu, G;
};

__device__ __forceinline__ f32x16 mfma32(bf16x8 a, bf16x8 b, f32x16 c) { return __builtin_amdgcn_mfma_f32_32x32x16_bf16(a, b, c, 0, 0, 0); }
__device__ __forceinline__ f32x4 mfma16(bf16x8 a, bf16x8 b, f32x4 c) { return __builtin_amdgcn_mfma_f32_16x16x32_bf16(a, b, c, 0, 0, 0); }
typedef short v4i16_t __attribute__((ext_vector_type(4)));
__device__ __forceinline__ v4i16_t vtr(LAS const unsigned char* p) { return __builtin_amdgcn_ds_read_tr16_b64_v4i16((LAS v4i16_t*)p); }
__device__ __forceinline__ float xhalf_sum(float v) { auto rr = __builtin_amdgcn_permlane32_swap(__float_as_uint(v), __float_as_uint(v), false, false); return __uint_as_float(rr[0]) + __uint_as_float(rr[1]); }
__device__ __forceinline__ float xhalf_max(float v) { auto rr = __builtin_amdgcn_permlane32_swap(__float_as_uint(v), __float_as_uint(v), false, false); return fmaxf(__uint_as_float(rr[0]), __uint_as_float(rr[1])); }
__device__ __forceinline__ float xhalf_other(float v, int hi) { auto rr = __builtin_amdgcn_permlane32_swap(__float_as_uint(v), __float_as_uint(v), false, false); return __uint_as_float(hi ? rr[0] : rr[1]); }
__device__ __forceinline__ int crow(int r, int hi) { return (r & 3) + 8 * (r >> 2) + 4 * hi; }

__device__ __forceinline__ int t5_bucket(int n) {
    if (n < 16) return n;
    int large = 16 + (int)(logf((float)n / 16.0f) / 2.0794415416798357f * 16.0f);
    return large < 31 ? large : 31;
}

template <int MAP>
__device__ __forceinline__ void p0_transpose_item(const float* W, int K, int N, bf16_t* WT, LAS float* scr, int item, int nblk, int lane) {
    const int kb = item / nblk, nb = item % nblk, k0 = 64 * kb, n0 = 32 * nb;
    const int v = n0 + (lane & 31);
    const int sc = MAP ? src_col(v) : v;
#pragma unroll 8
    for (int i = 0; i < 32; ++i) { const int kk = 2 * i + (lane >> 5); scr[kk * 33 + (lane & 31)] = (sc >= 0) ? W[(size_t)(k0 + kk) * N + sc] : 0.f; }
    asm volatile("s_waitcnt lgkmcnt(0)" ::: "memory");
    const int c = lane & 7;
#pragma unroll
    for (int j = 0; j < 4; ++j) { const int n = (lane >> 3) + 8 * j; const LAS float* s = scr + (8 * c) * 33 + n;
        u32x4 o; o.x = cvtpk(s[0 * 33], s[1 * 33]); o.y = cvtpk(s[2 * 33], s[3 * 33]); o.z = cvtpk(s[4 * 33], s[5 * 33]); o.w = cvtpk(s[6 * 33], s[7 * 33]);
        *(u32x4*)(WT + (size_t)(n0 + n) * K + k0 + 8 * c) = o; }
    asm volatile("s_waitcnt lgkmcnt(0)" ::: "memory");
}
__device__ __forceinline__ void p0_prologue(const Ctx& C, const Args& a) {
    unsigned char* ws = a.ws;
    LAS float* scr = (LAS float*)(C.lds + C.wid * 16384);
    const int gw = C.vcu * NWAVES + C.wid, NGW = C.G * NWAVES;
    constexpr int I_IN = (DM / 64) * (NV / 32), I_OUT = (DM / 64) * (DM / 32);
    for (int it = gw; it < 2 * I_IN + 2 * I_OUT; it += NGW) {
        int r = it;
        if (r < 2 * I_IN) { const int l = r / I_IN; r -= l * I_IN;
            p0_transpose_item<1>(a.w_in + (size_t)l * DM * D_IN, DM, D_IN, (bf16_t*)(ws + WS_WIN) + (size_t)l * NV * DM, scr, r, NV / 32, C.lane); continue; }
        r -= 2 * I_IN; { const int l = r / I_OUT; r -= l * I_OUT;
            p0_transpose_item<0>(a.w_out + (size_t)l * DM * DM, DM, DM, (bf16_t*)(ws + WS_WOUT) + (size_t)l * DM * DM, scr, r, DM / 32, C.lane); }
    }
    const int gt = C.vcu * NTHREADS + C.tid, NGT = C.G * NTHREADS;
    for (int e = gt; e < 2 * 1024 * 384; e += NGT) {
        const int l = e / (1024 * 384), rem = e % (1024 * 384), r = rem / 384, k = rem % 384;
        float v = 0.f;
        if (r < 256) { if (k < 256) v = a.mla_w_uq[(size_t)l * 256 * 384 + (size_t)k * 384 + (r >> 6) * 96 + (r & 63)]; }
        else if (r < 384) { if (k < 256) v = a.mla_w_uq[(size_t)l * 256 * 384 + (size_t)k * 384 + ((r - 256) >> 5) * 96 + 64 + ((r - 256) & 31)]; }
        else if (r < 512) { }
        else if (r < 768) { if (k >= 256) v = a.mla_w_ukv[(size_t)l * 128 * 512 + (size_t)(k - 256) * 512 + ((r - 512) >> 6) * 128 + ((r - 512) & 63)]; }
        else { if (k >= 256) v = a.mla_w_ukv[(size_t)l * 128 * 512 + (size_t)(k - 256) * 512 + ((r - 768) >> 6) * 128 + 64 + ((r - 768) & 63)]; }
        ((bf16_t*)(ws + WS_WMLA))[e] = (bf16_t)(cvtpk(v, 0.f) & 0xffffu);
    }
    for (int e = gt; e < SEQ * 16; e += NGT) {
        const int t = e >> 4, i = e & 15;
        const float ang = (float)t * powf(10000.0f, -(float)i / 16.0f);
        ((float*)(ws + WS_ROPE))[2 * e] = cosf(ang); ((float*)(ws + WS_ROPE))[2 * e + 1] = sinf(ang);
    }
    for (size_t e = gt; e < (size_t)M_TOK * DM / 8; e += NGT) {
        const f32x4 v0 = *(const f32x4*)(a.x + e * 8), v1 = *(const f32x4*)(a.x + e * 8 + 4);
        u32x4 o; o.x = cvtpk(v0[0], v0[1]); o.y = cvtpk(v0[2], v0[3]); o.z = cvtpk(v1[0], v1[1]); o.w = cvtpk(v1[2], v1[3]);
        *(u32x4*)((bf16_t*)(ws + WS_XB) + e * 8) = o;
    }
}

__device__ __forceinline__ void p2_mla_prep(const Ctx& C, const Args& a, int layer) {
    const bf16_t* HB = (const bf16_t*)(a.ws + WS_HB); bf16_t* CN = (bf16_t*)(a.ws + WS_CN); bf16_t* KR = (bf16_t*)(a.ws + WS_KR);
    const float* rope = (const float*)(a.ws + WS_ROPE);
    const float* gq = a.mla_q_norm + layer * 256; const float* gkv = a.mla_kv_norm + layer * 128;
    const int gw = C.vcu * NWAVES + C.wid, NGW = C.G * NWAVES, lane = C.lane;
    const f32x4 g4 = *(const f32x4*)(gq + 4 * lane); const float g20 = gkv[2 * lane], g21 = gkv[2 * lane + 1];
    for (int m = gw; m < M_TOK; m += NGW) {
        const bf16_t* hr = HB + (size_t)m * NV;
        const u32x2 q = *(const u32x2*)(hr + V_DCQ + 4 * lane);
        const unsigned kv = *(const unsigned*)(hr + V_DCKV + 2 * lane);
        const float q0 = bflo(q.x), q1 = bfhi(q.x), q2 = bflo(q.y), q3 = bfhi(q.y), k0 = bflo(kv), k1 = bfhi(kv);
        const float sq = wave_sum((q0 * q0 + q1 * q1) + (q2 * q2 + q3 * q3)), sk = wave_sum(k0 * k0 + k1 * k1);
        const float rq = 1.0f / sqrtf(sq * (1.0f / 256.0f) + 1e-6f), rk = 1.0f / sqrtf(sk * (1.0f / 128.0f) + 1e-6f);
        u32x2 oq; oq.x = cvtpk(q0 * rq * g4[0], q1 * rq * g4[1]); oq.y = cvtpk(q2 * rq * g4[2], q3 * rq * g4[3]);
        *(u32x2*)(CN + (size_t)m * 384 + 4 * lane) = oq;
        *(unsigned*)(CN + (size_t)m * 384 + 256 + 2 * lane) = cvtpk(k0 * rk * g20, k1 * rk * g21);
        if (lane < 16) {
            const float x1 = bf2f(hr[V_DKR + lane]), x2 = bf2f(hr[V_DKR + 16 + lane]);
            const float c = rope[((m & (SEQ - 1)) * 16 + lane) * 2], s = rope[((m & (SEQ - 1)) * 16 + lane) * 2 + 1];
            KR[(size_t)m * 32 + lane] = (bf16_t)(cvtpk(x1 * c - x2 * s, 0.f) & 0xffffu);
            KR[(size_t)m * 32 + 16 + lane] = (bf16_t)(cvtpk(x1 * s + x2 * c, 0.f) & 0xffffu);
        }
    }
}

__device__ __forceinline__ int wave_sum_dpp(int v) {
    v += __builtin_amdgcn_update_dpp(0, v, 0xB1, 0xf, 0xf, false);
    v += __builtin_amdgcn_update_dpp(0, v, 0x4E, 0xf, 0xf, false);
    v += __builtin_amdgcn_update_dpp(0, v, 0x141, 0xf, 0xf, false);
    v += __builtin_amdgcn_update_dpp(0, v, 0x140, 0xf, 0xf, false);
    return __builtin_amdgcn_readlane(v, 0) + __builtin_amdgcn_readlane(v, 16) + __builtin_amdgcn_readlane(v, 32) + __builtin_amdgcn_readlane(v, 48);
}
__device__ __forceinline__ unsigned wave_max_dpp(unsigned v) {
    unsigned o;
    o = (unsigned)__builtin_amdgcn_update_dpp(0, (int)v, 0xB1, 0xf, 0xf, false); v = v > o ? v : o;
    o = (unsigned)__builtin_amdgcn_update_dpp(0, (int)v, 0x4E, 0xf, 0xf, false); v = v > o ? v : o;
    o = (unsigned)__builtin_amdgcn_update_dpp(0, (int)v, 0x141, 0xf, 0xf, false); v = v > o ? v : o;
    o = (unsigned)__builtin_amdgcn_update_dpp(0, (int)v, 0x140, 0xf, 0xf, false); v = v > o ? v : o;
    const unsigned a = __builtin_amdgcn_readlane((int)v, 0), b = __builtin_amdgcn_readlane((int)v, 16), c = __builtin_amdgcn_readlane((int)v, 32), d = __builtin_amdgcn_readlane((int)v, 48);
    const unsigned ab = a > b ? a : b, cd = c > d ? c : d; return ab > cd ? ab : cd;
}
__device__ __forceinline__ unsigned wave_min_dpp(unsigned v) { return ~wave_max_dpp(~v); }
__device__ __forceinline__ unsigned sel_key(float v) { const unsigned bits = __float_as_uint(v + 0.0f); return (bits & 0x80000000u) ? ~bits : (bits | 0x80000000u); }
__device__ __forceinline__ unsigned sel_words(const unsigned (&u)[32], unsigned T, bool exact, int lane) {
    unsigned myword = 0u;
    if (exact) {
#pragma unroll
        for (int g = 0; g < 4; ++g) {
            asm("v_cmp_le_u32 s[84:85], %1, %2\n\tv_cmp_le_u32 s[86:87], %1, %3\n\tv_cmp_le_u32 s[88:89], %1, %4\n\tv_cmp_le_u32 s[90:91], %1, %5\n\t"
                "v_cmp_le_u32 s[92:93], %1, %6\n\tv_cmp_le_u32 s[94:95], %1, %7\n\tv_cmp_le_u32 s[96:97], %1, %8\n\tv_cmp_le_u32 s[98:99], %1, %9\n\ts_nop 3\n\t"
                "v_writelane_b32 %0, s84, %10\n\tv_writelane_b32 %0, s85, %10+1\n\tv_writelane_b32 %0, s86, %10+2\n\tv_writelane_b32 %0, s87, %10+3\n\t"
                "v_writelane_b32 %0, s88, %10+4\n\tv_writelane_b32 %0, s89, %10+5\n\tv_writelane_b32 %0, s90, %10+6\n\tv_writelane_b32 %0, s91, %10+7\n\t"
                "v_writelane_b32 %0, s92, %10+8\n\tv_writelane_b32 %0, s93, %10+9\n\tv_writelane_b32 %0, s94, %10+10\n\tv_writelane_b32 %0, s95, %10+11\n\t"
                "v_writelane_b32 %0, s96, %10+12\n\tv_writelane_b32 %0, s97, %10+13\n\tv_writelane_b32 %0, s98, %10+14\n\tv_writelane_b32 %0, s99, %10+15"
                : "+v"(myword) : "v"(T), "v"(u[8 * g]), "v"(u[8 * g + 1]), "v"(u[8 * g + 2]), "v"(u[8 * g + 3]), "v"(u[8 * g + 4]), "v"(u[8 * g + 5]), "v"(u[8 * g + 6]), "v"(u[8 * g + 7]), "i"(16 * g)
                : "s84", "s85", "s86", "s87", "s88", "s89", "s90", "s91", "s92", "s93", "s94", "s95", "s96", "s97", "s98", "s99");
        }
    } else {
        int cgt = 0;
#pragma unroll
        for (int i = 0; i < 32; ++i) cgt += __popcll(__ballot(u[i] > T));
        const int need = 256 - cgt;
        int running = 0;
        const unsigned long long ltmask = (1ull << lane) - 1ull;
#pragma unroll
        for (int i = 0; i < 32; ++i) {
            const unsigned long long eq = __ballot(u[i] == T);
            const int pre = running + __popcll(eq & ltmask);
            const bool selb = (u[i] > T) || ((u[i] == T) && (pre < need));
            const unsigned long long bal = __ballot(selb);
            running += __popcll(eq);
            if ((lane >> 1) == i) myword = (lane & 1) ? (unsigned)(bal >> 32) : (unsigned)bal;
            __builtin_amdgcn_sched_barrier(0);
        }
    }
    return myword;
}
__device__ __forceinline__ void sel_step(const Ctx& C, const Args& a, int b, int j) {
    const bf16_t* HB = (const bf16_t*)(a.ws + WS_HB); unsigned* SEL = (unsigned*)(a.ws + WS_SEL);
    LAS float* sc_lds = (LAS float*)C.lds;
    int lane_op = C.lane; asm volatile("" : "+v"(lane_op));
    const int lane = lane_op, wid = C.wid, t0 = 16 * j;
    const size_t rb = (size_t)b * SEQ;
    if (t0 + 15 < 256) {
#pragma unroll
        for (int rr = 0; rr < 2; ++rr) SEL[(rb + t0 + 2 * wid + rr) * 64 + lane] = 0xFFFFFFFFu;
        return;
    }
    const int nkt = j + 1;
    {
        const int q = lane & 15, kq = lane >> 4;
        const bf16_t* qrow = HB + (rb + t0 + q) * NV;
        bf16x8 ak[16];
#pragma unroll
        for (int i = 0; i < 16; ++i) { const int kt = wid + 8 * i; if (kt < nkt) ak[i] = *(const bf16x8*)(HB + (rb + 16 * kt + q) * NV + V_CIK + 8 * kq); }
        bf16x8 bq[8];
#pragma unroll
        for (int h = 0; h < 8; ++h) bq[h] = *(const bf16x8*)(qrow + V_CIQ + h * 32 + 8 * kq);
        const u32x4 wv = *(const u32x4*)(qrow + V_CIW);
        float w[8]; const float wsc = 0.35355339059327373f * 0.17677669529663687f;
        w[0] = bflo(wv.x) * wsc; w[1] = bfhi(wv.x) * wsc; w[2] = bflo(wv.y) * wsc; w[3] = bfhi(wv.y) * wsc;
        w[4] = bflo(wv.z) * wsc; w[5] = bfhi(wv.z) * wsc; w[6] = bflo(wv.w) * wsc; w[7] = bfhi(wv.w) * wsc;
        for (int rep = 0; rep < NREP(9); ++rep)
#pragma unroll
        for (int i = 0; i < 16; ++i) { const int kt = wid + 8 * i;
            if (kt < nkt) {
                f32x4 s = {0.f, 0.f, 0.f, 0.f};
#pragma unroll
                for (int h = 0; h < 8; ++h) { const f32x4 d = mfma16(ak[i], bq[h], (f32x4){0.f, 0.f, 0.f, 0.f});
#pragma unroll
                    for (int e = 0; e < 4; ++e) s[e] = fmaf(w[h], fmaxf(d[e], 0.f), s[e]); }
                *(LAS f32x4*)(sc_lds + q * SEL_RS + 16 * kt + 4 * kq) = s;
            } }
    }
    __syncthreads();
    for (int rep = 0; rep < NREP(15); ++rep)
#pragma unroll 1
    for (int rr = 0; rr < 2; ++rr) {
        const int q = 2 * wid + rr, t = t0 + q;
        LAS unsigned* hist = (LAS unsigned*)(C.lds + LDS_HIST + wid * HIST_WAVE);
        LAS unsigned* cand = hist + 512; LAS unsigned* ccnt = hist + 640;
        float v[32]; unsigned u[32];
        float vmin = 3.0e38f, vmax = -3.0e38f;
#pragma unroll
        for (int i = 0; i < 32; ++i) { const int key = lane + 64 * i; const int kc = key <= t ? key : t;
            const float x = sc_lds[q * SEL_RS + kc] + 0.0f;
            v[i] = x; u[i] = (key <= t) ? sel_key(x) : 0u; vmin = fminf(vmin, x); vmax = fmaxf(vmax, x); }
        *(LAS u32x4*)(hist + 8 * lane) = (u32x4){0u, 0u, 0u, 0u}; *(LAS u32x4*)(hist + 8 * lane + 4) = (u32x4){0u, 0u, 0u, 0u};
        if (lane == 0) ccnt[0] = 0u;
        const unsigned kmin = wave_min_dpp(sel_key(vmin)), kmax = wave_max_dpp(sel_key(vmax));
        const float fmin_ = (kmin & 0x80000000u) ? __uint_as_float(kmin & 0x7FFFFFFFu) : __uint_as_float(~kmin);
        const float fmax_ = (kmax & 0x80000000u) ? __uint_as_float(kmax & 0x7FFFFFFFu) : __uint_as_float(~kmax);
        const float range = fmax_ - fmin_;
        const float scale = range > 0.f ? 511.0f / range : 0.f;
        int bin[32];
#pragma unroll
        for (int i = 0; i < 32; ++i) { const float bf = (v[i] - fmin_) * scale; int bi = (int)bf; bi = bi < 0 ? 0 : (bi > 511 ? 511 : bi); bin[i] = bi; }
#pragma unroll
        for (int i = 0; i < 32; ++i) { if (lane + 64 * i <= t) atomicAdd((unsigned*)(hist + bin[i]), 1u); }
        asm volatile("s_waitcnt lgkmcnt(0)" ::: "memory");
        const u32x4 h0 = *(LAS const u32x4*)(hist + 8 * lane), h1 = *(LAS const u32x4*)(hist + 8 * lane + 4);
        const int hb[8] = {(int)h0[0], (int)h0[1], (int)h0[2], (int)h0[3], (int)h1[0], (int)h1[1], (int)h1[2], (int)h1[3]};
        const int own = (hb[0] + hb[1]) + (hb[2] + hb[3]) + (hb[4] + hb[5]) + (hb[6] + hb[7]);
        int incl = own;
#pragma unroll
        for (int o = 1; o < 64; o <<= 1) { const int x = __shfl_down(incl, o); if (lane + o < 64) incl += x; }
        const int above_lane = incl - own;
        const bool mine = (above_lane < 256) && (incl >= 256);
        int bstar = 0, above = 0;
        {
            int acc = above_lane, bs = 0, ab = 0; bool found = false;
#pragma unroll
            for (int k = 7; k >= 0; --k) { if (!found && acc + hb[k] >= 256) { found = true; bs = 8 * lane + k; ab = acc; } acc += hb[k]; }
            const unsigned long long mb = __ballot(mine);
            const int src = mb ? (int)__builtin_ctzll(mb) : 0;
            bstar = __shfl(bs, src); above = __shfl(ab, src);
        }
        const int need = 256 - above;
#pragma unroll
        for (int i = 0; i < 32; ++i) { if ((lane + 64 * i <= t) && bin[i] == bstar) { const unsigned slot = atomicAdd((unsigned*)ccnt, 1u); if (slot < 64u) cand[slot] = u[i]; } }
        asm volatile("s_waitcnt lgkmcnt(0)" ::: "memory");
        const int m = (int)ccnt[0];
        unsigned T = 0u; bool exact = false;
        if (m <= 64) {
            const unsigned mykey = (lane < m) ? cand[lane] : 0u;
            int cge = 0;
            for (int i = 0; i < m; ++i) { const unsigned ki = (unsigned)__builtin_amdgcn_readlane((int)mykey, i); cge += (ki >= mykey) ? 1 : 0; }
            T = wave_max_dpp((lane < m && cge >= need) ? mykey : 0u);
            exact = (int)wave_max_dpp((lane < m && mykey == T) ? (unsigned)cge : 0u) == need;
        } else {
#pragma unroll 1
            for (int bit = 31; bit >= 0; --bit) {
                const unsigned x = T | (1u << bit);
                int c = 0;
#pragma unroll
                for (int i = 0; i < 32; ++i) c += (u[i] >= x) ? 1 : 0;
                c = wave_sum_dpp(c);
                if (c >= 256) { T = x; if (c == 256) { exact = true; break; } }
            }
        }
        for (int rep2 = 0; rep2 < NREP(16); ++rep2) { asm volatile("" : "+v"(u[0])); SEL[(rb + t) * 64 + lane] = sel_words(u, T, exact, lane); }
    }
    __syncthreads();
}
__device__ __forceinline__ void p2_select(const Ctx& C, const Args& a) {
    for (int v = C.vcu; v < NB * 16; v += C.G) {
        const int b = v >> 4, p = v & 15;
#pragma unroll 1
        for (int i = 0; i < 8; ++i) { const int j = (i & 1) ? (32 * (i >> 1) + 31 - p) : (32 * (i >> 1) + p); sel_step(C, a, b, j); }
    }
}

struct TileRegs { u32x4 k0, k1, v; };
struct AttnSrc { const bf16_t* Kp; int kpitch; const bf16_t* Kr; const bf16_t* Vp; int vpitch; };
template <int NCH>
__device__ __forceinline__ void tile_load(TileRegs& r, const AttnSrc& s, int key0, int wid, int lane) {
    r.k0 = *(const u32x4*)(s.Kp + (size_t)(key0 + lane) * s.kpitch + wid * 8);
    if (NCH == 12) { if (wid < 4) r.k1 = *(const u32x4*)(s.Kr + (size_t)(key0 + lane) * 32 + wid * 8); }
    r.v = *(const u32x4*)(s.Vp + (size_t)(key0 + 16 * (wid & 3) + (lane >> 2)) * s.vpitch + (wid >> 2) * 32 + (lane & 3) * 8);
}
template <int NCH>
__device__ __forceinline__ void tile_write(const TileRegs& r, LAS unsigned char* kb, LAS unsigned char* vb, int wid, int lane) {
    *(LAS u32x4*)(kb + wid * 1024 + lane * 16) = r.k0;
    if (NCH == 12) { if (wid < 4) *(LAS u32x4*)(kb + (8 + wid) * 1024 + lane * 16) = r.k1; }
    *(LAS u32x4*)(vb + wid * 1024 + lane * 16) = r.v;
}
template <int ND>
__device__ __forceinline__ void qk_tile(f32x16& p0, f32x16& p1, LAS const unsigned char* kb, int cb, const bf16x8* qf, int r32, int hi) {
#pragma unroll
    for (int d0 = 0; d0 < ND; ++d0) {
        const bf16x8 a0 = *(LAS const bf16x8*)(kb + (cb + 2 * d0 + hi) * 1024 + r32 * 16);
        const bf16x8 a1 = *(LAS const bf16x8*)(kb + (cb + 2 * d0 + hi) * 1024 + 512 + r32 * 16);
        p0 = mfma32(a0, qf[d0], p0); p1 = mfma32(a1, qf[d0], p1);
    }
}
__device__ __forceinline__ bf16x8 pack8(const f32x16& p, int base) {
    u32x4 w; w.x = cvtpk(p[base + 0], p[base + 1]); w.y = cvtpk(p[base + 2], p[base + 3]); w.z = cvtpk(p[base + 4], p[base + 5]); w.w = cvtpk(p[base + 6], p[base + 7]);
    return __builtin_bit_cast(bf16x8, w);
}
__device__ __forceinline__ void pv_half(f32x16 (&o)[2], LAS const unsigned char* vb, int lane, int hi, int ks0, bf16x8 pa, bf16x8 pb) {
    LAS const unsigned char* vp = vb + ((lane >> 4) & 1) * 32 + (lane & 3) * 8 + (4 * hi + ((lane & 15) >> 2)) * 64;
#pragma unroll
    for (int d0 = 0; d0 < 2; ++d0) {
#pragma unroll
        for (int k = 0; k < 2; ++k) {
            const v4i16_t lo = vtr(vp + d0 * 4096 + (ks0 + k) * 1024), hh = vtr(vp + d0 * 4096 + (ks0 + k) * 1024 + 512);
            const bf16x8 vf = {lo[0], lo[1], lo[2], lo[3], hh[0], hh[1], hh[2], hh[3]};
            o[d0] = mfma32(vf, k == 0 ? pa : pb, o[d0]);
        }
    }
}
__device__ __forceinline__ void store_gated(const f32x16 (&o)[2], const bf16_t* HB, bf16_t* OB, size_t row, int colg, int hi) {
#pragma unroll
    for (int d0 = 0; d0 < 2; ++d0)
#pragma unroll
        for (int g4 = 0; g4 < 4; ++g4) {
            const int d = 32 * d0 + 8 * g4 + 4 * hi;
            const u32x2 g = *(const u32x2*)(HB + row * NV + V_GATE + colg + d);
            u32x2 w; w.x = cvtpk(o[d0][4 * g4 + 0] * bflo(g.x), o[d0][4 * g4 + 1] * bfhi(g.x)); w.y = cvtpk(o[d0][4 * g4 + 2] * bflo(g.y), o[d0][4 * g4 + 3] * bfhi(g.y));
            *(u32x2*)(OB + row * DM + colg + d) = w;
        }
}

struct SmState { float m, l; f32x16 o[2]; f32x16 lacc; };
template <bool MS>
__device__ __forceinline__ void sm_stats(SmState& st, f32x16& x0, f32x16& x1) {
    float ma = __builtin_fmaxf(__builtin_fmaxf(x0[0], x0[1]), x0[2]), mb = __builtin_fmaxf(__builtin_fmaxf(x1[0], x1[1]), x1[2]);
#pragma unroll
    for (int r = 3; r < 15; r += 2) { ma = __builtin_fmaxf(__builtin_fmaxf(ma, x0[r]), x0[r + 1]); mb = __builtin_fmaxf(__builtin_fmaxf(mb, x1[r]), x1[r + 1]); }
    float mx = __builtin_fmaxf(__builtin_fmaxf(ma, mb), __builtin_fmaxf(x0[15], x1[15]));
    mx = xhalf_max(mx);
    const float mn = fmaxf(st.m, mx);
    const float ms = (mn == -INFINITY) ? 0.f : mn;
    float ls = 0.f;
#pragma unroll
    for (int r = 0; r < 16; ++r) { x0[r] = __builtin_amdgcn_exp2f(x0[r] - ms); x1[r] = __builtin_amdgcn_exp2f(x1[r] - ms); if (!MS) ls += x0[r] + x1[r]; }
    if (__any(mn != st.m)) {
        const float alpha = __builtin_amdgcn_exp2f(st.m - ms);
        if (MS) st.lacc[0] *= alpha; else st.l *= alpha;
#pragma unroll
        for (int r = 0; r < 16; ++r) { st.o[0][r] *= alpha; st.o[1][r] *= alpha; }
    }
    if (!MS) st.l += ls;
    st.m = mn;
}
__device__ __forceinline__ void v_frags(bf16x8 (&vf)[2][4], LAS const unsigned char* vb, int lane, int hi) {
    LAS const unsigned char* vp = vb + ((lane >> 4) & 1) * 32 + (lane & 3) * 8 + (4 * hi + ((lane & 15) >> 2)) * 64;
#pragma unroll
    for (int d0 = 0; d0 < 2; ++d0)
#pragma unroll
        for (int ks = 0; ks < 4; ++ks) {
            const v4i16_t lo = vtr(vp + d0 * 4096 + ks * 1024), hh = vtr(vp + d0 * 4096 + ks * 1024 + 512);
            vf[d0][ks] = (bf16x8){lo[0], lo[1], lo[2], lo[3], hh[0], hh[1], hh[2], hh[3]};
        }
}
template <bool MS>
__device__ __forceinline__ void pv_tile(SmState& st, const bf16x8 (&vf)[2][4], const f32x16& x0, const f32x16& x1) {
    const bf16x8 p0 = pack8(x0, 0), p1 = pack8(x0, 8), p2 = pack8(x1, 0), p3 = pack8(x1, 8);
    const bf16x8 ones = {0x3F80, 0x3F80, 0x3F80, 0x3F80, 0x3F80, 0x3F80, 0x3F80, 0x3F80};
#pragma unroll
    for (int d0 = 0; d0 < 2; ++d0) { st.o[d0] = mfma32(vf[d0][0], p0, st.o[d0]); st.o[d0] = mfma32(vf[d0][1], p1, st.o[d0]); st.o[d0] = mfma32(vf[d0][2], p2, st.o[d0]); st.o[d0] = mfma32(vf[d0][3], p3, st.o[d0]); }
    if (MS) { st.lacc = mfma32(ones, p0, st.lacc); st.lacc = mfma32(ones, p1, st.lacc); st.lacc = mfma32(ones, p2, st.lacc); st.lacc = mfma32(ones, p3, st.lacc); }
}

template <int MODE>
__device__ __forceinline__ void attn_unit_sm(const Ctx& C, const Args& a, int layer, int b, int h, int qb) {
    constexpr int NCH = (MODE == 3) ? 12 : 8;
    const bf16_t* HB = (const bf16_t*)(a.ws + WS_HB); const bf16_t* MD = (const bf16_t*)(a.ws + WS_MD); const bf16_t* KR = (const bf16_t*)(a.ws + WS_KR);
    bf16_t* OB = (bf16_t*)(a.ws + WS_XB); const unsigned* SEL = (const unsigned*)(a.ws + WS_SEL);
    int lane_op = C.lane; asm volatile("" : "+v"(lane_op));
    const int lane = lane_op, wid = C.wid, r32 = lane & 31, hi = lane >> 5;
    const size_t rb = (size_t)b * SEQ;
    const int q0 = 256 * qb, tq = q0 + 32 * wid + r32;
    const size_t qrow = rb + tq;
    LAS unsigned char* lds = C.lds;
    LAS float* btab = (LAS float*)(lds + AL_BIAS);
    AttnSrc src;
    if (MODE == 1) { src.Kp = HB + rb * NV + V_BK + h * 64; src.kpitch = NV; src.Kr = nullptr; src.Vp = HB + rb * NV + V_BV + h * 64; src.vpitch = NV; }
    if (MODE == 2) { src.Kp = HB + rb * NV + V_CK + h * 64; src.kpitch = NV; src.Kr = nullptr; src.Vp = HB + rb * NV + V_CV + h * 64; src.vpitch = NV; }
    if (MODE == 3) { src.Kp = MD + rb * DM + MD_KN + h * 64; src.kpitch = DM; src.Kr = KR + rb * 32; src.Vp = MD + rb * DM + MD_V + h * 64; src.vpitch = DM; }
    if (MODE != 3) { if (C.tid <= 128) btab[C.tid] = a.rel_bias[t5_bucket(C.tid) * 8 + (MODE == 2 ? 4 : 0) + h] * LOG2E; }
    const float c1 = (MODE == 1 ? 0.17677669529663687f : (MODE == 2 ? 0.125f : 0.10206207261596577f)) * LOG2E;
    auto qscale = [&](bf16x8 q) { u32x4 w = __builtin_bit_cast(u32x4, q);
#pragma unroll
        for (int i = 0; i < 4; ++i) w[i] = cvtpk(bflo(w[i]) * c1, bfhi(w[i]) * c1);
        return __builtin_bit_cast(bf16x8, w); };
    constexpr int NQ = (MODE == 3) ? 6 : (MODE == 1 ? 1 : 4);
    bf16x8 qf[NQ];
    LAS bf16x8* qlds = (LAS bf16x8*)(lds + AL_Q) + wid * 256 + lane;
    if (MODE == 1) {
#pragma unroll
        for (int d0 = 0; d0 < 4; ++d0) qlds[64 * d0] = qscale(*(const bf16x8*)(HB + qrow * NV + V_BQ + h * 64 + 16 * d0 + 8 * hi)); }
    if (MODE == 2) {
#pragma unroll
        for (int d0 = 0; d0 < 4; ++d0) qf[d0] = qscale(*(const bf16x8*)(HB + qrow * NV + V_CQ + h * 64 + 16 * d0 + 8 * hi)); }
    if (MODE == 3) {
#pragma unroll
        for (int d0 = 0; d0 < 4; ++d0) qf[d0] = qscale(*(const bf16x8*)(MD + qrow * DM + MD_QN + h * 64 + 16 * d0 + 8 * hi));
#pragma unroll
        for (int d0 = 0; d0 < 2; ++d0) qf[4 + d0] = *(const bf16x8*)(MD + qrow * DM + MD_QR + h * 32 + 16 * d0 + 8 * hi);
        const f32x2_t* rp = (const f32x2_t*)(a.ws + WS_ROPE) + (size_t)tq * 16 + 8 * hi;
        u32x4 w4 = __builtin_bit_cast(u32x4, qf[4]), w5 = __builtin_bit_cast(u32x4, qf[5]);
#pragma unroll
        for (int jj = 0; jj < 4; ++jj) {
            const f32x2_t cs0 = rp[2 * jj], cs1 = rp[2 * jj + 1];
            const float a0 = bflo(w4[jj]), a1 = bfhi(w4[jj]), b0 = bflo(w5[jj]), b1 = bfhi(w5[jj]);
            w4[jj] = cvtpk((a0 * cs0.x - b0 * cs0.y) * c1, (a1 * cs1.x - b1 * cs1.y) * c1);
            w5[jj] = cvtpk((a0 * cs0.y + b0 * cs0.x) * c1, (a1 * cs1.y + b1 * cs1.x) * c1);
        }
        qf[4] = __builtin_bit_cast(bf16x8, w4); qf[5] = __builtin_bit_cast(bf16x8, w5); }
    SmState s1, s2;
    s1.m = -INFINITY; s1.l = 0.f; s1.lacc = f32x16{}; s1.o[0] = f32x16{}; s1.o[1] = f32x16{};
    if (MODE == 1) { s2.m = -INFINITY; s2.l = 0.f; s2.o[0] = f32x16{}; s2.o[1] = f32x16{}; }
    const int NT = 4 * (qb + 1), my_last = 4 * qb + (wid >> 1);
    const int tmin = q0 + 32 * wid;
    constexpr bool PF2 = (MODE != 1);
    auto compute = [&](const int tt, const int cur) {
        if (tt <= my_last) {
            LAS const unsigned char* kb = lds + AL_K + cur * AL_KB; LAS const unsigned char* vb = lds + AL_V + cur * AL_VB;
            const int key0 = 64 * tt;
            const bool diag = (tt == my_last);
            const bool farb = (MODE != 3) && (key0 + 63 + 128 <= tmin);
            const float pinit = farb ? btab[128] : 0.f;
            u32x2 wsel = {0u, 0u};
            if (MODE == 2) wsel = *(const u32x2*)(SEL + qrow * 64 + 2 * tt);
            auto finish_scores = [&](f32x16& p0, f32x16& p1) {
                if (MODE != 3 && !farb) {
#pragma unroll
                    for (int r = 0; r < 16; ++r) { int d0i = tq - (key0 + crow(r, hi)); int d1i = d0i - 32;
                        d0i = d0i < 0 ? 0 : (d0i > 128 ? 128 : d0i); d1i = d1i < 0 ? 0 : (d1i > 128 ? 128 : d1i);
                        p0[r] += btab[d0i]; p1[r] += btab[d1i]; }
                }
                if (diag) {
#pragma unroll
                    for (int r = 0; r < 16; ++r) { const int k0i = key0 + crow(r, hi); if (k0i > tq) p0[r] = -INFINITY; if (k0i + 32 > tq) p1[r] = -INFINITY; }
                }
                if (MODE == 2) {
                    const unsigned w0 = wsel.x >> (4 * hi), w1 = wsel.y >> (4 * hi);
#pragma unroll
                    for (int r = 0; r < 16; ++r) { const int bp = (r & 3) + 8 * (r >> 2);
                        const unsigned m0 = (unsigned)((int)(w0 << (31 - bp)) >> 31), m1 = (unsigned)((int)(w1 << (31 - bp)) >> 31);
                        p0[r] = __uint_as_float((__float_as_uint(p0[r]) & m0) | (~m0 & 0xFF800000u)); p1[r] = __uint_as_float((__float_as_uint(p1[r]) & m1) | (~m1 & 0xFF800000u)); }
                }
            };
            f32x16 pz;
#pragma unroll
            for (int r = 0; r < 16; ++r) pz[r] = pinit;
            bf16x8 vf[2][4];
            if (MODE == 1) {
                f32x16 a0 = pz, a1 = pz, b0 = pz, b1 = pz;
                { bf16x8 q2[2] = {qlds[0], qlds[64]}; qk_tile<2>(a0, a1, kb, 0, q2, r32, hi); }
                { bf16x8 q2[2] = {qlds[128], qlds[192]}; qk_tile<2>(b0, b1, kb, 4, q2, r32, hi); }
                finish_scores(a0, a1); sm_stats<false>(s1, a0, a1);
                finish_scores(b0, b1); sm_stats<false>(s2, b0, b1);
                v_frags(vf, vb, lane, hi);
                pv_tile<false>(s1, vf, a0, a1); pv_tile<false>(s2, vf, b0, b1);
            } else {
                f32x16 p0 = pz, p1 = pz;
                qk_tile<(MODE == 3 ? 6 : 4)>(p0, p1, kb, 0, qf, r32, hi);
                if (MODE == 2 && REP_PH == 20) { f32x16 d0_ = pz, d1_ = pz; qk_tile<4>(d0_, d1_, kb, 0, qf, r32, hi); asm volatile("" :: "v"(d0_), "v"(d1_)); }
                if (MODE == 2 && REP_PH == 21) { SmState sx = s1; f32x16 e0 = p0, e1 = p1; finish_scores(e0, e1); sm_stats<true>(sx, e0, e1); asm volatile("" :: "v"(e0), "v"(e1), "v"(sx.m)); }
                finish_scores(p0, p1); sm_stats<true>(s1, p0, p1);
                v_frags(vf, vb, lane, hi);
                if (MODE == 2 && REP_PH == 22) { bf16x8 vg[2][4]; v_frags(vg, vb, lane, hi); SmState sx2 = s1; pv_tile<true>(sx2, vg, p0, p1); asm volatile("" :: "v"(sx2.o[0]), "v"(sx2.o[1])); }
                pv_tile<true>(s1, vf, p0, p1);
            }
        }
    };
    TileRegs trA, trB;
    tile_load<NCH>(trA, src, 0, wid, lane);
    tile_write<NCH>(trA, lds + AL_K, lds + AL_V, wid, lane);
    if constexpr (PF2) {
        tile_load<NCH>(trB, src, 64, wid, lane);
        __syncthreads();
#pragma unroll 1
        for (int tt = 0; tt < NT; tt += 2) {
            if (tt + 2 < NT) tile_load<NCH>(trA, src, 64 * (tt + 2), wid, lane);
            compute(tt, 0);
            tile_write<NCH>(trB, lds + AL_K + AL_KB, lds + AL_V + AL_VB, wid, lane);
            __syncthreads();
            if (MODE == 2 && REP_PH == 23) __syncthreads();
            if (tt + 3 < NT) tile_load<NCH>(trB, src, 64 * (tt + 3), wid, lane);
            compute(tt + 1, 1);
            if (tt + 2 < NT) tile_write<NCH>(trA, lds + AL_K, lds + AL_V, wid, lane);
            __syncthreads();
            if (MODE == 2 && REP_PH == 23) __syncthreads();
        }
    } else {
        __syncthreads();
#pragma unroll 1
        for (int tt = 0; tt < NT; ++tt) {
            const int cur = tt & 1;
            if (tt + 1 < NT) tile_load<NCH>(trA, src, 64 * (tt + 1), wid, lane);
            compute(tt, cur);
            if (tt + 1 < NT) tile_write<NCH>(trA, lds + AL_K + (cur ^ 1) * AL_KB, lds + AL_V + (cur ^ 1) * AL_VB, wid, lane);
            __syncthreads();
        }
    }
    const float l1 = (MODE == 1) ? xhalf_sum(s1.l) : s1.lacc[0], il1 = 1.0f / l1;
    if (MODE == 1) {
        const float* dl = a.diff_lambda + layer * 128;
        float a0 = 0.f, a1 = 0.f;
        if (lane < 32) { a0 = dl[lane] * dl[32 + lane]; a1 = dl[64 + lane] * dl[96 + lane]; }
        const float lam_init = (layer == 0) ? 0.2f : 0.35550906779f;
        const float lam = expf(wave_sum(a0)) - expf(wave_sum(a1)) + lam_init;
        const float l2 = xhalf_sum(s2.l), f2 = lam / l2;
        float ss = 0.f;
#pragma unroll
        for (int d0 = 0; d0 < 2; ++d0)
#pragma unroll
            for (int r = 0; r < 16; ++r) { const float v = s1.o[d0][r] * il1 - s2.o[d0][r] * f2; s1.o[d0][r] = v; ss += v * v; }
        ss = xhalf_sum(ss);
        const float rn = (1.0f / sqrtf(ss * (1.0f / 64.0f) + 1e-6f)) * (1.0f - lam_init);
        const float* sg = a.diff_subln + layer * 64;
#pragma unroll
        for (int d0 = 0; d0 < 2; ++d0)
#pragma unroll
            for (int g4 = 0; g4 < 4; ++g4) { const f32x4 gv = *(const f32x4*)(sg + 32 * d0 + 8 * g4 + 4 * hi);
#pragma unroll
                for (int i = 0; i < 4; ++i) s1.o[d0][4 * g4 + i] *= rn * gv[i]; }
    } else {
#pragma unroll
        for (int d0 = 0; d0 < 2; ++d0)
#pragma unroll
            for (int r = 0; r < 16; ++r) s1.o[d0][r] *= il1;
    }
    store_gated(s1.o, HB, OB, qrow, MODE * 256 + h * 64, hi);
}

template <int NCH>
__device__ __forceinline__ void tile_load2(TileRegs& r, const AttnSrc& s, int kkey0, bool kon, int vkey0, bool von, int wid, int lane) {
    if (kon) { r.k0 = *(const u32x4*)(s.Kp + (size_t)(kkey0 + lane) * s.kpitch + wid * 8);
        if (NCH == 12) { if (wid < 4) r.k1 = *(const u32x4*)(s.Kr + (size_t)(kkey0 + lane) * 32 + wid * 8); } }
    if (von) r.v = *(const u32x4*)(s.Vp + (size_t)(vkey0 + 16 * (wid & 3) + (lane >> 2)) * s.vpitch + (wid >> 2) * 32 + (lane & 3) * 8);
}
template <int NCH>
__device__ __forceinline__ void tile_write2(const TileRegs& r, LAS unsigned char* kb, bool kon, LAS unsigned char* vb, bool von, int wid, int lane) {
    if (kon) { *(LAS u32x4*)(kb + wid * 1024 + lane * 16) = r.k0;
        if (NCH == 12) { if (wid < 4) *(LAS u32x4*)(kb + (8 + wid) * 1024 + lane * 16) = r.k1; } }
    if (von) *(LAS u32x4*)(vb + wid * 1024 + lane * 16) = r.v;
}
template <int MODE>
__device__ __forceinline__ void attn_unit_pipe(const Ctx& C, const Args& a, int layer, int b, int h, int qb) {
    constexpr int NCH = (MODE == 3) ? 12 : 8;
    constexpr int ND = (MODE == 3) ? 6 : 4;
    const bf16_t* HB = (const bf16_t*)(a.ws + WS_HB); const bf16_t* MD = (const bf16_t*)(a.ws + WS_MD); const bf16_t* KR = (const bf16_t*)(a.ws + WS_KR);
    bf16_t* OB = (bf16_t*)(a.ws + WS_XB); const unsigned* SEL = (const unsigned*)(a.ws + WS_SEL);
    int lane_op = C.lane; asm volatile("" : "+v"(lane_op));
    const int lane = lane_op, wid = C.wid, r32 = lane & 31, hi = lane >> 5;
    const size_t rb = (size_t)b * SEQ;
    const int q0 = 256 * qb, tq = q0 + 32 * wid + r32;
    const size_t qrow = rb + tq;
    LAS unsigned char* lds = C.lds;
    LAS float* btab = (LAS float*)(lds + AL_BIAS);
    AttnSrc src;
    if (MODE == 2) { src.Kp = HB + rb * NV + V_CK + h * 64; src.kpitch = NV; src.Kr = nullptr; src.Vp = HB + rb * NV + V_CV + h * 64; src.vpitch = NV; }
    if (MODE == 3) { src.Kp = MD + rb * DM + MD_KN + h * 64; src.kpitch = DM; src.Kr = KR + rb * 32; src.Vp = MD + rb * DM + MD_V + h * 64; src.vpitch = DM; }
    if (MODE != 3) { if (C.tid <= 128) btab[C.tid] = a.rel_bias[t5_bucket(C.tid) * 8 + 4 + h] * LOG2E; }
    const float c1 = (MODE == 2 ? 0.125f : 0.10206207261596577f) * LOG2E;
    auto qscale = [&](bf16x8 q) { u32x4 w = __builtin_bit_cast(u32x4, q);
#pragma unroll
        for (int i = 0; i < 4; ++i) w[i] = cvtpk(bflo(w[i]) * c1, bfhi(w[i]) * c1);
        return __builtin_bit_cast(bf16x8, w); };
    bf16x8 qf[ND];
    if (MODE == 2) {
#pragma unroll
        for (int d0 = 0; d0 < 4; ++d0) qf[d0] = qscale(*(const bf16x8*)(HB + qrow * NV + V_CQ + h * 64 + 16 * d0 + 8 * hi)); }
    if (MODE == 3) {
#pragma unroll
        for (int d0 = 0; d0 < 4; ++d0) qf[d0] = qscale(*(const bf16x8*)(MD + qrow * DM + MD_QN + h * 64 + 16 * d0 + 8 * hi));
#pragma unroll
        for (int d0 = 0; d0 < 2; ++d0) qf[4 + d0] = *(const bf16x8*)(MD + qrow * DM + MD_QR + h * 32 + 16 * d0 + 8 * hi);
        const f32x2_t* rp = (const f32x2_t*)(a.ws + WS_ROPE) + (size_t)tq * 16 + 8 * hi;
        u32x4 w4 = __builtin_bit_cast(u32x4, qf[4]), w5 = __builtin_bit_cast(u32x4, qf[5]);
#pragma unroll
        for (int jj = 0; jj < 4; ++jj) {
            const f32x2_t cs0 = rp[2 * jj], cs1 = rp[2 * jj + 1];
            const float a0 = bflo(w4[jj]), a1 = bfhi(w4[jj]), b0 = bflo(w5[jj]), b1 = bfhi(w5[jj]);
            w4[jj] = cvtpk((a0 * cs0.x - b0 * cs0.y) * c1, (a1 * cs1.x - b1 * cs1.y) * c1);
            w5[jj] = cvtpk((a0 * cs0.y + b0 * cs0.x) * c1, (a1 * cs1.y + b1 * cs1.x) * c1);
        }
        qf[4] = __builtin_bit_cast(bf16x8, w4); qf[5] = __builtin_bit_cast(bf16x8, w5); }
    float m_run = -INFINITY, l_run = 0.f;
    f32x16 o[2]; o[0] = f32x16{}; o[1] = f32x16{};
    const int NT = 4 * (qb + 1), my_last = 4 * qb + (wid >> 1);
    const int tmin = q0 + 32 * wid;
    TileRegs tr;
    tile_load2<NCH>(tr, src, 0, true, 0, false, wid, lane);
    tile_write2<NCH>(tr, lds + AL_K, true, lds + AL_V, false, wid, lane);
    __syncthreads();
    f32x16 sc0 = f32x16{}, sc1 = f32x16{};
    bf16x8 pk[4] = {};
    auto step = [&](int it, auto S1, auto S2, auto S3, auto FA) {
        constexpr bool s1 = decltype(S1)::value, s2 = decltype(S2)::value, s3 = decltype(S3)::value, fast = decltype(FA)::value;
        const int cur = it & 1;
        LAS const unsigned char* kb = lds + AL_K + cur * AL_KB; LAS const unsigned char* vb = lds + AL_V + cur * AL_VB;
        f32x16 n0, n1;
        if (s1) {
            const int key0 = 64 * it;
            const float pinit = ((MODE != 3) && (key0 + 63 + 128 <= tmin)) ? btab[128] : 0.f;
#pragma unroll
            for (int r = 0; r < 16; ++r) { n0[r] = pinit; n1[r] = pinit; }
            qk_tile<ND>(n0, n1, kb, 0, qf, r32, hi);
        }
        float mn = m_run, ls = 0.f; bf16x8 pn[4];
        if (s2) {
            const int tb = it - 1, key0 = 64 * tb;
            if (!fast && MODE != 3 && !(key0 + 63 + 128 <= tmin)) {
#pragma unroll
                for (int r = 0; r < 16; ++r) { int d0i = tq - (key0 + crow(r, hi)); int d1i = d0i - 32;
                    d0i = d0i < 0 ? 0 : (d0i > 128 ? 128 : d0i); d1i = d1i < 0 ? 0 : (d1i > 128 ? 128 : d1i);
                    sc0[r] += btab[d0i]; sc1[r] += btab[d1i]; }
            }
            if (!fast && tb == my_last) {
#pragma unroll
                for (int r = 0; r < 16; ++r) { const int k0i = key0 + crow(r, hi); if (k0i > tq) sc0[r] = -INFINITY; if (k0i + 32 > tq) sc1[r] = -INFINITY; }
            }
            if (MODE == 2) {
                const u32x2 wsel = *(const u32x2*)(SEL + qrow * 64 + 2 * tb);
                const unsigned w0 = wsel.x >> (4 * hi), w1 = wsel.y >> (4 * hi);
#pragma unroll
                for (int r = 0; r < 16; ++r) { const int bp = (r & 3) + 8 * (r >> 2);
                    const unsigned m0 = (unsigned)((int)(w0 << (31 - bp)) >> 31), m1 = (unsigned)((int)(w1 << (31 - bp)) >> 31);
                    sc0[r] = __uint_as_float((__float_as_uint(sc0[r]) & m0) | (~m0 & 0xFF800000u)); sc1[r] = __uint_as_float((__float_as_uint(sc1[r]) & m1) | (~m1 & 0xFF800000u)); }
            }
            float ma = __builtin_fmaxf(__builtin_fmaxf(sc0[0], sc0[1]), sc0[2]), mb = __builtin_fmaxf(__builtin_fmaxf(sc1[0], sc1[1]), sc1[2]);
#pragma unroll
            for (int r = 3; r < 15; r += 2) { ma = __builtin_fmaxf(__builtin_fmaxf(ma, sc0[r]), sc0[r + 1]); mb = __builtin_fmaxf(__builtin_fmaxf(mb, sc1[r]), sc1[r + 1]); }
            float mx = __builtin_fmaxf(__builtin_fmaxf(ma, mb), __builtin_fmaxf(sc0[15], sc1[15]));
            mx = xhalf_max(mx);
            mn = fmaxf(m_run, mx);
            const float ms = (mn == -INFINITY) ? 0.f : mn;
#pragma unroll
            for (int r = 0; r < 16; ++r) { sc0[r] = __builtin_amdgcn_exp2f(sc0[r] - ms); sc1[r] = __builtin_amdgcn_exp2f(sc1[r] - ms); ls += sc0[r] + sc1[r]; }
            pn[0] = pack8(sc0, 0); pn[1] = pack8(sc0, 8); pn[2] = pack8(sc1, 0); pn[3] = pack8(sc1, 8);
        }
        if (s3) {
            LAS const unsigned char* vp = vb + ((lane >> 4) & 1) * 32 + (lane & 3) * 8 + (4 * hi + ((lane & 15) >> 2)) * 64;
#pragma unroll
            for (int d0 = 0; d0 < 2; ++d0) {
                bf16x8 vf[4];
#pragma unroll
                for (int ks = 0; ks < 4; ++ks) { const v4i16_t lo = vtr(vp + d0 * 4096 + ks * 1024), hh = vtr(vp + d0 * 4096 + ks * 1024 + 512);
                    vf[ks] = (bf16x8){lo[0], lo[1], lo[2], lo[3], hh[0], hh[1], hh[2], hh[3]}; }
                if (!fast) __builtin_amdgcn_sched_barrier(0);
                o[d0] = mfma32(vf[0], pk[0], o[d0]); o[d0] = mfma32(vf[1], pk[1], o[d0]); o[d0] = mfma32(vf[2], pk[2], o[d0]); o[d0] = mfma32(vf[3], pk[3], o[d0]);
            }
        }
        if (s2) {
            if (__any(mn != m_run)) {
                const float ms = (mn == -INFINITY) ? 0.f : mn;
                const float alpha = __builtin_amdgcn_exp2f(m_run - ms);
                l_run *= alpha;
#pragma unroll
                for (int r = 0; r < 16; ++r) { o[0][r] *= alpha; o[1][r] *= alpha; }
            }
            l_run += ls; m_run = mn;
#pragma unroll
            for (int k = 0; k < 4; ++k) pk[k] = pn[k];
        }
        if (s1) { sc0 = n0; sc1 = n1; }
    };
    using T_ = std::true_type; using F_ = std::false_type;
#pragma unroll 1
    for (int it = 0; it < NT + 2; ++it) {
        const bool kon = it + 1 < NT, von = (it >= 1) && (it - 1 < NT);
        tile_load2<NCH>(tr, src, 64 * (it + 1), kon, 64 * (it - 1), von, wid, lane);
        const bool g1 = it <= my_last, g2 = (it >= 1) && (it - 1 <= my_last), g3 = (it >= 2) && (it - 2 <= my_last);
        const bool s2fast = (it - 1 < my_last) && (MODE == 3 || (64 * (it - 1) + 63 + 128 <= tmin));
        if (g1 && g2 && g3 && s2fast) step(it, T_{}, T_{}, T_{}, T_{});
        else { if (g3) step(it, F_{}, F_{}, T_{}, F_{}); if (g2) step(it, F_{}, T_{}, F_{}, F_{}); if (g1) step(it, T_{}, F_{}, F_{}, F_{}); }
        const int nxt = (it + 1) & 1;
        tile_write2<NCH>(tr, lds + AL_K + nxt * AL_KB, kon, lds + AL_V + nxt * AL_VB, von, wid, lane);
        __syncthreads();
    }
    const float il = 1.0f / xhalf_sum(l_run);
#pragma unroll
    for (int d0 = 0; d0 < 2; ++d0)
#pragma unroll
        for (int r = 0; r < 16; ++r) o[d0][r] *= il;
    store_gated(o, HB, OB, qrow, MODE * 256 + h * 64, hi);
}

__device__ __forceinline__ void sb_tile_load(u32x4 (&kr)[8], u32x4 (&vr)[8], const bf16_t* Kp, const bf16_t* Vp, int key0, int lane) {
#pragma unroll
    for (int c = 0; c < 8; ++c) kr[c] = *(const u32x4*)(Kp + (size_t)(key0 + lane) * NV + c * 8);
#pragma unroll
    for (int w = 0; w < 8; ++w) vr[w] = *(const u32x4*)(Vp + (size_t)(key0 + 16 * (w & 3) + (lane >> 2)) * NV + (w >> 2) * 32 + (lane & 3) * 8);
}
__device__ __forceinline__ void sb_tile_write(const u32x4 (&kr)[8], const u32x4 (&vr)[8], LAS unsigned char* kb, LAS unsigned char* vb, int lane) {
#pragma unroll
    for (int c = 0; c < 8; ++c) *(LAS u32x4*)(kb + c * 1024 + lane * 16) = kr[c];
#pragma unroll
    for (int w = 0; w < 8; ++w) *(LAS u32x4*)(vb + w * 1024 + lane * 16) = vr[w];
}
__device__ __forceinline__ void attn_item_sb(const Ctx& C, const Args& a, int b, int h, int qw) {
    const bf16_t* HB = (const bf16_t*)(a.ws + WS_HB); bf16_t* OB = (bf16_t*)(a.ws + WS_XB);
    int lane_op = C.lane; asm volatile("" : "+v"(lane_op));
    const int lane = lane_op, wid = C.wid, r32 = lane & 31, hi = lane >> 5;
    const size_t rb = (size_t)b * SEQ;
    const int tq = 32 * qw + r32;
    const size_t qrow = rb + tq;
    LAS unsigned char* kb = C.lds + wid * 16384; LAS unsigned char* vb = kb + 8192;
    const bf16_t* Kp = HB + rb * NV + V_AK + h * 64; const bf16_t* Vp = HB + rb * NV + V_AV + h * 64;
    bf16x8 qf[4];
#pragma unroll
    for (int d0 = 0; d0 < 4; ++d0) qf[d0] = *(const bf16x8*)(HB + qrow * NV + V_AQ + h * 64 + 16 * d0 + 8 * hi);
    f32x16 o[2]; o[0] = f32x16{}; o[1] = f32x16{};
    float carry = 0.f;
    const int t_first = qw >> 1;
    u32x4 kr[8], vr[8];
    sb_tile_load(kr, vr, Kp, Vp, 64 * t_first, lane);
#pragma unroll 1
    for (int tt = t_first; tt >= 0; --tt) {
        sb_tile_write(kr, vr, kb, vb, lane);
        if (tt > 0) sb_tile_load(kr, vr, Kp, Vp, 64 * (tt - 1), lane);
        f32x16 p0 = f32x16{}, p1 = f32x16{};
        qk_tile<4>(p0, p1, kb, 0, qf, r32, hi);
        const int key0 = 64 * tt;
#pragma unroll
        for (int sub = 1; sub >= 0; --sub) {
            f32x16& p = sub ? p1 : p0;
            float x[16], ls[16];
#pragma unroll
            for (int r = 0; r < 16; ++r) {
                const float z = p[r] * 0.125f;
                const float e = __builtin_amdgcn_exp2f(-fabsf(z) * LOG2E);
                const float sp = fmaxf(z, 0.f) + __builtin_amdgcn_logf(1.0f + e) * LN2;
                x[r] = -sp;
                ls[r] = z - sp;
            }
            if (tt == t_first) {
#pragma unroll
                for (int r = 0; r < 16; ++r) { const bool valid = (key0 + 32 * sub + crow(r, hi)) < tq; x[r] = valid ? x[r] : 0.f; ls[r] = valid ? ls[r] : -INFINITY; __builtin_amdgcn_sched_barrier(0); }
            }
            float ex[16], gs[4];
#pragma unroll
            for (int g = 0; g < 4; ++g) { ex[4 * g + 3] = 0.f; ex[4 * g + 2] = x[4 * g + 3]; ex[4 * g + 1] = ex[4 * g + 2] + x[4 * g + 2]; ex[4 * g + 0] = ex[4 * g + 1] + x[4 * g + 1]; gs[g] = ex[4 * g] + x[4 * g]; }
            float oth[4], pr[4];
#pragma unroll
            for (int g = 0; g < 4; ++g) { oth[g] = xhalf_other(gs[g], hi); pr[g] = gs[g] + oth[g]; }
            float tail[4]; tail[3] = 0.f; tail[2] = pr[3]; tail[1] = pr[3] + pr[2]; tail[0] = tail[1] + pr[1];
            const float total = tail[0] + pr[0];
#pragma unroll
            for (int g = 0; g < 4; ++g) { const float off = carry + tail[g] + (hi == 0 ? oth[g] : 0.f);
#pragma unroll
                for (int i = 0; i < 4; ++i) p[4 * g + i] = __builtin_amdgcn_exp2f((ls[4 * g + i] + (off + ex[4 * g + i])) * LOG2E); }
            carry += total;
            pv_half(o, vb, lane, hi, 2 * sub, pack8(p, 0), pack8(p, 8));
        }
        if (__all(carry < -104.0f)) break;
    }
    store_gated(o, HB, OB, qrow, 0 * 256 + h * 64, hi);
}

__device__ __forceinline__ void p4_attention(const Ctx& C, const Args& a, int layer) {
    const int npair = 3 * NB * 16;
    for (int u = C.vcu; u < npair; u += C.G) {
        const int g = u / (NB * 16), rem = u % (NB * 16), b = rem >> 4, h = (rem >> 2) & 3, p = rem & 3;
#pragma unroll 1
        for (int k = 0; k < 2; ++k) {
            const int qb = k ? 7 - p : p;
            if (g == 0) { for (int rep = 0; rep < NREP(11); ++rep) if (HAS(9)) attn_unit_sm<1>(C, a, layer, b, h, qb); }
            else if (g == 1) { for (int rep = 0; rep < NREP(12); ++rep) if (HAS(10)) attn_unit_sm<2>(C, a, layer, b, h, qb); }
            else { for (int rep = 0; rep < NREP(13); ++rep) if (HAS(11)) attn_unit_sm<3>(C, a, layer, b, h, qb); }
        }
    }
    __syncthreads();
    for (int it = C.vcu * NWAVES + C.wid; it < NB * 256; it += C.G * NWAVES) { const int b = it >> 8, h = (it >> 6) & 3, qw = it & 63; for (int rep = 0; rep < NREP(14); ++rep) if (HAS(8)) attn_item_sb(C, a, b, h, qw); }
    __syncthreads();
}

__device__ __forceinline__ void p6_layernorm(const Ctx& C, const Args& a, int layer) {
    const float* Z = (const float*)(a.ws + WS_HB); bf16_t* XB = (bf16_t*)(a.ws + WS_XB);
    const float* g = a.ln_g + layer * DM; const float* bb = a.ln_b + layer * DM;
    const int gw = C.vcu * NWAVES + C.wid, NGW = C.G * NWAVES, lane = C.lane;
    f32x4 gv[4], bv[4];
#pragma unroll
    for (int j = 0; j < 4; ++j) { gv[j] = *(const f32x4*)(g + 256 * j + 4 * lane); bv[j] = *(const f32x4*)(bb + 256 * j + 4 * lane); }
    for (int m = gw; m < M_TOK; m += NGW) {
        f32x4 v[4]; float s = 0.f;
#pragma unroll
        for (int j = 0; j < 4; ++j) { v[j] = *(const f32x4*)(Z + (size_t)m * DM + 256 * j + 4 * lane); s += (v[j][0] + v[j][1]) + (v[j][2] + v[j][3]); }
        const float mean = wave_sum(s) * (1.0f / DM); float s2 = 0.f;
#pragma unroll
        for (int j = 0; j < 4; ++j) { v[j] = v[j] - mean; s2 += (v[j][0] * v[j][0] + v[j][1] * v[j][1]) + (v[j][2] * v[j][2] + v[j][3] * v[j][3]); }
        const float rstd = 1.0f / sqrtf(wave_sum(s2) * (1.0f / DM) + 1e-5f);
#pragma unroll
        for (int j = 0; j < 4; ++j) { const f32x4 o = v[j] * rstd * gv[j] + bv[j];
            *(f32x4*)(a.out + (size_t)m * DM + 256 * j + 4 * lane) = o;
            if (layer + 1 < DEPTH) { u32x2 w; w.x = cvtpk(o[0], o[1]); w.y = cvtpk(o[2], o[3]); *(u32x2*)(XB + (size_t)m * DM + 256 * j + 4 * lane) = w; } }
    }
}

#define RLX_AGENT __ATOMIC_RELAXED, __HIP_MEMORY_SCOPE_AGENT
#define XB_TMO      128
#define XB_XCNT(j)  (256  + 64 * (j))
#define XB_XSUB(j)  (1280 + 64 * (j))
#define XB_XGEN(j)  (2304 + 64 * (j))
#define XB_TOP      3328
#define XB_TOPGEN   3392
#define XCD_BAR_WORDS 3456
#define XB_SPIN_CAP (1u << 18)

__device__ __forceinline__ unsigned xb_ld(unsigned* p)              { return __hip_atomic_load(p, __ATOMIC_RELAXED, __HIP_MEMORY_SCOPE_AGENT); }
__device__ __forceinline__ unsigned xb_add(unsigned* p, unsigned v) { return __hip_atomic_fetch_add(p, v, __ATOMIC_RELAXED, __HIP_MEMORY_SCOPE_AGENT); }
__device__ __forceinline__ unsigned xb_xcc_id() { return (unsigned)__builtin_amdgcn_s_getreg((3 << 11) | 20) & 0xFu; }
#define XB_SPIN(cond, bar) do { unsigned _sp = 0; while (cond) { __builtin_amdgcn_s_sleep(1); \
    if ((++_sp & 255u) == 0u) { if (xb_ld(&(bar)[XB_TMO])) break; if (_sp > XB_SPIN_CAP) { atomicAdd(&(bar)[XB_TMO], 1u); break; } } } } while (0)

struct XcdBarrier {
    unsigned* bar; unsigned x;
    volatile LAS unsigned* st;
};

__device__ __forceinline__ XcdBarrier xcd_barrier_post(unsigned* bar, volatile LAS unsigned* st, bool leader) {
    XcdBarrier b; b.bar = bar; b.x = xb_xcc_id(); b.st = st;
    if (leader) (void)xb_add(&bar[XB_XCNT(b.x)], 1u);
    return b;
}
__device__ __forceinline__ void xcd_barrier_complete(unsigned* bar, unsigned x, unsigned& nloc, unsigned& nx) {
    const unsigned G = gridDim.x * gridDim.y * gridDim.z;
    unsigned sum, cnt, mine, sp = 0u;
    for (;;) {
        sum = 0u; cnt = 0u; mine = 0u;
#pragma unroll
        for (unsigned j = 0; j < 16; ++j) { const unsigned c = xb_ld(&bar[XB_XCNT(j)]); sum += c; cnt += (c > 0u) ? 1u : 0u; mine = (j == x) ? c : mine; }
        if (sum == G) break;
        __builtin_amdgcn_s_sleep(1);
        if ((++sp & 255u) == 0u) { if (xb_ld(&bar[XB_TMO])) break; if (sp > XB_SPIN_CAP) { atomicAdd(&bar[XB_TMO], 1u); break; } }
    }
    nloc = mine > 0u ? mine : 1u; nx = cnt > 0u ? cnt : 1u;
}

__device__ __forceinline__ void xcd_barrier(const XcdBarrier& b, bool leader) {
    asm volatile("s_waitcnt vmcnt(0)" ::: "memory");
    __syncthreads();
    if (leader) {
        unsigned* bar = b.bar;
        __builtin_amdgcn_s_waitcnt(0);
        unsigned nloc = b.st[0], nx = b.st[1];
        if (nloc == 0u) { xcd_barrier_complete(bar, b.x, nloc, nx); b.st[0] = nloc; b.st[1] = nx; }
        const unsigned old = xb_add(&bar[XB_XSUB(b.x)], 1u);
        const unsigned gen = old / nloc;
        if (old + 1u == (gen + 1u) * nloc) {
            __builtin_amdgcn_fence(__ATOMIC_RELEASE, "agent");
            asm volatile("s_waitcnt vmcnt(0)" ::: "memory");
            const unsigned og = xb_add(&bar[XB_TOP], 1u);
            const unsigned tg = og / nx;
            if (og + 1u == (tg + 1u) * nx) xb_add(&bar[XB_TOPGEN], 1u);
            else XB_SPIN(xb_ld(&bar[XB_TOPGEN]) == tg, bar);
            __builtin_amdgcn_fence(__ATOMIC_ACQUIRE, "agent");
            xb_add(&bar[XB_XGEN(b.x)], 1u);
            asm volatile("s_waitcnt vmcnt(0)" ::: "memory");
        } else {
            XB_SPIN(xb_ld(&bar[XB_XGEN(b.x)]) == gen, bar);
            __builtin_amdgcn_fence(__ATOMIC_ACQUIRE, "agent");
            asm volatile("s_waitcnt vmcnt(0)" ::: "memory");
        }
    }
    __syncthreads();
}

constexpr int N_PHASES = 1 + 6 * DEPTH;
#define IN(k) (lo <= (k) && (k) < hi)
#if DIAG
#define SEAM(k) do { } while (0)
#else
#define SEAM(k) do { if (IN(k) && IN((k) + 1)) { { xcd_barrier(bar, C.wid == 0 && C.lane == 0); if (REP_PH == 8) xcd_barrier(bar, C.wid == 0 && C.lane == 0); } } } while (0)
#endif
#define REFRESH() do { int l_op; asm volatile("v_mbcnt_lo_u32_b32 %0, -1, 0\n\tv_mbcnt_hi_u32_b32 %0, -1, %0" : "=v"(l_op)); C.lane = l_op; C.tid = C.wid * 64 + l_op; \
        size_t z_op = 0; asm volatile("" : "+s"(z_op)); al.ws = a.ws + z_op; } while (0)
template <int layer>
__device__ __forceinline__ void layer_body(Ctx& C, const Args& a, Args& al, const int lo, const int hi, cg::grid_group& grid, const XcdBarrier& bar) {
        const int pb = 1 + 6 * layer;
        for (int rep = 0; rep < NREP(1); ++rep) if (HAS(1) && IN(pb)) {
            REFRESH();
            pg8::Gemm g{(const pg8::bf16_t*)(al.ws + WS_XB), (const pg8::bf16_t*)(al.ws + WS_WIN) + (size_t)layer * NV * DM, M_TOK, NV, DM};
            pg8::StaticOrder S; S.init(M_TOK, NV, C.G, (int)blockIdx.x);
            pg8::EpiMain E{(pg8::bf16_t*)(al.ws + WS_HB), NV, 12};
            pg8::gemm_phase<pg8::EpiMain, pg8::StaticOrder, true, true>(C.lds, g, S, E, C.wid);
        }
        SEAM(pb);
        if (IN(pb + 1)) { for (int rep = 0; rep < NREP(2); ++rep) if (HAS(2)) { REFRESH(); p2_mla_prep(C, al, layer); } for (int rep = 0; rep < NREP(7); ++rep) if (HAS(7)) { REFRESH(); p2_select(C, al); } }
        SEAM(pb + 1);
        for (int rep = 0; rep < NREP(3); ++rep) if (HAS(3) && IN(pb + 2)) {
            REFRESH();
            pg8::Gemm g{(const pg8::bf16_t*)(al.ws + WS_CN), (const pg8::bf16_t*)(al.ws + WS_WMLA) + (size_t)layer * 1024 * 384, M_TOK, 1024, 384};
            pg8::StaticOrder S; S.init(M_TOK, 1024, C.G, (int)blockIdx.x);
            pg8::EpiMain E{(pg8::bf16_t*)(al.ws + WS_MD), DM, 1 << 30};
            pg8::gemm_phase<pg8::EpiMain, pg8::StaticOrder, true, true>(C.lds, g, S, E, C.wid);
        }
        SEAM(pb + 2);
        for (int rep = 0; rep < NREP(4); ++rep) if (HAS(4) && IN(pb + 3)) { REFRESH(); p4_attention(C, al, layer); }
        SEAM(pb + 3);
        for (int rep = 0; rep < NREP(5); ++rep) if (HAS(5) && IN(pb + 4)) {
            REFRESH();
            pg8::Gemm g{(const pg8::bf16_t*)(al.ws + WS_XB), (const pg8::bf16_t*)(al.ws + WS_WOUT) + (size_t)layer * DM * DM, M_TOK, DM, DM};
            pg8::StaticOrder S; S.init(M_TOK, DM, C.G, (int)blockIdx.x);
            pg8::EpiOut E{layer == 0 ? al.x : al.out, (float*)(al.ws + WS_HB), ALPHA_RES};
            pg8::gemm_phase<pg8::EpiOut, pg8::StaticOrder, true, true>(C.lds, g, S, E, C.wid);
        }
        SEAM(pb + 4);
        for (int rep = 0; rep < NREP(6); ++rep) if (HAS(6) && IN(pb + 5)) { REFRESH(); p6_layernorm(C, al, layer); }
        SEAM(pb + 5);
}
__global__ void __launch_bounds__(NTHREADS, 2) mega_fwd(Args a) {
    extern __shared__ __attribute__((aligned(16))) unsigned char lds_raw[];
    cg::grid_group grid = cg::this_grid();
    Ctx C; C.lds = (LAS unsigned char*)lds_raw; C.tid = threadIdx.x; C.lane = C.tid & 63; C.wid = __builtin_amdgcn_readfirstlane(C.tid >> 6);
    C.G = gridDim.x; { const int bx = blockIdx.x; C.vcu = (C.G % 8 == 0) ? (bx % 8) * (C.G / 8) + bx / 8 : bx; }
    const int lo = a.ph_lo, hi = a.ph_hi;
    Args al = a;
    volatile LAS unsigned* MISC = (volatile LAS unsigned*)(C.lds + LDS_CTL);
    if (C.tid < 16) MISC[C.tid] = 0u;
    __syncthreads();
    XcdBarrier bar = xcd_barrier_post((unsigned*)(a.ws + WS_CTL), MISC, C.tid == 0);
    for (int rep = 0; rep < NREP(0); ++rep) if (HAS(0) && IN(0)) { REFRESH(); p0_prologue(C, al); } SEAM(0);
    layer_body<0>(C, a, al, lo, hi, grid, bar);
    layer_body<1>(C, a, al, lo, hi, grid, bar);
}
#undef IN
#undef SEAM

#if !DIAG
extern "C" void kernel_launch(void* const* d_in, const int* in_sizes, int n_in, void* d_out, int out_size, void* d_ws, size_t ws_size, hipStream_t stream) {
    static int grid = 0;
    if (grid == 0) {
        if (n_in != 12 || in_sizes[0] != M_TOK * DM || out_size != M_TOK * DM || ws_size < WS_END) {
            fprintf(stderr, "kernel_launch: unexpected shapes (n_in %d, x %d, out %d, ws %zu, need %zu); nothing launched\n", n_in, n_in > 0 ? in_sizes[0] : -1, out_size, ws_size, (size_t)WS_END); grid = -1; return; }
        int dev = 0, cus = 0, per_cu = 0;
        (void)hipGetDevice(&dev); (void)hipDeviceGetAttribute(&cus, hipDeviceAttributeMultiprocessorCount, dev);
        if (hipFuncSetAttribute((const void*)mega_fwd, hipFuncAttributeMaxDynamicSharedMemorySize, LDS_BYTES) != hipSuccess) { fprintf(stderr, "kernel_launch: hipFuncSetAttribute failed\n"); grid = -1; return; }
        if (hipOccupancyMaxActiveBlocksPerMultiprocessor(&per_cu, (const void*)mega_fwd, NTHREADS, LDS_BYTES) != hipSuccess || per_cu < 1) { fprintf(stderr, "kernel_launch: occupancy query says %d blocks per CU\n", per_cu); per_cu = 1; }
        (void)hipGetLastError();
        grid = cus;
    }
    if (grid < 0) return;
    Args a{};
    a.x = (const float*)d_in[0]; a.w_in = (const float*)d_in[1]; a.w_out = (const float*)d_in[2]; a.ln_g = (const float*)d_in[3]; a.ln_b = (const float*)d_in[4];
    a.rel_bias = (const float*)d_in[5]; a.diff_lambda = (const float*)d_in[6]; a.diff_subln = (const float*)d_in[7]; a.mla_q_norm = (const float*)d_in[8];
    a.mla_kv_norm = (const float*)d_in[9]; a.mla_w_uq = (const float*)d_in[10]; a.mla_w_ukv = (const float*)d_in[11];
    a.out = (float*)d_out; a.ws = (unsigned char*)d_ws; a.ph_lo = 0; a.ph_hi = N_PHASES;
    if (hipMemsetAsync(d_ws, 0, 16384, stream) != hipSuccess) { fprintf(stderr, "kernel_launch: hipMemsetAsync of the barrier words failed\n"); return; }
    void* args[] = {&a};
    const hipError_t e = hipLaunchCooperativeKernel((const void*)mega_fwd, dim3(grid), dim3(NTHREADS), args, LDS_BYTES, stream);
    if (e != hipSuccess) fprintf(stderr, "kernel_launch: cooperative launch failed: %s (grid %d)\n", hipGetErrorString(e), grid);
}
#endif
#if DIAG
namespace nv {
constexpr int D_MODEL = 1024, BATCH = 16, SEQ = 2048, DEPTH = 2, H = 4, HD = 64;
constexpr int D_IN = 4040;
constexpr int O_AQ = 0, O_AK = 256, O_AV = 512, O_BQ = 768, O_BK = 1024, O_BV = 1280, O_CQ = 1536, O_CK = 1792, O_CV = 2048,
              O_CIQ = 2304, O_CIK = 2560, O_CIW = 2592, O_DCQ = 2600, O_DCKV = 2856, O_DKR = 2984, O_GATE = 3016;
constexpr int CB = 1;
constexpr int MC = CB * SEQ;
constexpr float ALPHA = 1.4142135623730951f;

__global__ void __launch_bounds__(256) gemm_f32(const float* __restrict__ A, int lda, const float* __restrict__ B, int ldb,
                                                float* __restrict__ C, int ldc, int M, int N, int K) {
    __shared__ float As[16][65];
    __shared__ float Bs[16][65];
    const int tx = threadIdx.x & 15, ty = threadIdx.x >> 4;
    const int m0 = blockIdx.y * 64, n0 = blockIdx.x * 64;
    float acc[4][4];
#pragma unroll
    for (int i = 0; i < 4; ++i)
#pragma unroll
        for (int j = 0; j < 4; ++j) acc[i][j] = 0.f;
    for (int k0 = 0; k0 < K; k0 += 16) {
#pragma unroll
        for (int i = 0; i < 4; ++i) {
            const int e = threadIdx.x + i * 256, r = e >> 4, kk = e & 15;
            As[kk][r] = A[(size_t)(m0 + r) * lda + k0 + kk];
        }
#pragma unroll
        for (int i = 0; i < 4; ++i) {
            const int e = threadIdx.x + i * 256, kk = e >> 6, c = e & 63;
            Bs[kk][c] = (n0 + c < N) ? B[(size_t)(k0 + kk) * ldb + n0 + c] : 0.f;
        }
        __syncthreads();
#pragma unroll
        for (int kk = 0; kk < 16; ++kk) {
            float a[4], b[4];
#pragma unroll
            for (int i = 0; i < 4; ++i) a[i] = As[kk][ty * 4 + i];
#pragma unroll
            for (int j = 0; j < 4; ++j) b[j] = Bs[kk][tx * 4 + j];
#pragma unroll
            for (int i = 0; i < 4; ++i)
#pragma unroll
                for (int j = 0; j < 4; ++j) acc[i][j] = fmaf(a[i], b[j], acc[i][j]);
        }
        __syncthreads();
    }
#pragma unroll
    for (int i = 0; i < 4; ++i)
#pragma unroll
        for (int j = 0; j < 4; ++j) {
            const int c = n0 + tx * 4 + j;
            if (c < N) C[(size_t)(m0 + ty * 4 + i) * ldc + c] = acc[i][j];
        }
}

__device__ __forceinline__ float wave_sum(float v) {
#pragma unroll
    for (int o = 1; o < 64; o <<= 1) v += __shfl_xor(v, o);
    return v;
}

__global__ void __launch_bounds__(256) rms_rows(const float* __restrict__ src, int ld, int off, int W, const float* __restrict__ g, float* __restrict__ dst, int M) {
    const int row = blockIdx.x * 4 + (threadIdx.x >> 6), lane = threadIdx.x & 63;
    if (row >= M) return;
    const float* p = src + (size_t)row * ld + off;
    float s = 0.f;
    for (int c = lane; c < W; c += 64) { const float v = p[c]; s += v * v; }
    s = wave_sum(s);
    const float r = 1.0f / sqrtf(s / (float)W + 1e-6f);
    for (int c = lane; c < W; c += 64) dst[(size_t)row * W + c] = p[c] * r * g[c];
}

__device__ __forceinline__ float inv_freq(int i) { return powf(10000.0f, -(float)i / 16.0f); }

__global__ void __launch_bounds__(256) rope_k(float* __restrict__ dq, const float* __restrict__ hbuf, float* __restrict__ kr, int M) {
    const int idx = blockIdx.x * 256 + threadIdx.x;
    if (idx >= M * 16 * 5) return;
    const int i = idx & 15, which = (idx >> 4) % 5, m = idx / 80;
    const int t = m % SEQ;
    const float ang = (float)t * inv_freq(i);
    const float c = cosf(ang), s = sinf(ang);
    if (which < 4) {
        float* p = dq + (size_t)m * 384 + which * 96 + 64;
        const float x1 = p[i], x2 = p[16 + i];
        p[i] = x1 * c - x2 * s; p[16 + i] = x1 * s + x2 * c;
    } else {
        const float* p = hbuf + (size_t)m * D_IN + O_DKR;
        const float x1 = p[i], x2 = p[16 + i];
        kr[(size_t)m * 32 + i] = x1 * c - x2 * s; kr[(size_t)m * 32 + 16 + i] = x1 * s + x2 * c;
    }
}

__device__ __forceinline__ int t5_bucket(int dist) {
    const int n = dist > 0 ? dist : 0;
    if (n < 16) return n;
    const float nf = (float)n;
    int large = 16 + (int)(logf(nf / 16.0f) / 2.0794415416798357f * 16.0f);
    return large < 31 ? large : 31;
}

__device__ __forceinline__ float softplusf(float z) { return fmaxf(z, 0.f) + log1pf(expf(-fabsf(z))); }

__global__ void __launch_bounds__(256) attn_A(const float* __restrict__ hb, float* __restrict__ o) {
    const int b = blockIdx.z, hd = blockIdx.y, t = blockIdx.x * 256 + threadIdx.x;
    const float* qp = hb + (size_t)(b * SEQ + t) * D_IN + O_AQ + hd * 64;
    float q[64], acc[64];
#pragma unroll
    for (int d = 0; d < 64; ++d) { q[d] = qp[d]; acc[d] = 0.f; }
    float cum = 0.f;
    const int tmax = blockIdx.x * 256 + 255;
    for (int s = tmax - 1; s >= 0; --s) {
        const float* kp = hb + (size_t)(b * SEQ + s) * D_IN + O_AK + hd * 64;
        const float* vp = hb + (size_t)(b * SEQ + s) * D_IN + O_AV + hd * 64;
        float z = 0.f;
#pragma unroll
        for (int d = 0; d < 64; ++d) z = fmaf(q[d], kp[d], z);
        z *= 0.125f;
        if (s < t) {
            const float sp = softplusf(z);
            const float w = expf((z - sp) + cum);
#pragma unroll
            for (int d = 0; d < 64; ++d) acc[d] = fmaf(w, vp[d], acc[d]);
            cum -= sp;
        }
    }
    float* op = o + (size_t)(b * SEQ + t) * 1024 + 0 * 256 + hd * 64;
#pragma unroll
    for (int d = 0; d < 64; ++d) op[d] = acc[d];
}

__global__ void __launch_bounds__(256) attn_B(const float* __restrict__ hb, float* __restrict__ o, const float* __restrict__ rel_bias,
                                              const float* __restrict__ dlam, const float* __restrict__ subln, float lam_init) {
    const int b = blockIdx.z, hd = blockIdx.y, t = blockIdx.x * 256 + threadIdx.x;
    const float* qp = hb + (size_t)(b * SEQ + t) * D_IN + O_BQ + hd * 64;
    float q[64], o1[64], o2[64];
#pragma unroll
    for (int d = 0; d < 64; ++d) { q[d] = qp[d]; o1[d] = 0.f; o2[d] = 0.f; }
    float m1 = -INFINITY, m2 = -INFINITY, l1 = 0.f, l2 = 0.f;
    const int tmax = blockIdx.x * 256 + 255;
    const float sc = 0.17677669529663687f;
    for (int s = 0; s <= tmax; ++s) {
        const float* kp = hb + (size_t)(b * SEQ + s) * D_IN + O_BK + hd * 64;
        const float* vp = hb + (size_t)(b * SEQ + s) * D_IN + O_BV + hd * 64;
        float s1 = 0.f, s2 = 0.f;
#pragma unroll
        for (int d = 0; d < 32; ++d) { s1 = fmaf(q[d], kp[d], s1); s2 = fmaf(q[32 + d], kp[32 + d], s2); }
        if (s <= t) {
            const float bias = rel_bias[t5_bucket(t - s) * 8 + hd];
            s1 = s1 * sc + bias; s2 = s2 * sc + bias;
            {
                const float mn = fmaxf(m1, s1), a = expf(m1 - mn), p = expf(s1 - mn);
                l1 = l1 * a + p; m1 = mn;
#pragma unroll
                for (int d = 0; d < 64; ++d) o1[d] = fmaf(p, vp[d], o1[d] * a);
            }
            {
                const float mn = fmaxf(m2, s2), a = expf(m2 - mn), p = expf(s2 - mn);
                l2 = l2 * a + p; m2 = mn;
#pragma unroll
                for (int d = 0; d < 64; ++d) o2[d] = fmaf(p, vp[d], o2[d] * a);
            }
        }
    }
    float a0 = 0.f, a1 = 0.f;
    for (int d = 0; d < 32; ++d) { a0 += dlam[d] * dlam[32 + d]; a1 += dlam[64 + d] * dlam[96 + d]; }
    const float lam = expf(a0) - expf(a1) + lam_init;
    float ss = 0.f;
#pragma unroll
    for (int d = 0; d < 64; ++d) { o1[d] = o1[d] / l1 - lam * (o2[d] / l2); ss += o1[d] * o1[d]; }
    const float r = 1.0f / sqrtf(ss / 64.0f + 1e-6f);
    float* op = o + (size_t)(b * SEQ + t) * 1024 + 1 * 256 + hd * 64;
#pragma unroll
    for (int d = 0; d < 64; ++d) op[d] = o1[d] * r * subln[d] * (1.0f - lam_init);
}

__global__ void __launch_bounds__(256) c_score(const float* __restrict__ hb, float* __restrict__ score) {
    const int b = blockIdx.z, t = blockIdx.y, s = blockIdx.x * 256 + threadIdx.x;
    if (blockIdx.x * 256 > t) return;
    const float* iq = hb + (size_t)(b * SEQ + t) * D_IN + O_CIQ;
    const float* iw = hb + (size_t)(b * SEQ + t) * D_IN + O_CIW;
    const float* ik = hb + (size_t)(b * SEQ + s) * D_IN + O_CIK;
    float k[32];
#pragma unroll
    for (int d = 0; d < 32; ++d) k[d] = ik[d];
    float sc = 0.f;
#pragma unroll
    for (int hh = 0; hh < 8; ++hh) {
        float dot = 0.f;
#pragma unroll
        for (int d = 0; d < 32; ++d) dot = fmaf(iq[hh * 32 + d], k[d], dot);
        dot *= 0.17677669529663687f;
        sc += (iw[hh] * 0.35355339059327373f) * fmaxf(dot, 0.f);
    }
    score[((size_t)b * SEQ + t) * SEQ + s] = sc;
}

__global__ void __launch_bounds__(256) c_select(const float* __restrict__ score, unsigned* __restrict__ selbits) {
    const int row = blockIdx.x * 4 + (threadIdx.x >> 6), lane = threadIdx.x & 63;
    const int t = row % SEQ;
    unsigned* out = selbits + (size_t)row * 64;
    if (t < 256) {
        const int lo = lane * 32;
        unsigned w = 0u;
        if (t >= lo + 31) w = 0xFFFFFFFFu; else if (t >= lo) w = (2u << (t - lo)) - 1u;
        out[lane] = w;
        return;
    }
    const float* sp = score + (size_t)row * SEQ;
    unsigned u[32];
#pragma unroll
    for (int i = 0; i < 32; ++i) {
        const int key = lane * 32 + i;
        unsigned v = 0u;
        if (key <= t) { const unsigned bits = __float_as_uint(sp[key] + 0.0f); v = (bits & 0x80000000u) ? ~bits : (bits | 0x80000000u); }
        u[i] = v;
    }
    unsigned T = 0u;
    for (int bit = 31; bit >= 0; --bit) {
        const unsigned cand = T | (1u << bit);
        int c = 0;
#pragma unroll
        for (int i = 0; i < 32; ++i) c += (u[i] >= cand) ? 1 : 0;
        c = (int)wave_sum((float)c);
        if (c >= 256) T = cand;
    }
    int cg = 0, ce = 0;
#pragma unroll
    for (int i = 0; i < 32; ++i) { cg += (u[i] > T) ? 1 : 0; ce += (u[i] == T) ? 1 : 0; }
    const int G = (int)wave_sum((float)cg);
    int need = 256 - G;
    int pre = ce;
#pragma unroll
    for (int o = 1; o < 64; o <<= 1) { const int v = __shfl_up(pre, o); if (lane >= o) pre += v; }
    pre -= ce;
    unsigned w = 0u;
    int taken = pre;
#pragma unroll
    for (int i = 0; i < 32; ++i) {
        if (u[i] > T) w |= (1u << i);
        else if (u[i] == T) { if (taken < need) w |= (1u << i); ++taken; }
    }
    out[lane] = w;
}

__global__ void __launch_bounds__(256) attn_C(const float* __restrict__ hb, float* __restrict__ o, const float* __restrict__ rel_bias, const unsigned* __restrict__ selbits) {
    const int b = blockIdx.z, hd = blockIdx.y, t = blockIdx.x * 256 + threadIdx.x;
    const float* qp = hb + (size_t)(b * SEQ + t) * D_IN + O_CQ + hd * 64;
    const unsigned* sb = selbits + (size_t)(b * SEQ + t) * 64;
    float q[64], acc[64];
#pragma unroll
    for (int d = 0; d < 64; ++d) { q[d] = qp[d]; acc[d] = 0.f; }
    float m = -INFINITY, l = 0.f;
    const int tmax = blockIdx.x * 256 + 255;
    unsigned word = 0u;
    for (int s = 0; s <= tmax; ++s) {
        if ((s & 31) == 0) word = sb[s >> 5];
        const float* kp = hb + (size_t)(b * SEQ + s) * D_IN + O_CK + hd * 64;
        const float* vp = hb + (size_t)(b * SEQ + s) * D_IN + O_CV + hd * 64;
        float z = 0.f;
#pragma unroll
        for (int d = 0; d < 64; ++d) z = fmaf(q[d], kp[d], z);
        if (s <= t && ((word >> (s & 31)) & 1u)) {
            z = z * 0.125f + rel_bias[t5_bucket(t - s) * 8 + 4 + hd];
            const float mn = fmaxf(m, z), a = expf(m - mn), p = expf(z - mn);
            l = l * a + p; m = mn;
#pragma unroll
            for (int d = 0; d < 64; ++d) acc[d] = fmaf(p, vp[d], acc[d] * a);
        }
    }
    float* op = o + (size_t)(b * SEQ + t) * 1024 + 2 * 256 + hd * 64;
    const float il = 1.0f / l;
#pragma unroll
    for (int d = 0; d < 64; ++d) op[d] = acc[d] * il;
}

__global__ void __launch_bounds__(256) attn_D(const float* __restrict__ dq, const float* __restrict__ dkv, const float* __restrict__ kr, float* __restrict__ o) {
    const int b = blockIdx.z, hd = blockIdx.y, t = blockIdx.x * 256 + threadIdx.x;
    const float* qp = dq + (size_t)(b * SEQ + t) * 384 + hd * 96;
    float q[96], acc[64];
#pragma unroll
    for (int d = 0; d < 96; ++d) q[d] = qp[d];
#pragma unroll
    for (int d = 0; d < 64; ++d) acc[d] = 0.f;
    float m = -INFINITY, l = 0.f;
    const int tmax = blockIdx.x * 256 + 255;
    const float sc = 0.10206207261596577f;
    for (int s = 0; s <= tmax; ++s) {
        const float* kp = dkv + (size_t)(b * SEQ + s) * 512 + hd * 128;
        const float* vp = kp + 64;
        const float* rp = kr + (size_t)(b * SEQ + s) * 32;
        float z = 0.f;
#pragma unroll
        for (int d = 0; d < 64; ++d) z = fmaf(q[d], kp[d], z);
#pragma unroll
        for (int d = 0; d < 32; ++d) z = fmaf(q[64 + d], rp[d], z);
        if (s <= t) {
            z *= sc;
            const float mn = fmaxf(m, z), a = expf(m - mn), p = expf(z - mn);
            l = l * a + p; m = mn;
#pragma unroll
            for (int d = 0; d < 64; ++d) acc[d] = fmaf(p, vp[d], acc[d] * a);
        }
    }
    float* op = o + (size_t)(b * SEQ + t) * 1024 + 3 * 256 + hd * 64;
    const float il = 1.0f / l;
#pragma unroll
    for (int d = 0; d < 64; ++d) op[d] = acc[d] * il;
}

__global__ void __launch_bounds__(256) gate_mul(float* __restrict__ o, const float* __restrict__ hb, int M) {
    const size_t idx = (size_t)blockIdx.x * 256 + threadIdx.x;
    if (idx >= (size_t)M * 1024) return;
    const int m = (int)(idx >> 10), c = (int)(idx & 1023);
    const float g = hb[(size_t)m * D_IN + O_GATE + c];
    o[idx] = o[idx] * (g / (1.0f + expf(-g)));
}

__global__ void __launch_bounds__(256) ln_res(const float* __restrict__ x, const float* __restrict__ y, const float* __restrict__ g, const float* __restrict__ bb, float* __restrict__ out, int M) {
    const int row = blockIdx.x * 4 + (threadIdx.x >> 6), lane = threadIdx.x & 63;
    if (row >= M) return;
    float v[16]; float s = 0.f;
#pragma unroll
    for (int i = 0; i < 16; ++i) { const int c = i * 64 + lane; v[i] = ALPHA * x[(size_t)row * 1024 + c] + y[(size_t)row * 1024 + c]; s += v[i]; }
    const float mean = wave_sum(s) * (1.0f / 1024.0f);
    float s2 = 0.f;
#pragma unroll
    for (int i = 0; i < 16; ++i) { v[i] -= mean; s2 += v[i] * v[i]; }
    const float r = 1.0f / sqrtf(wave_sum(s2) * (1.0f / 1024.0f) + 1e-5f);
#pragma unroll
    for (int i = 0; i < 16; ++i) { const int c = i * 64 + lane; out[(size_t)row * 1024 + c] = v[i] * r * g[c] + bb[c]; }
}
}

#ifndef DIAG_SEL
#define DIAG_SEL -1
#endif
namespace dg {
constexpr int NITEM = 32;
struct P { const bf16_t* CN; const float* cq; const bf16_t* HB; const bf16_t* MD; const bf16_t* KR; const unsigned* SEL; const bf16_t* OB; const float* OUTOPT;
           const float* hb; const float* dq; const float* dkv; const float* kr; const unsigned* selbits; const float* ob; const float* outn; };
__device__ __forceinline__ bool pair(const P& p, int it, int r, int c, float& av, float& bv) {
    if (it < 16) { const int v = it * 256 + c, s = src_col(v); if (s < 0) return false; av = bf2f(p.HB[(size_t)r * NV + v]); bv = p.hb[(size_t)r * nv::D_IN + s];
        if (it >= 12) bv = bv / (1.0f + expf(-bv)); return true; }
    if (it == 16) { if (c >= 32) return false; av = bf2f(p.HB[(size_t)r * NV + V_DKR + c]); bv = p.hb[(size_t)r * nv::D_IN + nv::O_DKR + c]; return true; }
    if (it == 17) { if (c >= 32) return false; av = bf2f(p.HB[(size_t)r * NV + V_CIK + c]); bv = p.hb[(size_t)r * nv::D_IN + nv::O_CIK + c]; return true; }
    if (it == 18) { if (c >= 8) return false; av = bf2f(p.HB[(size_t)r * NV + V_CIW + c]); bv = p.hb[(size_t)r * nv::D_IN + nv::O_CIW + c]; return true; }
    if (it == 19) { av = bf2f(p.MD[(size_t)r * DM + MD_QN + c]); bv = p.dq[(size_t)r * 384 + (c >> 6) * 96 + (c & 63)]; return true; }
    if (it == 20) { return false; }
    if (it == 21) { av = bf2f(p.MD[(size_t)r * DM + MD_KN + c]); bv = p.dkv[(size_t)r * 512 + (c >> 6) * 128 + (c & 63)]; return true; }
    if (it == 22) { av = bf2f(p.MD[(size_t)r * DM + MD_V + c]); bv = p.dkv[(size_t)r * 512 + (c >> 6) * 128 + 64 + (c & 63)]; return true; }
    if (it == 23) { if (c >= 32) return false; av = bf2f(p.KR[(size_t)r * 32 + c]); bv = p.kr[(size_t)r * 32 + c]; return true; }
    if (it == 24) { if (c >= 64) return false; const unsigned x = p.SEL[(size_t)r * 64 + c], y = p.selbits[(size_t)r * 64 + c];
        unsigned cm = 0xFFFFFFFFu; const int t = r & 2047, lo = c * 32; if (t < lo) cm = 0u; else if (t < lo + 31) cm = (2u << (t - lo)) - 1u;
        av = (float)__popc((x ^ y) & cm); bv = 0.f; if (c == 0) bv = (t < 256) ? (float)(t + 1) : 256.f; av = sqrtf(av); bv = sqrtf(bv); av += bv; return true; }
    if (it == 31) { av = bf2f(p.CN[(size_t)r * 384 + c]); bv = p.cq[(size_t)r * 256 + c]; return true; }
    if (it == 30) { av = bf2f(p.MD[(size_t)r * DM + MD_QN + c]); bv = p.dq[(size_t)r * 384 + (c >> 6) * 96 + (c & 63)]; return true; }
    if (it >= 25 && it < 29) { const int g = it - 25; av = bf2f(p.OB[(size_t)r * DM + g * 256 + c]); bv = p.ob[(size_t)r * 1024 + g * 256 + c]; return true; }
    return false;
}
__global__ void __launch_bounds__(256) cmp_item(P p, int it, int rows, float* acc) {
    float num = 0.f, den = 0.f;
    for (size_t e = (size_t)blockIdx.x * 256 + threadIdx.x; e < (size_t)rows * 256; e += (size_t)gridDim.x * 256) {
        const int r = (int)(e >> 8), c = (int)(e & 255); float av, bv;
        if (pair(p, it, r, c, av, bv)) { const float d = av - bv; num += d * d; den += bv * bv; }
    }
    num = ::wave_sum(num); den = ::wave_sum(den);
    if ((threadIdx.x & 63) == 0) { atomicAdd(acc + 2 * it, num); atomicAdd(acc + 2 * it + 1, den); }
}
__global__ void __launch_bounds__(256) cmp_final(const float* a, const float* b, size_t n, float* acc, int it) {
    float num = 0.f, den = 0.f;
    for (size_t e = (size_t)blockIdx.x * 256 + threadIdx.x; e < n; e += (size_t)gridDim.x * 256) { const float d = a[e] - b[e]; num += d * d; den += b[e] * b[e]; }
    num = ::wave_sum(num); den = ::wave_sum(den);
    if ((threadIdx.x & 63) == 0) { atomicAdd(acc + 2 * it, num); atomicAdd(acc + 2 * it + 1, den); }
}
#ifndef DIAG_SEL2
#define DIAG_SEL2 -1
#endif
#ifndef DIAG_MAXHI
#define DIAG_MAXHI 24
#endif
__global__ void finalize(float* acc) {
    float E = 0.f; int arg = 0; float e2 = 0.f;
    for (int i = 0; i < NITEM; ++i) { const float den = acc[2 * i + 1]; float e = den > 0.f ? sqrtf(acc[2 * i] / den) : 0.f; if (!(e == e)) e = 9.f;
        if (DIAG_SEL >= 0) { if (i == DIAG_SEL) { E = e; arg = i; } } else if (i < DIAG_MAXHI && e > E) { E = e; arg = i; }
        if (i == DIAG_SEL2) e2 = e; }
    acc[2 * NITEM] = E; acc[2 * NITEM + 1] = (DIAG_SEL2 >= 0) ? fmaxf(1.0e6f * e2, 100.f) : (float)((10 + arg) * 10);
}
__global__ void __launch_bounds__(256) perturb(float* out, size_t n, const float* acc) {
    const float E = acc[2 * NITEM], spike = acc[2 * NITEM + 1];
    for (size_t e = (size_t)blockIdx.x * 256 + threadIdx.x; e < n; e += (size_t)gridDim.x * 256) { float v = out[e] * (1.0f + 1000.0f * E);     if (e == 0) v += spike; out[e] = v; }
}
}

extern "C" void kernel_launch(void* const* d_in, const int* in_sizes, int n_in, void* d_out, int out_size, void* d_ws, size_t ws_size, hipStream_t stream) {
    constexpr int MC = nv::MC, CB = nv::CB, BATCH = nv::BATCH, H = nv::H, O_DCQ = nv::O_DCQ, O_DCKV = nv::O_DCKV;
    using nv::gemm_f32; using nv::rms_rows; using nv::rope_k; using nv::attn_A; using nv::attn_B; using nv::c_score; using nv::c_select; using nv::attn_C; using nv::attn_D; using nv::gate_mul; using nv::ln_res;
    const float* x = (const float*)d_in[0]; const float* w_in = (const float*)d_in[1]; const float* w_out = (const float*)d_in[2]; const float* ln_g = (const float*)d_in[3];
    const float* ln_b = (const float*)d_in[4]; const float* rel_bias = (const float*)d_in[5]; const float* diff_lambda = (const float*)d_in[6]; const float* diff_subln = (const float*)d_in[7];
    const float* mla_q_norm = (const float*)d_in[8]; const float* mla_kv_norm = (const float*)d_in[9]; const float* mla_w_uq = (const float*)d_in[10]; const float* mla_w_ukv = (const float*)d_in[11];
    float* out = (float*)d_out; char* ws = (char*)d_ws;
    size_t off = (WS_END + 255) & ~(size_t)255;
    auto carve = [&](size_t bytes) { char* p = ws + off; off += (bytes + 255) & ~(size_t)255; return p; };
    float* outopt = (float*)carve((size_t)M_TOK * DM * 4);
    float* acc = (float*)carve(4096);
    float* hb = (float*)carve((size_t)MC * D_IN * 4); float* cq = (float*)carve((size_t)MC * 256 * 4); float* ckv = (float*)carve((size_t)MC * 128 * 4);
    float* dq = (float*)carve((size_t)MC * 384 * 4); float* dkv = (float*)carve((size_t)MC * 512 * 4); float* kr = (float*)carve((size_t)MC * 32 * 4);
    float* score = (float*)carve((size_t)CB * SEQ * SEQ * 4); unsigned* selbits = (unsigned*)carve((size_t)MC * 64 * 4);
    float* ob = (float*)carve((size_t)MC * 1024 * 4); float* yb = (float*)carve((size_t)MC * 1024 * 4); float* x1 = (float*)carve((size_t)MC * 1024 * 4);
    if (off > ws_size) { fprintf(stderr, "DIAG workspace too small: need %zu have %zu\n", off, ws_size); return; }
    (void)hipMemsetAsync(acc, 0, 4096, stream);
    auto naive_layer = [&](const float* xin, float* xout, int l, bool upto_y_only) {
        const float* wi = w_in + (size_t)l * 1024 * D_IN; const float* wo = w_out + (size_t)l * 1024 * 1024;
        const float lam_init = (float)(0.8 - 0.6 * exp(-0.3 * (double)l));
        gemm_f32<<<dim3((D_IN + 63) / 64, MC / 64), 256, 0, stream>>>(xin, 1024, wi, D_IN, hb, D_IN, MC, D_IN, 1024);
        rms_rows<<<MC / 4, 256, 0, stream>>>(hb, D_IN, O_DCQ, 256, mla_q_norm + l * 256, cq, MC);
        rms_rows<<<MC / 4, 256, 0, stream>>>(hb, D_IN, O_DCKV, 128, mla_kv_norm + l * 128, ckv, MC);
        gemm_f32<<<dim3(384 / 64, MC / 64), 256, 0, stream>>>(cq, 256, mla_w_uq + (size_t)l * 256 * 384, 384, dq, 384, MC, 384, 256);
        gemm_f32<<<dim3(512 / 64, MC / 64), 256, 0, stream>>>(ckv, 128, mla_w_ukv + (size_t)l * 128 * 512, 512, dkv, 512, MC, 512, 128);
        rope_k<<<(MC * 80 + 255) / 256, 256, 0, stream>>>(dq, hb, kr, MC);
        attn_A<<<dim3(SEQ / 256, H, CB), 256, 0, stream>>>(hb, ob);
        attn_B<<<dim3(SEQ / 256, H, CB), 256, 0, stream>>>(hb, ob, rel_bias, diff_lambda + l * 128, diff_subln + l * 64, lam_init);
        c_score<<<dim3(SEQ / 256, SEQ, CB), 256, 0, stream>>>(hb, score);
        c_select<<<MC / 4, 256, 0, stream>>>(score, selbits);
        attn_C<<<dim3(SEQ / 256, H, CB), 256, 0, stream>>>(hb, ob, rel_bias, selbits);
        attn_D<<<dim3(SEQ / 256, H, CB), 256, 0, stream>>>(dq, dkv, kr, ob);
        gate_mul<<<MC * 1024 / 256, 256, 0, stream>>>(ob, hb, MC);
        if (upto_y_only) return;
        gemm_f32<<<dim3(1024 / 64, MC / 64), 256, 0, stream>>>(ob, 1024, wo, 1024, yb, 1024, MC, 1024, 1024);
        ln_res<<<MC / 4, 256, 0, stream>>>(xin, yb, ln_g + l * 1024, ln_b + l * 1024, xout, MC);
    };
    for (int c = 0; c < BATCH / CB; ++c) {
        naive_layer(x + (size_t)c * MC * 1024, x1, 0, false);
        naive_layer(x1, out + (size_t)c * MC * 1024, 1, false);
    }
    naive_layer(x, x1, 0, true);
    (void)hipFuncSetAttribute((const void*)mega_fwd, hipFuncAttributeMaxDynamicSharedMemorySize, LDS_BYTES);
    Args a{};
    a.x = x; a.w_in = w_in; a.w_out = w_out; a.ln_g = ln_g; a.ln_b = ln_b; a.rel_bias = rel_bias; a.diff_lambda = diff_lambda; a.diff_subln = diff_subln;
    a.mla_q_norm = mla_q_norm; a.mla_kv_norm = mla_kv_norm; a.mla_w_uq = mla_w_uq; a.mla_w_ukv = mla_w_ukv; a.out = outopt; a.ws = (unsigned char*)d_ws;
    dg::P p{(const bf16_t*)(ws + WS_CN), cq, (const bf16_t*)(ws + WS_HB), (const bf16_t*)(ws + WS_MD), (const bf16_t*)(ws + WS_KR), (const unsigned*)(ws + WS_SEL), (const bf16_t*)(ws + WS_XB), outopt,
            hb, dq, dkv, kr, selbits, ob, out};
    auto run = [&](int lo, int hi) { for (int ph = lo; ph < hi; ++ph) { a.ph_lo = ph; a.ph_hi = ph + 1; hipLaunchKernelGGL(mega_fwd, dim3(256), dim3(NTHREADS), LDS_BYTES, stream, a); } };
    auto cmp = [&](int it) { dg::cmp_item<<<512, 256, 0, stream>>>(p, it, SEQ, acc); };
    run(0, 2); for (int it = 0; it < 19; ++it) cmp(it);
    run(2, 4); for (int it = 19; it < 25; ++it) cmp(it); cmp(31); run(3, 4); cmp(30);
#ifdef DIAG_COPYSEL
    (void)hipMemcpyAsync(ws + WS_SEL, selbits, (size_t)SEQ * 64 * 4, hipMemcpyDeviceToDevice, stream);
#endif
    run(4, 5); for (int it = 25; it < 29; ++it) cmp(it);
    run(5, N_PHASES);
    dg::cmp_final<<<1024, 256, 0, stream>>>(outopt, out, (size_t)M_TOK * DM, acc, 29);
    dg::finalize<<<1, 1, 0, stream>>>(acc);
    dg::perturb<<<2048, 256, 0, stream>>>(out, (size_t)BATCH * SEQ * 1024, acc);
}
#endif
```
